# Optimizing an MI355X kernel written in HIP

```python
import math
import jax, jax.numpy as jnp
from jax import lax
import numpy as np

D_MODEL = 1024
BATCH = 4
SEQ = 4096
DEPTH = 2
DEC_BATCH = 16
DEC_SEQ = 4096
PAST_LEN = 128

POOL_WIDTH = 256
POOL_GROUPS = 4
POOL_GROUP_DIM = POOL_WIDTH // POOL_GROUPS
POOL_WINDOWS = (2, 4, 8, 16)
N_HEADS = 8
QK_NOPE = 64
QK_ROPE = 32
QK_DIM = QK_NOPE + QK_ROPE
V_HEAD = 64
Q_LORA = 256
KV_LORA = 128
ROPE_BASE = 10000.0
ATTN_WIDTH = N_HEADS * V_HEAD
Q_BLOCK = 128
CONV_WIDTH = 256
CONV_K = 31
FOURIER_WIDTH = 256
FOURIER_GROUPS = 4
FOURIER_GROUP_DIM = FOURIER_WIDTH // FOURIER_GROUPS
N_BRANCH = 4
NORM_EPS = 1e-6
LN_EPS = 1e-5
IN_SIZES = (POOL_WIDTH, Q_LORA, KV_LORA + QK_ROPE, 2 * CONV_WIDTH, FOURIER_WIDTH,
            POOL_WIDTH, ATTN_WIDTH, CONV_WIDTH, FOURIER_WIDTH, N_BRANCH * D_MODEL)
N_IN = POOL_WIDTH + Q_LORA + KV_LORA + QK_ROPE + 2 * CONV_WIDTH + FOURIER_WIDTH + POOL_WIDTH + ATTN_WIDTH + CONV_WIDTH + FOURIER_WIDTH + N_BRANCH * D_MODEL

kernel_name = "hybrid_parallel_gated_encoder"


def rms_norm(x, g):
    xf = x.astype(jnp.float32)
    y = xf * lax.rsqrt(jnp.mean(xf * xf, axis=-1, keepdims=True) + NORM_EPS)
    return (y * g.astype(jnp.float32)).astype(x.dtype)


def layer_norm(x, g, b):
    xf = x.astype(jnp.float32)
    mu = jnp.mean(xf, axis=-1, keepdims=True)
    var = jnp.mean(jnp.square(xf - mu), axis=-1, keepdims=True)
    y = (xf - mu) * lax.rsqrt(var + LN_EPS)
    return (y * g.astype(jnp.float32) + b.astype(jnp.float32)).astype(x.dtype)


def pool_mixer(u, pool_w, pool_scale):
    B, S, C = u.shape
    uf = u.astype(jnp.float32)
    cs = jnp.concatenate([jnp.zeros((B, 1, C), jnp.float32), jnp.cumsum(uf, axis=1)], axis=1)
    t = jnp.arange(S)
    outs = []
    for g, w in enumerate(POOL_WINDOWS):
        sl = slice(g * POOL_GROUP_DIM, (g + 1) * POOL_GROUP_DIM)
        lo = jnp.clip(t - w // 2, 0, S)
        hi = jnp.clip(t + w // 2, 0, S)
        csg = cs[..., sl]
        win_sum = jnp.take(csg, hi, axis=1) - jnp.take(csg, lo, axis=1)
        cnt = (hi - lo).astype(jnp.float32)[None, :, None]
        outs.append(win_sum / cnt - uf[..., sl])
    p = jnp.stack(outs, axis=2).astype(u.dtype)
    p = jnp.einsum('bsgc,gcd->bsgd', p, pool_w).reshape(B, S, C)
    return p * pool_scale


def rope_tables(S):
    inv_freq = 1.0 / (ROPE_BASE ** (jnp.arange(0, QK_ROPE, 2, dtype=jnp.float32) / QK_ROPE))
    ang = jnp.arange(S, dtype=jnp.float32)[:, None] * inv_freq[None, :]
    ang = jnp.concatenate([ang, ang], axis=-1)
    return jnp.cos(ang)[None, :, None, :], jnp.sin(ang)[None, :, None, :]


def apply_rope(x, cos, sin):
    xf = x.astype(jnp.float32)
    x1, x2 = xf[..., : QK_ROPE // 2], xf[..., QK_ROPE // 2:]
    rot = jnp.concatenate([-x2, x1], axis=-1)
    return (xf * cos + rot * sin).astype(x.dtype)


def mla(c_q, kv_a, q_norm_g, w_uq, kv_norm_g, w_ukv):
    B, S, _ = c_q.shape
    q = (rms_norm(c_q, q_norm_g) @ w_uq).reshape(B, S, N_HEADS, QK_DIM)
    q_nope, q_rope = q[..., :QK_NOPE], q[..., QK_NOPE:]
    c_kv, k_rope = kv_a[..., :KV_LORA], kv_a[..., KV_LORA:]
    kv = (rms_norm(c_kv, kv_norm_g) @ w_ukv).reshape(B, S, N_HEADS, QK_NOPE + V_HEAD)
    k_nope, v = kv[..., :QK_NOPE], kv[..., QK_NOPE:]
    cos, sin = rope_tables(S)
    q_rope = apply_rope(q_rope, cos, sin)
    k_rope = apply_rope(k_rope[:, :, None, :], cos, sin)
    q = jnp.concatenate([q_nope, q_rope], axis=-1)
    k = jnp.concatenate([k_nope, jnp.broadcast_to(k_rope, (B, S, N_HEADS, QK_ROPE))], axis=-1)
    scale = QK_DIM ** -0.5
    nb = S // Q_BLOCK
    qb = q.reshape(B, nb, Q_BLOCK, N_HEADS, QK_DIM).transpose(1, 0, 2, 3, 4)

    def attend(qblk):
        s = jnp.einsum('bqhd,bkhd->bhqk', qblk, k, preferred_element_type=jnp.float32) * scale
        p = jax.nn.softmax(s, axis=-1).astype(v.dtype)
        return jnp.einsum('bhqk,bkhd->bqhd', p, v)

    o = lax.map(attend, qb)
    return o.transpose(1, 0, 2, 3, 4).reshape(B, S, ATTN_WIDTH)


def conv_module(u, conv_w, conv_b, ln_g, ln_b, pw_w, pw_b):
    a, b = u[..., :CONV_WIDTH], u[..., CONV_WIDTH:]
    a = a * jax.nn.sigmoid(b)
    y = lax.conv_general_dilated(a, conv_w[:, None, :].astype(a.dtype), window_strides=(1,),
                                 padding=[(CONV_K // 2, CONV_K // 2)],
                                 dimension_numbers=('NWC', 'WIO', 'NWC'),
                                 feature_group_count=CONV_WIDTH) + conv_b
    y = jax.nn.silu(layer_norm(y, ln_g, ln_b))
    return y @ pw_w + pw_b


def fourier_mixer(u, fourier_w):
    B, S, _ = u.shape
    ug = u.astype(jnp.float32).reshape(B, S, FOURIER_GROUPS, FOURIER_GROUP_DIM)
    f = jnp.fft.fft2(ug, axes=(1, 3), norm='ortho').real
    f = f.reshape(B, S, FOURIER_WIDTH).astype(u.dtype)
    return f @ fourier_w


def encoder_layer(x, pre_g, post_g, w_in, gate_b, q_norm_g, w_uq, kv_norm_g, w_ukv,
                  pool_w, pool_scale, conv_w, conv_b, conv_ln_g, conv_ln_b, conv_pw_w, conv_pw_b,
                  fourier_w, w_up_pool, w_up_attn, w_up_conv, w_up_fourier, w_out):
    B, S, D = x.shape
    h = rms_norm(x, pre_g)
    z = h @ w_in
    points = []
    acc = 0
    for sz in IN_SIZES[:-1]:
        acc += sz
        points.append(acc)
    (u_pool, c_q, kv_a, u_conv, u_four,
     g_pool, g_attn, g_conv, g_four, z_merge) = jnp.split(z, points, axis=-1)
    y_pool = pool_mixer(u_pool, pool_w, pool_scale) * jax.nn.silu(g_pool)
    y_attn = mla(c_q, kv_a, q_norm_g, w_uq, kv_norm_g, w_ukv) * jax.nn.silu(g_attn)
    y_conv = conv_module(u_conv, conv_w, conv_b, conv_ln_g, conv_ln_b, conv_pw_w, conv_pw_b) * jax.nn.silu(g_conv)
    y_four = fourier_mixer(u_four, fourier_w) * jax.nn.silu(g_four)
    gates = jax.nn.sigmoid((z_merge + gate_b).reshape(B, S, N_BRANCH, D))
    m = (gates[:, :, 0] * (y_pool @ w_up_pool)
         + gates[:, :, 1] * (y_attn @ w_up_attn)
         + gates[:, :, 2] * (y_conv @ w_up_conv)
         + gates[:, :, 3] * (y_four @ w_up_fourier))
    out = m @ w_out
    return x + rms_norm(out, post_g)


def setup_inputs(seed: int = 0) -> dict:
    key = jax.random.key(seed)
    ks = jax.random.split(key, 32)
    L, D = DEPTH, D_MODEL
    f32 = jnp.float32

    def nrm(k, shape, fan_in):
        return jax.random.normal(k, shape, f32) * (fan_in ** -0.5)

    def gain(k, shape):
        return 1.0 + 0.02 * jax.random.normal(k, shape, f32)

    def small(k, shape):
        return 0.01 * jax.random.normal(k, shape, f32)

    return {
        "x_prompt": jax.random.normal(ks[0], (BATCH, SEQ, D), f32),
        "x_sample": jax.random.normal(ks[1], (DEC_BATCH, DEC_SEQ, D), f32),
        "pre_norm_g": gain(ks[2], (L, D)),
        "post_norm_g": gain(ks[3], (L, D)),
        "w_in": nrm(ks[4], (L, D, N_IN), D),
        "gate_b": small(ks[5], (L, N_BRANCH * D)),
        "q_norm_g": gain(ks[6], (L, Q_LORA)),
        "w_uq": nrm(ks[7], (L, Q_LORA, N_HEADS * QK_DIM), Q_LORA),
        "kv_norm_g": gain(ks[8], (L, KV_LORA)),
        "w_ukv": nrm(ks[9], (L, KV_LORA, N_HEADS * (QK_NOPE + V_HEAD)), KV_LORA),
        "pool_w": nrm(ks[10], (L, POOL_GROUPS, POOL_GROUP_DIM, POOL_GROUP_DIM), POOL_GROUP_DIM),
        "pool_scale": 1.0 + 0.1 * jax.random.normal(ks[11], (L, POOL_WIDTH), f32),
        "conv_w": nrm(ks[12], (L, CONV_K, CONV_WIDTH), CONV_K),
        "conv_b": small(ks[13], (L, CONV_WIDTH)),
        "conv_ln_g": gain(ks[14], (L, CONV_WIDTH)),
        "conv_ln_b": small(ks[15], (L, CONV_WIDTH)),
        "conv_pw_w": nrm(ks[16], (L, CONV_WIDTH, CONV_WIDTH), CONV_WIDTH),
        "conv_pw_b": small(ks[17], (L, CONV_WIDTH)),
        "fourier_w": nrm(ks[18], (L, FOURIER_WIDTH, FOURIER_WIDTH), FOURIER_WIDTH),
        "w_up_pool": nrm(ks[19], (L, POOL_WIDTH, D), POOL_WIDTH),
        "w_up_attn": nrm(ks[20], (L, ATTN_WIDTH, D), ATTN_WIDTH),
        "w_up_conv": nrm(ks[21], (L, CONV_WIDTH, D), CONV_WIDTH),
        "w_up_fourier": nrm(ks[22], (L, FOURIER_WIDTH, D), FOURIER_WIDTH),
        "w_out": nrm(ks[23], (L, D, D), D),
    }


def reference(x_prompt, x_sample, pre_norm_g, post_norm_g, w_in, gate_b, q_norm_g, w_uq, kv_norm_g, w_ukv,
              pool_w, pool_scale, conv_w, conv_b, conv_ln_g, conv_ln_b, conv_pw_w, conv_pw_b,
              fourier_w, w_up_pool, w_up_attn, w_up_conv, w_up_fourier, w_out):
    def trunk(x):
        for l in range(DEPTH):
            x = encoder_layer(x, pre_norm_g[l], post_norm_g[l], w_in[l], gate_b[l], q_norm_g[l], w_uq[l],
                              kv_norm_g[l], w_ukv[l], pool_w[l], pool_scale[l], conv_w[l], conv_b[l],
                              conv_ln_g[l], conv_ln_b[l], conv_pw_w[l], conv_pw_b[l], fourier_w[l],
                              w_up_pool[l], w_up_attn[l], w_up_conv[l], w_up_fourier[l], w_out[l])
        return x

    y_prompt = trunk(x_prompt)
    y_sample = trunk(x_sample)
    return (y_prompt, y_sample)
```

```cpp
#include <hip/hip_runtime.h>
#include <hip/hip_cooperative_groups.h>
#include <cstdio>
#include <cstdint>
namespace cg = cooperative_groups;

#ifndef PH4_ATT
#define PH4_ATT 1
#endif
#ifndef PH4_DFT
#define PH4_DFT 1
#endif
#ifndef PH4_CONV
#define PH4_CONV 1
#endif
#ifndef PH4_POOL
#define PH4_POOL 1
#endif
#ifndef DBL_PREP
#define DBL_PREP 0
#endif
#ifndef DBL_MASK
#define DBL_MASK 0
#endif
#ifndef DBG_ON
#define DBG_ON 0
#endif
#ifndef DBG_CH
#define DBG_CH 0
#endif
#ifndef MULTI_LAUNCH
#define MULTI_LAUNCH 0
#endif

#define DI __device__ __forceinline__
#define LAS __attribute__((address_space(3)))
typedef unsigned short bf16_t;
typedef short bf16x8 __attribute__((ext_vector_type(8)));
typedef short s16x4 __attribute__((ext_vector_type(4)));
typedef float f32x4 __attribute__((ext_vector_type(4)));
typedef float f32x2 __attribute__((ext_vector_type(2)));
typedef float f32x16 __attribute__((ext_vector_type(16)));
typedef unsigned u32x4 __attribute__((ext_vector_type(4)));
typedef unsigned u32x2 __attribute__((ext_vector_type(2)));

constexpr int DM = 1024, SEQ = 4096, NLAYER = 2, NIN = 6816;
constexpr int MC = 16384, NCHUNK = 5, CSEQ = 4;
constexpr int NZ = 3072;
constexpr int ZC_GLU = 768, ZC_G = 1792, ZC_GATTN = 2048, ZC_GCONV = 2560, ZC_GFOUR = 2816;
constexpr float NORM_EPS = 1e-6f, LN_EPS = 1e-5f;
constexpr float ATT_SCALE = 0.10206207261596575f;
constexpr int LDS_BYTES = 147456;
constexpr int NTHREADS = 512, NWAVES = 8;

constexpr size_t MiB = 1u << 20;
constexpr size_t WS_ROPE = 0;
constexpr size_t WS_MAB = 1 * MiB;
constexpr size_t WS_W = 2 * MiB, LW = 20 * MiB;
constexpr size_t W_IN = 0, W_G = 6 * MiB, W_UQ = 14 * MiB, W_UKV = 14 * MiB + 512 * 1024, W_UP = 15 * MiB, W_OUT = 17 * MiB + 512 * 1024, W_PW = 19 * MiB + 512 * 1024;
constexpr size_t WS_DFT = 42 * MiB;
constexpr size_t WS_H = 74 * MiB, WS_Z = 106 * MiB, WS_CQN = 202 * MiB, WS_CKVN = 210 * MiB, WS_KROPE = 218 * MiB;
constexpr size_t WS_Q = 219 * MiB, WS_KN = 243 * MiB, WS_V = 259 * MiB, WS_ABT = 275 * MiB, WS_P = 291 * MiB, WS_CB = 323 * MiB;
constexpr size_t WS_U = 331 * MiB, WS_M = 459 * MiB, WS_OB = 491 * MiB, WS_END = 523 * MiB;

struct Params {
    const float* in[24];
    float* out;
    unsigned char* ws;
    float inv_freq[16];
    int step_lo, step_hi;
};

DI unsigned cvt_pk(float lo, float hi) { unsigned r; asm volatile("v_cvt_pk_bf16_f32 %0, %1, %2" : "=v"(r) : "v"(lo), "v"(hi)); return r; }
DI bf16_t f2bf(float f) { unsigned u = __builtin_bit_cast(unsigned, f); return (bf16_t)((u + 0x7fffu + ((u >> 16) & 1u)) >> 16); }
DI float bf2f(bf16_t b) { return __builtin_bit_cast(float, (unsigned)b << 16); }
DI float bflo(unsigned w) { return __builtin_bit_cast(float, w << 16); }
DI float bfhi(unsigned w) { return __builtin_bit_cast(float, w & 0xffff0000u); }
DI float sigmoidf_(float x) { return __builtin_amdgcn_rcpf(1.f + __builtin_amdgcn_exp2f(-1.4426950408889634f * x)); }
DI float siluf_(float x) { return x * sigmoidf_(x); }
DI float wave_sum(float v, int lane) {
#pragma unroll
    for (int o = 1; o < 64; o <<= 1) v += __builtin_bit_cast(float, __builtin_amdgcn_ds_bpermute((lane ^ o) << 2, __builtin_bit_cast(int, v)));
    return v;
}
DI void store8(bf16_t* p, f32x4 v0, f32x4 v1) { u32x4 w; w.x = cvt_pk(v0[0], v0[1]); w.y = cvt_pk(v0[2], v0[3]); w.z = cvt_pk(v1[0], v1[1]); w.w = cvt_pk(v1[2], v1[3]); *(u32x4*)p = w; }
DI void load8(const bf16_t* p, f32x4& v0, f32x4& v1) { u32x4 w = *(const u32x4*)p; v0 = (f32x4){bflo(w.x), bfhi(w.x), bflo(w.y), bfhi(w.y)}; v1 = (f32x4){bflo(w.z), bfhi(w.z), bflo(w.w), bfhi(w.w)}; }

namespace pg8 {
constexpr int BM = 256, BK = 64, HALF = 128, HTB = HALF * BK * 2, STAGE_BYTES = 8 * HTB;
DI int lds_byte(int r, int c) { const int st = (r >> 4) * 2 + (c >> 5), rr = r & 15, cc = c & 31, ob = rr * 64 + cc * 2; return st * 1024 + (ob ^ (((ob >> 9) & 1) << 5)); }
DI void stage_rc(int b, int& R, int& C) { const int st = b / 1024, sb = b % 1024, swz = sb ^ (((sb >> 9) & 1) << 5); R = (st >> 1) * 16 + swz / 64; C = (st & 1) * 32 + (swz % 64) / 2; }
DI int perm32(int rho) { const int n = rho >> 4, i = rho & 15; return 8 * (i >> 2) + 4 * n + (i & 3); }

struct Unit { const char* A; const char* B; int nt; int pm; int pn; int tag; };

template <class Epi, class Sched>
DI void gemm_phase(LAS unsigned char* lds, const int tid, const int lda, const int ldb, const Sched& S, const Epi& E) {
    const int  wid = __builtin_amdgcn_readfirstlane(tid >> 6), lane = tid & 63, wr = wid >> 2, wc = wid & 3, fr = lane & 15, fq = lane >> 4;
    unsigned voffA[2], voffB[2];
#pragma unroll
    for (int i = 0; i < 2; ++i) { int R, C; stage_rc(tid * 16 + i * 8192, R, C); const int Rb = (R & ~31) + perm32(R & 31);
        voffA[i] = (unsigned)(R * lda + C) * 2u; voffB[i] = (unsigned)(Rb * ldb + C) * 2u; }
    const int kstep = BK * 2;
    const int hstepA = HALF * lda * 2, hstepB = HALF * ldb * 2;
    const unsigned ldsw = (unsigned)wid * 1024u;
    const int aoff = lds_byte(wr * 64 + fr, fq * 8), boff = lds_byte(wc * 32 + fr, fq * 8);
#define PG8_SA(b, h) (((b) * 2 + (h)) * HTB)
#define PG8_SB(b, h) ((4 + (b) * 2 + (h)) * HTB)
#define PG8_STAGE(bufoff, gbase, voff, soff) do { const __amdgpu_buffer_rsrc_t _rs = __builtin_amdgcn_make_buffer_rsrc((void*)(gbase), (short)0, (int)0x7fffffff, (int)0x00020000); _Pragma("unroll") for (int _i = 0; _i < 2; ++_i) \
        __builtin_amdgcn_raw_ptr_buffer_load_lds(_rs, (LAS void*)(lds + (bufoff) + ldsw + _i * 8192), 16, (int)(voff)[_i], (int)(soff), 0, 0); } while (0)
#define PG8_LDA(dst, b, h) do { _Pragma("unroll") for (int m = 0; m < 4; ++m) _Pragma("unroll") for (int k = 0; k < 2; ++k) dst[m][k] = *(const LAS bf16x8*)(lds + PG8_SA(b, h) + aoff + m * 2048 + k * 1024); } while (0)
#define PG8_LDB(dst, b, h) do { _Pragma("unroll") for (int n = 0; n < 2; ++n) _Pragma("unroll") for (int k = 0; k < 2; ++k) dst[n][k] = *(const LAS bf16x8*)(lds + PG8_SB(b, h) + boff + n * 2048 + k * 1024); } while (0)
#define PG8_MMA(ai, bj, At, Bt) do { __builtin_amdgcn_s_setprio(1); _Pragma("unroll") for (int m = 0; m < 4; ++m) _Pragma("unroll") for (int n = 0; n < 2; ++n) _Pragma("unroll") for (int k = 0; k < 2; ++k) \
        acc[ai][bj][m][n] = __builtin_amdgcn_mfma_f32_16x16x32_bf16(Bt[n][k], At[m][k], acc[ai][bj][m][n], 0, 0, 0); __builtin_amdgcn_s_setprio(0); } while (0)
#define PG8_WAIT_V(n) asm volatile("s_waitcnt vmcnt(" #n ")" ::: "memory")
#define PG8_WAIT_L(n) asm volatile("s_waitcnt lgkmcnt(" #n ")" ::: "memory")
#define PG8_BAR __builtin_amdgcn_s_barrier()
#define PG8_SCHED __builtin_amdgcn_sched_barrier(0)
    Unit cur, nxt; int ui = 0;
    if (!S.next(0, cur)) return;
    f32x4 acc[2][2][4][2];
#pragma unroll
    for (int a = 0; a < 2; ++a)
#pragma unroll
        for (int b = 0; b < 2; ++b)
#pragma unroll
            for (int m = 0; m < 4; ++m)
#pragma unroll
                for (int n = 0; n < 2; ++n) acc[a][b][m][n] = (f32x4){0.f, 0.f, 0.f, 0.f};
    bf16x8 At[4][2], B0[2][2], B1[2][2];
    const char* cA = cur.A; const char* cB = cur.B;
    PG8_STAGE(PG8_SB(0, 0), cB, voffB, 0); PG8_STAGE(PG8_SB(0, 1), cB, voffB, hstepB); PG8_STAGE(PG8_SA(0, 0), cA, voffA, 0); PG8_STAGE(PG8_SA(0, 1), cA, voffA, hstepA);
    if (wr == 1) PG8_BAR;
    PG8_WAIT_V(2); PG8_BAR;
    PG8_STAGE(PG8_SB(1, 0), cB, voffB, kstep); PG8_STAGE(PG8_SA(1, 0), cA, voffA, kstep); PG8_STAGE(PG8_SB(1, 1), cB, voffB, hstepB + kstep);
    PG8_WAIT_V(6); PG8_BAR;
    for (;;) {
        const bool has_next = S.next(ui + 1, nxt);
        const char* nA = has_next ? nxt.A : cA; const char* nB = has_next ? nxt.B : cB;
        const int nt = cur.nt;
        for (int t = 0; t < nt; t += 2) {
            const bool last = (t == nt - 2);
            const int o1 = (t + 1) * kstep;
            const char* a2 = last ? nA : cA; const char* b2 = last ? nB : cB; const int o2 = last ? 0 : (t + 2) * kstep, o3 = o2 + kstep;
            PG8_LDB(B0, 0, 0); PG8_LDB(B1, 0, 1); PG8_SCHED; PG8_LDA(At, 0, 0); PG8_STAGE(PG8_SA(1, 1), cA, voffA, o1 + hstepA);
            PG8_WAIT_V(8); PG8_WAIT_L(0); PG8_BAR; PG8_MMA(0, 0, At, B0); PG8_MMA(0, 1, At, B1); PG8_BAR; PG8_SCHED;
            PG8_LDA(At, 0, 1); PG8_STAGE(PG8_SB(0, 0), b2, voffB, o2); PG8_STAGE(PG8_SB(0, 1), b2, voffB, o2 + hstepB); PG8_STAGE(PG8_SA(0, 0), a2, voffA, o2);
            PG8_WAIT_V(8); PG8_WAIT_L(0); PG8_BAR; PG8_MMA(1, 0, At, B0); PG8_MMA(1, 1, At, B1); PG8_BAR; PG8_SCHED;
            PG8_LDB(B0, 1, 0); PG8_LDB(B1, 1, 1); PG8_SCHED; PG8_LDA(At, 1, 0); PG8_STAGE(PG8_SA(0, 1), a2, voffA, o2 + hstepA);
            PG8_WAIT_V(8); PG8_WAIT_L(0); PG8_BAR; PG8_MMA(0, 0, At, B0); PG8_MMA(0, 1, At, B1); PG8_BAR; PG8_SCHED;
            PG8_LDA(At, 1, 1); PG8_STAGE(PG8_SB(1, 0), b2, voffB, o3); PG8_STAGE(PG8_SB(1, 1), b2, voffB, o3 + hstepB); PG8_STAGE(PG8_SA(1, 0), a2, voffA, o3);
            PG8_WAIT_V(8); PG8_WAIT_L(0); PG8_BAR; PG8_MMA(1, 0, At, B0); PG8_MMA(1, 1, At, B1); PG8_BAR; PG8_SCHED;
        }
        if (wr == 0) PG8_BAR;
        E(acc, cur, wr, wc, fr, fq);
        if (!has_next) break;
#pragma unroll
        for (int a = 0; a < 2; ++a)
#pragma unroll
            for (int b = 0; b < 2; ++b)
#pragma unroll
                for (int m = 0; m < 4; ++m)
#pragma unroll
                    for (int n = 0; n < 2; ++n) acc[a][b][m][n] = (f32x4){0.f, 0.f, 0.f, 0.f};
        cur = nxt; cA = nA; cB = nB; ++ui;
        if (wr == 1) PG8_BAR;
    }
    PG8_WAIT_V(0);
    PG8_BAR;
#undef PG8_SA
#undef PG8_SB
#undef PG8_STAGE
#undef PG8_LDA
#undef PG8_LDB
#undef PG8_MMA
#undef PG8_WAIT_V
#undef PG8_WAIT_L
#undef PG8_BAR
#undef PG8_SCHED
}
}
using pg8::Unit;
typedef f32x4 Acc[2][2][4][2];

DI bool tile_of(int i, int G, int c, int npn, int& pm, int& pn, int ioff = 0) {
    if ((G & 7) == 0) { const int per = G >> 3, x = c & 7, idx = c >> 3, q = i * per + idx - ioff; if (q < 0 || q >= 8 * npn) return false; pm = 8 * x + (q & 7); pn = q >> 3; return true; }
    const int L = i * G + c; if (L >= 64 * npn) return false; pm = L & 63; pn = L >> 6; return true;
}

struct SchedSimple {
    const char* A; const char* B; int lda, ldb, nt, npn, G, c, ioff;
    DI bool next(int i, Unit& u) const { int pm, pn; if (!tile_of(i, G, c, npn, pm, pn, ioff)) return false;
        u.A = A + (size_t)pm * 256 * lda * 2; u.B = B + (size_t)pn * 256 * ldb * 2; u.nt = nt; u.pm = pm; u.pn = pn; u.tag = 0; return true; }
};
struct SchedQKV {
    const char* Aq; const char* Akv; const char* Bq; const char* Bkv; int G, c;
    DI bool next(int i, Unit& u) const { int pm, pn; if (!tile_of(i, G, c, 7, pm, pn)) return false;
        const bool isq = pn < 3; u.A = (isq ? Aq : Akv) + (size_t)pm * 256 * 256 * 2; u.B = isq ? Bq + (size_t)pn * 256 * 256 * 2 : Bkv + (size_t)(pn - 3) * 256 * 256 * 2;
        u.nt = 4; u.pm = pm; u.pn = isq ? pn : pn - 3; u.tag = isq ? 0 : 1; return true; }
};
struct SchedUp {
    const char* Z; const char* W; int G, c;
    DI bool next(int i, Unit& u) const { const int L = i * G + c; if (L >= 1024) return false; const int br = L >> 8, r = L & 255;
        const int x = r & 7, idx = r >> 3, pm = 8 * x + (idx & 7), pn = idx >> 3;
        const int koff = br == 0 ? 0 : (br == 1 ? 256 : (br == 2 ? 768 : 1024));
        u.A = Z + ((size_t)pm * 256 * NZ + ZC_G + koff) * 2; u.B = W + ((size_t)pn * 256 * 1280 + koff) * 2; u.nt = br == 1 ? 8 : 4; u.pm = pm; u.pn = br * 4 + pn; u.tag = br; return true; }
};
struct SchedGate {
    const char* H; const char* W; int G, c;
    DI bool next(int i, Unit& u) const { const int P = (i >> 2) * G + c; if (P >= 256) return false; const int b = i & 3;
        const int x = P & 7, idx = P >> 3, pm = 8 * x + (idx & 7), pc = idx >> 3;
        u.A = H + (size_t)pm * 256 * 1024 * 2; u.B = W + (size_t)(b * 4 + pc) * 256 * 1024 * 2; u.nt = 16; u.pm = pm; u.pn = b * 4 + pc; u.tag = b; return true; }
};
struct SchedDft {
    const char* T; const char* AB; int G, c;
    DI bool next(int i, Unit& u) const { const int L = i * G + c; if (L >= 256) return false; const int j = L & 7, r = L >> 3, b = r >> 3, kt = r & 7;
        u.A = T + ((size_t)j * 2048 + kt * 256) * 1024 * 2; u.B = AB + (size_t)(b * 8 + j) * 256 * 1024 * 2; u.nt = 16; u.pm = kt; u.pn = 0; u.tag = b * 8 + j; return true; }
};

#define EPI_LOOP_ROWS for (int ai = 0; ai < 2; ++ai) for (int m = 0; m < 4; ++m)
struct EpiIn {
    bf16_t* z; bf16_t* abt;
    DI void operator()(const Acc& acc, const Unit& u, int wr, int wc, int fr, int fq) const {
        const int row0 = u.pm * 256 + wr * 64 + fr, pn = u.pn, cb = wc * 32 + 8 * fq;
        if (pn <= 2 || pn >= 7) {
#pragma unroll
            EPI_LOOP_ROWS { bf16_t* rp = z + (size_t)(row0 + ai * 128 + m * 16) * NZ + pn * 256 + cb;
#pragma unroll
                for (int bj = 0; bj < 2; ++bj) { f32x4 v0 = acc[ai][bj][m][0], v1 = acc[ai][bj][m][1];
                    if (pn >= 7) {
#pragma unroll
                        for (int e = 0; e < 4; ++e) { v0[e] = siluf_(v0[e]); v1[e] = siluf_(v1[e]); } }
                    store8(rp + bj * 128, v0, v1); } __builtin_amdgcn_sched_barrier(0); }
        } else if (pn <= 4) {
#pragma unroll
            EPI_LOOP_ROWS { bf16_t* rp = z + (size_t)(row0 + ai * 128 + m * 16) * NZ + ZC_GLU + (pn - 3) * 128 + cb;
                f32x4 v0, v1;
#pragma unroll
                for (int e = 0; e < 4; ++e) { v0[e] = acc[ai][0][m][0][e] * sigmoidf_(acc[ai][1][m][0][e]); v1[e] = acc[ai][0][m][1][e] * sigmoidf_(acc[ai][1][m][1][e]); }
                store8(rp, v0, v1); __builtin_amdgcn_sched_barrier(0); }
        } else {
            const int koff = pn == 6 ? 512 : 0;
#pragma unroll
            EPI_LOOP_ROWS { const int row = row0 + ai * 128 + m * 16, b = row >> 12, s = row & 4095;
                const int j = (s & 1) + 2 * (s >> 10), kidx = ((s >> 1) & 511) + koff;
                bf16_t* bp = abt + ((size_t)(b * 8 + j) * 256 + cb) * 1024 + kidx;
#pragma unroll
                for (int bj = 0; bj < 2; ++bj)
#pragma unroll
                    for (int n = 0; n < 2; ++n)
#pragma unroll
                        for (int e = 0; e < 4; ++e) bp[(size_t)(bj * 128 + n * 4 + e) * 1024] = f2bf(acc[ai][bj][m][n][e]); __builtin_amdgcn_sched_barrier(0); }
        }
    }
};
struct EpiQKV {
    bf16_t* q; bf16_t* kn; bf16_t* v;
    DI void operator()(const Acc& acc, const Unit& u, int wr, int wc, int fr, int fq) const {
        const int row0 = u.pm * 256 + wr * 64 + fr;
#pragma unroll
        for (int bj = 0; bj < 2; ++bj) { const int c0 = u.pn * 256 + bj * 128 + wc * 32 + 8 * fq; bf16_t* base; int rstride;
            if (u.tag == 0) { const int h = c0 / 96, d = c0 - 96 * h; base = q + (size_t)h * 4096 * 96 + d; rstride = 96; }
            else { const int h = c0 >> 7, w = c0 & 127; base = (w < 64 ? kn : v) + (size_t)h * 4096 * 64 + (w & 63); rstride = 64; }
#pragma unroll
            EPI_LOOP_ROWS { const int row = row0 + ai * 128 + m * 16; const int rr = row + (row >> 12) * 7 * 4096;
                store8(base + (size_t)rr * rstride, acc[ai][bj][m][0], acc[ai][bj][m][1]); __builtin_amdgcn_sched_barrier(0); } }
    }
};
struct EpiPlain {
    bf16_t* O; int ldc; int col0;
    DI void operator()(const Acc& acc, const Unit& u, int wr, int wc, int fr, int fq) const {
        const int row0 = u.pm * 256 + wr * 64 + fr;
#pragma unroll
        EPI_LOOP_ROWS { bf16_t* rp = O + (size_t)(row0 + ai * 128 + m * 16) * ldc + col0 + u.pn * 256 + wc * 32 + 8 * fq;
#pragma unroll
            for (int bj = 0; bj < 2; ++bj) store8(rp + bj * 128, acc[ai][bj][m][0], acc[ai][bj][m][1]); __builtin_amdgcn_sched_barrier(0); }
    }
};
struct EpiDft {
    bf16_t* P;
    DI void operator()(const Acc& acc, const Unit& u, int wr, int wc, int fr, int fq) const {
        const int row0 = u.pm * 256 + wr * 64 + fr;
#pragma unroll
        EPI_LOOP_ROWS { bf16_t* rp = P + ((size_t)u.tag * 2048 + row0 + ai * 128 + m * 16) * 256 + wc * 32 + 8 * fq;
#pragma unroll
            for (int bj = 0; bj < 2; ++bj) store8(rp + bj * 128, acc[ai][bj][m][0], acc[ai][bj][m][1]); __builtin_amdgcn_sched_barrier(0); }
    }
};
struct EpiPw {
    bf16_t* z; const float* pwb;
    DI void operator()(const Acc& acc, const Unit& u, int wr, int wc, int fr, int fq) const {
        const int row0 = u.pm * 256 + wr * 64 + fr;
#pragma unroll
        for (int bj = 0; bj < 2; ++bj) { const int c0 = bj * 128 + wc * 32 + 8 * fq; const f32x4 b0 = *(const f32x4*)(pwb + c0), b1 = *(const f32x4*)(pwb + c0 + 4);
            u32x4 gg[8];
#pragma unroll
            for (int r8 = 0; r8 < 8; ++r8) gg[r8] = *(const u32x4*)(z + (size_t)(row0 + (r8 >> 2) * 128 + (r8 & 3) * 16) * NZ + ZC_GCONV + c0);
            __builtin_amdgcn_sched_barrier(0);
#pragma unroll
            for (int r8 = 0; r8 < 8; ++r8) { const int ai = r8 >> 2, m = r8 & 3; const u32x4 w = gg[r8];
                const f32x4 g0 = {bflo(w.x), bfhi(w.x), bflo(w.y), bfhi(w.y)}, g1 = {bflo(w.z), bfhi(w.z), bflo(w.w), bfhi(w.w)};
                store8(z + (size_t)(row0 + ai * 128 + m * 16) * NZ + ZC_GCONV + c0, (acc[ai][bj][m][0] + b0) * g0, (acc[ai][bj][m][1] + b1) * g1); }
            __builtin_amdgcn_sched_barrier(0); }
    }
};
struct EpiGate {
    const bf16_t* U; bf16_t* mbuf; const float* gb;
    DI void operator()(const Acc& acc, const Unit& u, int wr, int wc, int fr, int fq) const {
        const int row0 = u.pm * 256 + wr * 64 + fr, br = u.tag;
        const int cgb = u.pn * 256 + wc * 32 + 8 * fq;
        u32x4 uA[2], pA[2], uB[2], pB[2];
#define GATE_LOAD(UU, PP, K) do { const int bj_ = (K) >> 2, ai_ = ((K) >> 1) & 1, mh_ = (K) & 1; const int cg_ = cgb + bj_ * 128; _Pragma("unroll") for (int mm = 0; mm < 2; ++mm) { const size_t row = row0 + ai_ * 128 + (2 * mh_ + mm) * 16; \
            UU[mm] = *(const u32x4*)(U + row * 4096 + cg_); if (br != 0) PP[mm] = *(const u32x4*)(mbuf + row * 1024 + (cg_ & 1023)); else PP[mm] = (u32x4){0u, 0u, 0u, 0u}; } } while (0)
#define GATE_DO(UU, PP, K) do { const int bj_ = (K) >> 2, ai_ = ((K) >> 1) & 1, mh_ = (K) & 1; const int cg_ = cgb + bj_ * 128; const f32x4 b0 = *(const f32x4*)(gb + cg_), b1 = *(const f32x4*)(gb + cg_ + 4); \
        _Pragma("unroll") for (int mm = 0; mm < 2; ++mm) { const int m = 2 * mh_ + mm; const size_t row = row0 + ai_ * 128 + m * 16; const u32x4 w = UU[mm], q = PP[mm]; \
            const f32x4 u0 = {bflo(w.x), bfhi(w.x), bflo(w.y), bfhi(w.y)}, u1 = {bflo(w.z), bfhi(w.z), bflo(w.w), bfhi(w.w)}; \
            const f32x4 p0 = {bflo(q.x), bfhi(q.x), bflo(q.y), bfhi(q.y)}, p1 = {bflo(q.z), bfhi(q.z), bflo(q.w), bfhi(q.w)}; \
            f32x4 v0 = acc[ai_][bj_][m][0] + b0, v1 = acc[ai_][bj_][m][1] + b1; \
            _Pragma("unroll") for (int e = 0; e < 4; ++e) { v0[e] = sigmoidf_(v0[e]) * u0[e] + p0[e]; v1[e] = sigmoidf_(v1[e]) * u1[e] + p1[e]; } \
            store8(mbuf + row * 1024 + (cg_ & 1023), v0, v1); } } while (0)
#define SB __builtin_amdgcn_sched_barrier(0)
        GATE_LOAD(uA, pA, 0); SB;
        GATE_LOAD(uB, pB, 1); SB; GATE_DO(uA, pA, 0); SB;
        GATE_LOAD(uA, pA, 2); SB; GATE_DO(uB, pB, 1); SB;
        GATE_LOAD(uB, pB, 3); SB; GATE_DO(uA, pA, 2); SB;
        GATE_LOAD(uA, pA, 4); SB; GATE_DO(uB, pB, 3); SB;
        GATE_LOAD(uB, pB, 5); SB; GATE_DO(uA, pA, 4); SB;
        GATE_LOAD(uA, pA, 6); SB; GATE_DO(uB, pB, 5); SB;
        GATE_LOAD(uB, pB, 7); SB; GATE_DO(uA, pA, 6); SB;
        GATE_DO(uB, pB, 7); SB;
#undef SB
#undef GATE_LOAD
#undef GATE_DO
    }
};

struct SchedQKVPW {
    const char* Aq; const char* Akv; const char* Apw; const char* Bq; const char* Bkv; const char* Bpw; int G, c;
    DI bool next(int i, Unit& u) const { int pm, pn; if (!tile_of(i, G, c, 8, pm, pn)) return false;
        const int t = pn < 3 ? 0 : (pn < 7 ? 1 : 2); const int lp = t == 0 ? pn : (t == 1 ? pn - 3 : 0);
        u.A = (t == 0 ? Aq : (t == 1 ? Akv : Apw)) + (size_t)pm * 256 * 256 * 2; u.B = (t == 0 ? Bq : (t == 1 ? Bkv : Bpw)) + (size_t)lp * 256 * 256 * 2;
        u.nt = 4; u.pm = pm; u.pn = lp; u.tag = t; return true; }
};
struct EpiQKVPW {
    EpiQKV a; EpiPw b;
    DI void operator()(const Acc& acc, const Unit& u, int wr, int wc, int fr, int fq) const { if (u.tag == 2) b(acc, u, wr, wc, fr, fq); else a(acc, u, wr, wc, fr, fq); }
};

namespace att {
constexpr int KROWB = 208, SHM_K = 64 * KROWB, SHM_V = 8192;
constexpr int NBUF = 3, OFF_V = 0, OFF_K = NBUF * SHM_V, OFF_WS = OFF_K + NBUF * SHM_K;
constexpr float THR = 8.f;
#define SBAR() __builtin_amdgcn_sched_barrier(0)
DI int crow(int r, int hi) { return (r & 3) + 8 * (r >> 2) + 4 * hi; }
DI void partialSM(f32x16& p0, f32x16& p1, float& m_reg, float& mn, float& alpha) {
    constexpr float C = ATT_SCALE * 1.4426950408889634f;
    float pmax = p0[0];
#pragma unroll
    for (int r = 1; r < 16; ++r) pmax = fmaxf(pmax, p0[r]);
#pragma unroll
    for (int r = 0; r < 16; ++r) pmax = fmaxf(pmax, p1[r]);
    { auto rr = __builtin_amdgcn_permlane32_swap(__float_as_uint(pmax), __float_as_uint(pmax), false, false);
      pmax = fmaxf(__uint_as_float(rr[0]), __uint_as_float(rr[1])); }
    if (__builtin_expect(__all(pmax - m_reg <= THR / ATT_SCALE), 1)) { mn = m_reg; alpha = 1.f; }
    else { mn = fmaxf(m_reg, pmax); alpha = __builtin_amdgcn_exp2f((m_reg - mn) * C); m_reg = mn; }
    const float mnC = -mn * C;
#pragma unroll
    for (int r = 0; r < 16; ++r) p0[r] = fmaf(p0[r], C, mnC);
#pragma unroll
    for (int r = 0; r < 16; ++r) p1[r] = fmaf(p1[r], C, mnC);
#pragma unroll
    for (int r = 0; r < 16; ++r) p0[r] = __builtin_amdgcn_exp2f(p0[r]);
}
DI void finishSM(f32x16& p0, f32x16& p1, float alpha, float& l_reg, bf16x8& pa0, bf16x8& pa1, bf16x8& pa2, bf16x8& pa3) {
#pragma unroll
    for (int r = 0; r < 16; ++r) p1[r] = __builtin_amdgcn_exp2f(p1[r]);
    float ps = 0;
#pragma unroll
    for (int r = 0; r < 16; ++r) ps += p0[r];
#pragma unroll
    for (int r = 0; r < 16; ++r) ps += p1[r];
    { auto rr = __builtin_amdgcn_permlane32_swap(__float_as_uint(ps), __float_as_uint(ps), false, false);
      ps = __uint_as_float(rr[0]) + __uint_as_float(rr[1]); }
    l_reg = l_reg * alpha + ps;
#define PK4(P, BASE, OUT) do { unsigned a0 = cvt_pk(P[BASE + 0], P[BASE + 1]), a1 = cvt_pk(P[BASE + 2], P[BASE + 3]);   \
    unsigned b0 = cvt_pk(P[BASE + 4], P[BASE + 5]), b1 = cvt_pk(P[BASE + 6], P[BASE + 7]);                              \
    auto r0 = __builtin_amdgcn_permlane32_swap(a0, b0, false, false); auto r1 = __builtin_amdgcn_permlane32_swap(a1, b1, false, false); \
    u32x4 w = {r0[0], r1[0], r0[1], r1[1]}; OUT = __builtin_bit_cast(bf16x8, w); } while (0)
    PK4(p0, 0, pa0); PK4(p0, 8, pa1); PK4(p1, 0, pa2); PK4(p1, 8, pa3);
#undef PK4
}
DI void qkt(f32x16& p0, f32x16& p1, const char* Ks, const bf16x8* qr, int r32, int hi) {
#pragma unroll
    for (int r = 0; r < 16; ++r) { p0[r] = 0.f; p1[r] = 0.f; }
    const char* k0p = Ks + r32 * KROWB + hi * 16; const char* k1p = k0p + 32 * KROWB;
    bf16x8 b0 = *reinterpret_cast<const bf16x8*>(k0p), b1 = *reinterpret_cast<const bf16x8*>(k1p);
#pragma unroll
    for (int d0 = 0; d0 < 6; ++d0) {
        bf16x8 n0 = b0, n1 = b1;
        if (d0 < 5) { n0 = *reinterpret_cast<const bf16x8*>(k0p + (d0 + 1) * 32); n1 = *reinterpret_cast<const bf16x8*>(k1p + (d0 + 1) * 32); }
        p0 = __builtin_amdgcn_mfma_f32_32x32x16_bf16(b0, qr[d0], p0, 0, 0, 0);
        p1 = __builtin_amdgcn_mfma_f32_32x32x16_bf16(b1, qr[d0], p1, 0, 0, 0);
        b0 = n0; b1 = n1; }
}
DI int v_st(int k, int c) { const int kk = (k & ~0xC) | ((k & 4) << 1) | ((k & 8) >> 1); return ((kk >> 3) * 2 + (c >> 5)) * 512 + ((kk & 7) * 32 + (c & 31)) * 2; }
DI int v_rd_base(int lane) { return ((lane & 3) << 3) | (((lane >> 2) & 3) << 6) | (((lane >> 4) & 1) << 5) | (((lane >> 5) & 1) << 8); }
constexpr int v_rd_off(int d0, int ks, int half) { return d0 * 512 + ks * 2048 + half * 1024; }
template <int OFF> DI s16x4 tr_read(int vb) { s16x4 r; asm volatile("ds_read_b64_tr_b16 %0, %1 offset:%2" : "=&v"(r) : "v"(vb), "i"(OFF) : "memory"); return r; }
template <int D0> DI void pv_one(f32x16& od, int vb, bf16x8 pa0, bf16x8 pa1, bf16x8 pa2, bf16x8 pa3) {
    const s16x4 l0 = tr_read<v_rd_off(D0, 0, 0)>(vb), h0 = tr_read<v_rd_off(D0, 0, 1)>(vb), l1 = tr_read<v_rd_off(D0, 1, 0)>(vb), h1 = tr_read<v_rd_off(D0, 1, 1)>(vb);
    const s16x4 l2 = tr_read<v_rd_off(D0, 2, 0)>(vb), h2 = tr_read<v_rd_off(D0, 2, 1)>(vb), l3 = tr_read<v_rd_off(D0, 3, 0)>(vb), h3 = tr_read<v_rd_off(D0, 3, 1)>(vb);
    asm volatile("s_waitcnt lgkmcnt(0)" ::: "memory"); SBAR();
#define PK(L, H) (bf16x8){L[0], L[1], L[2], L[3], H[0], H[1], H[2], H[3]}
    od = __builtin_amdgcn_mfma_f32_32x32x16_bf16(pa0, PK(l0, h0), od, 0, 0, 0);
    od = __builtin_amdgcn_mfma_f32_32x32x16_bf16(pa1, PK(l1, h1), od, 0, 0, 0);
    od = __builtin_amdgcn_mfma_f32_32x32x16_bf16(pa2, PK(l2, h2), od, 0, 0, 0);
    od = __builtin_amdgcn_mfma_f32_32x32x16_bf16(pa3, PK(l3, h3), od, 0, 0, 0);
#undef PK
}
DI void pv_d0(f32x16* o, int vb, bf16x8 pa0, bf16x8 pa1, bf16x8 pa2, bf16x8 pa3) { pv_one<0>(o[0], vb, pa0, pa1, pa2, pa3); pv_one<1>(o[1], vb, pa0, pa1, pa2, pa3); }

DI void attn_unit(const bf16_t* __restrict__ Qb, const bf16_t* __restrict__ Kn, const bf16_t* __restrict__ Kr, const bf16_t* __restrict__ Vh,
                  const bf16_t* Zg, bf16_t* Zo, const float* __restrict__ ropec, const float* __restrict__ ropes, int pos0, char* lds, const int tid) {
    const int wid = tid >> 6, lane = tid & 63, r32 = lane & 31, hi = lane >> 5;
    char* V_lds = lds + OFF_V; char* K_lds = lds + OFF_K;
    float* ws = (float*)(lds + OFF_WS) + wid * 64; float* li_l = ws; float* al_l = ws + 32;
    float m_reg = -1e30f, l_reg = 0; f32x16 o[2];
#pragma unroll
    for (int r = 0; r < 16; ++r) { o[0][r] = 0.f; o[1][r] = 0.f; }
    bf16x8 qr[6];
    { const bf16_t* Qw = Qb + (size_t)(wid * 32 + r32) * 96 + hi * 8;
#pragma unroll
      for (int d0 = 0; d0 < 6; ++d0) qr[d0] = *reinterpret_cast<const bf16x8*>(Qw + d0 * 16);
      const int pos = pos0 + wid * 32 + r32;
      const f32x4 c0 = *(const f32x4*)(ropec + pos * 16 + hi * 8), c1 = *(const f32x4*)(ropec + pos * 16 + hi * 8 + 4);
      const f32x4 s0 = *(const f32x4*)(ropes + pos * 16 + hi * 8), s1 = *(const f32x4*)(ropes + pos * 16 + hi * 8 + 4);
      float x1[8], x2[8], cs[8], sn[8];
#pragma unroll
      for (int j = 0; j < 8; ++j) { x1[j] = bf2f((bf16_t)qr[4][j]); x2[j] = bf2f((bf16_t)qr[5][j]); cs[j] = j < 4 ? c0[j & 3] : c1[j & 3]; sn[j] = j < 4 ? s0[j & 3] : s1[j & 3]; }
      u32x4 w1, w2;
      w1.x = cvt_pk(x1[0] * cs[0] - x2[0] * sn[0], x1[1] * cs[1] - x2[1] * sn[1]); w1.y = cvt_pk(x1[2] * cs[2] - x2[2] * sn[2], x1[3] * cs[3] - x2[3] * sn[3]);
      w1.z = cvt_pk(x1[4] * cs[4] - x2[4] * sn[4], x1[5] * cs[5] - x2[5] * sn[5]); w1.w = cvt_pk(x1[6] * cs[6] - x2[6] * sn[6], x1[7] * cs[7] - x2[7] * sn[7]);
      w2.x = cvt_pk(x2[0] * cs[0] + x1[0] * sn[0], x2[1] * cs[1] + x1[1] * sn[1]); w2.y = cvt_pk(x2[2] * cs[2] + x1[2] * sn[2], x2[3] * cs[3] + x1[3] * sn[3]);
      w2.z = cvt_pk(x2[4] * cs[4] + x1[4] * sn[4], x2[5] * cs[5] + x1[5] * sn[5]); w2.w = cvt_pk(x2[6] * cs[6] + x1[6] * sn[6], x2[7] * cs[7] + x1[7] * sn[7]);
      qr[4] = __builtin_bit_cast(bf16x8, w1); qr[5] = __builtin_bit_cast(bf16x8, w2); }
    const int ka_r = tid / 12, ka_c = tid - 12 * ka_r; const int kb_i = 512 + (tid & 255), kb_r = kb_i / 12, kb_c = kb_i - 12 * kb_r;
    const int dKr = (int)((const char*)Kr - (const char*)Kn);
    const int koa = ka_c < 8 ? (ka_r * 64 + ka_c * 8) * 2 : dKr + (ka_r * 32 + (ka_c - 8) * 8) * 2; const int ksa = ka_c < 8 ? 128 : 64;
    const int kob = kb_c < 8 ? (kb_r * 64 + kb_c * 8) * 2 : dKr + (kb_r * 32 + (kb_c - 8) * 8) * 2; const int ksb = kb_c < 8 ? 128 : 64;
    const int kda = ka_r * KROWB + ka_c * 16, kdb = kb_r * KROWB + kb_c * 16; const bool has_b = tid < 256;
    const int vr = tid >> 3, vc = (tid & 7) * 8; const int vo = (vr * 64 + vc) * 2; const int vd = v_st(vr, vc);
    const int vb0 = (int)(uintptr_t)V_lds + v_rd_base(lane);
    struct { bf16x8 ka, kb, vv; } sr_[2];
#define SLOAD(i, k0) do { sr_[i].ka = *reinterpret_cast<const bf16x8*>((const char*)Kn + (koa + (k0) * ksa)); sr_[i].kb = *reinterpret_cast<const bf16x8*>((const char*)Kn + (kob + (k0) * ksb)); \
    sr_[i].vv = *reinterpret_cast<const bf16x8*>((const char*)Vh + (vo + (k0) * 128)); } while (0)
#define SWRITE(b, i) do { *(bf16x8*)(V_lds + (b) * SHM_V + vd) = sr_[i].vv; *(bf16x8*)(K_lds + (b) * SHM_K + kda) = sr_[i].ka; \
    if (has_b) *(bf16x8*)(K_lds + (b) * SHM_K + kdb) = sr_[i].kb; } while (0)
#define SWAIT() asm volatile("s_waitcnt vmcnt(3)" ::: "memory")
#define RESC(a) do { if (__any((a) < 1.f)) { if (hi == 0) al_l[r32] = (a); asm volatile("s_waitcnt lgkmcnt(0)" ::: "memory"); \
    _Pragma("unroll") for (int d = 0; d < 2; ++d) _Pragma("unroll") for (int r = 0; r < 16; ++r) o[d][r] *= al_l[crow(r, hi)]; } } while (0)
    f32x16 pA0, pA1, pB0, pB1; float mnA, mnB, alA, alB; bf16x8 pa0, pa1, pa2, pa3; constexpr int NT = SEQ / 64;
    SLOAD(0, 0); asm volatile("s_waitcnt vmcnt(0)" ::: "memory"); SWRITE(0, 0); __syncthreads();
    qkt(pA0, pA1, K_lds, qr, r32, hi); partialSM(pA0, pA1, m_reg, mnA, alA);
    SLOAD(1, 64); SLOAD(0, 128);
    SWAIT(); SWRITE(1, 1); __syncthreads();
    int bc = 1;
    for (int j = 1; j + 1 < NT; j += 2) {
        const int bp = bc == 0 ? 2 : bc - 1, bn = bc == 2 ? 0 : bc + 1, bnn = bn == 2 ? 0 : bn + 1;
        SBAR(); qkt(pB0, pB1, K_lds + bc * SHM_K, qr, r32, hi);
        finishSM(pA0, pA1, alA, l_reg, pa0, pa1, pa2, pa3); SBAR();
        SLOAD(1, (j + 2) * 64); SBAR();
        pv_d0(o, vb0 + bp * SHM_V, pa0, pa1, pa2, pa3); partialSM(pB0, pB1, m_reg, mnB, alB);
        SWAIT(); SWRITE(bn, 0);
        RESC(alB); __syncthreads();
        SBAR(); qkt(pA0, pA1, K_lds + bn * SHM_K, qr, r32, hi);
        finishSM(pB0, pB1, alB, l_reg, pa0, pa1, pa2, pa3); SBAR();
        if (j + 3 < NT) SLOAD(0, (j + 3) * 64); SBAR();
        pv_d0(o, vb0 + bc * SHM_V, pa0, pa1, pa2, pa3); partialSM(pA0, pA1, m_reg, mnA, alA);
        SWAIT(); SWRITE(bnn, 1);
        RESC(alA); __syncthreads();
        bc = bnn;
    }
    { const int bp = bc == 0 ? 2 : bc - 1;
      SBAR(); qkt(pB0, pB1, K_lds + bc * SHM_K, qr, r32, hi);
      finishSM(pA0, pA1, alA, l_reg, pa0, pa1, pa2, pa3); SBAR();
      pv_d0(o, vb0 + bp * SHM_V, pa0, pa1, pa2, pa3); partialSM(pB0, pB1, m_reg, mnB, alB);
      RESC(alB);
      finishSM(pB0, pB1, alB, l_reg, pa0, pa1, pa2, pa3); SBAR();
      pv_d0(o, vb0 + bc * SHM_V, pa0, pa1, pa2, pa3); }
    if (hi == 0) li_l[r32] = l_reg; asm volatile("s_waitcnt lgkmcnt(0)" ::: "memory");
    bf16_t* Zw = Zo + (size_t)(wid * 32) * NZ; const bf16_t* Zgw = Zg + (size_t)(wid * 32) * NZ;
#pragma unroll
    for (int r = 0; r < 16; ++r) { const int orow = crow(r, hi); const float rl = __builtin_amdgcn_rcpf(li_l[orow]);
#pragma unroll
        for (int d0 = 0; d0 < 2; ++d0) { const size_t off = (size_t)orow * NZ + d0 * 32 + r32; Zw[off] = f2bf(o[d0][r] * rl * bf2f(Zgw[off])); } }
    __syncthreads();
#undef SLOAD
#undef SWRITE
#undef SWAIT
#undef RESC
}
}

struct Ctx {
    const Params* p; unsigned char* ws; char* lds; int G, c, tid, lane, wave, zero;
};

DI void job_transpose(const Ctx& X, const float* W, int ldw, int col0, int ncols, int K, int kvalid, bf16_t* dst, int ldd, int drow0, int dcol0, float scale) {
    const int k8n = K >> 3, total = ncols * k8n;
    for (int it = X.c * NTHREADS + X.tid; it < total; it += X.G * NTHREADS) {
        const int n = it % ncols, k8 = it / ncols; float v[8];
#pragma unroll
        for (int i = 0; i < 8; ++i) { const int k = k8 * 8 + i; v[i] = k < kvalid ? W[(size_t)k * ldw + col0 + n] * scale : 0.f; }
        u32x4 w; w.x = cvt_pk(v[0], v[1]); w.y = cvt_pk(v[2], v[3]); w.z = cvt_pk(v[4], v[5]); w.w = cvt_pk(v[6], v[7]);
        *(u32x4*)(dst + (size_t)(drow0 + n) * ldd + dcol0 + k8 * 8) = w;
    }
}
DI void job_zero_rows(const Ctx& X, bf16_t* dst, int ldd, int drow0, int nrows, int K) {
    const int k8n = K >> 3, total = nrows * k8n; unsigned zz = 0u; asm volatile("" : "+v"(zz));
    for (int it = X.c * NTHREADS + X.tid; it < total; it += X.G * NTHREADS) { const int n = it / k8n, k8 = it % k8n;
        *(u32x4*)(dst + (size_t)(drow0 + n) * ldd + k8 * 8) = (u32x4){zz, zz, zz, zz}; }
}

DI void prep1(const Ctx& X) {
    const Params& P = *X.p; unsigned char* ws = X.ws;
    const int gt = X.c * NTHREADS + X.tid, GT = X.G * NTHREADS;
    if (gt < 16) ((float*)(ws + 768 * 1024))[gt] = 0.f;
    { float* rc = (float*)(ws + WS_ROPE); float* rs = rc + 4096 * 16;
      for (int it = gt; it < 4096 * 16; it += GT) { const int pos = it >> 4, i = it & 15; const float ang = (float)pos * P.inv_freq[i];
          double rev = (double)ang * 0.15915494309189535; rev -= __builtin_rint(rev); const float rf = (float)rev;
          rc[it] = __builtin_amdgcn_cosf(rf); rs[it] = __builtin_amdgcn_sinf(rf); } }
    { bf16_t* T = (bf16_t*)(ws + WS_DFT);
      for (int it = gt; it < 8 * 2048 * 128; it += GT) { const int k8 = it & 127, ks = (it >> 7) & 2047, j = it >> 18; float v[8];
#pragma unroll
          for (int i = 0; i < 8; ++i) { const int kidx = k8 * 8 + i, kk = kidx & 511, s = 2 * ((j >> 1) * 512 + kk) + (j & 1);
              const float fr = (float)((ks * s) & 4095) * (1.f / 4096.f);
              v[i] = (kidx < 512 ? __builtin_amdgcn_cosf(fr) : -__builtin_amdgcn_sinf(fr)) * (1.f / 64.f); }
          u32x4 w; w.x = cvt_pk(v[0], v[1]); w.y = cvt_pk(v[2], v[3]); w.z = cvt_pk(v[4], v[5]); w.w = cvt_pk(v[6], v[7]);
          *(u32x4*)(T + (size_t)it * 8) = w; } }
    for (int l = 0; l < NLAYER; ++l) {
        unsigned char* wl = ws + WS_W + (size_t)l * LW;
        const float* w_in = P.in[4 + X.zero] + (size_t)l * DM * NIN;
        bf16_t* WinT = (bf16_t*)(wl + W_IN);
        job_transpose(X, w_in, NIN, 256, 256, DM, DM, WinT, DM, 256, 0, 1.f);
        job_transpose(X, w_in, NIN, 512, 160, DM, DM, WinT, DM, 512, 0, 1.f);
        job_zero_rows(X, WinT, DM, 672, 96, DM);
        job_transpose(X, w_in, NIN, 672, 128, DM, DM, WinT, DM, 768, 0, 1.f);
        job_transpose(X, w_in, NIN, 928, 128, DM, DM, WinT, DM, 896, 0, 1.f);
        job_transpose(X, w_in, NIN, 800, 128, DM, DM, WinT, DM, 1024, 0, 1.f);
        job_transpose(X, w_in, NIN, 1056, 128, DM, DM, WinT, DM, 1152, 0, 1.f);
        job_transpose(X, w_in, NIN, 1440, 1280, DM, DM, WinT, DM, 1792, 0, 1.f);
        job_transpose(X, w_in, NIN, 2720, 4096, DM, DM, (bf16_t*)(wl + W_G), DM, 0, 0, 1.f);
        job_transpose(X, P.in[7 + X.zero] + (size_t)l * 256 * 768, 768, 0, 768, 256, 256, (bf16_t*)(wl + W_UQ), 256, 0, 0, 1.f);
        job_transpose(X, P.in[9 + X.zero] + (size_t)l * 128 * 1024, 1024, 0, 1024, 256, 128, (bf16_t*)(wl + W_UKV), 256, 0, 0, 1.f);
        job_transpose(X, P.in[19 + X.zero] + (size_t)l * 256 * DM, DM, 0, DM, 256, 256, (bf16_t*)(wl + W_UP), 1280, 0, 0, 1.f);
        job_transpose(X, P.in[20 + X.zero] + (size_t)l * 512 * DM, DM, 0, DM, 512, 512, (bf16_t*)(wl + W_UP), 1280, 0, 256, 1.f);
        job_transpose(X, P.in[21 + X.zero] + (size_t)l * 256 * DM, DM, 0, DM, 256, 256, (bf16_t*)(wl + W_UP), 1280, 0, 768, 1.f);
        job_transpose(X, P.in[22 + X.zero] + (size_t)l * 256 * DM, DM, 0, DM, 256, 256, (bf16_t*)(wl + W_UP), 1280, 0, 1024, 1.f);
        job_transpose(X, P.in[23 + X.zero] + (size_t)l * DM * DM, DM, 0, DM, DM, DM, (bf16_t*)(wl + W_OUT), DM, 0, 0, 1.f);
        job_transpose(X, P.in[16 + X.zero] + (size_t)l * 256 * 256, 256, 0, 256, 256, 256, (bf16_t*)(wl + W_PW), 256, 0, 0, 1.f);
        { const float* pw = P.in[10 + X.zero] + (size_t)l * 4 * 64 * 64; const float* psc = P.in[11 + X.zero] + (size_t)l * 256;
          for (int it = gt; it < DM * 256; it += GT) { const int n = it & 255, k = it >> 8, g = n >> 6, d = n & 63; float a = 0.f;
              const float* wr_ = w_in + (size_t)k * NIN + g * 64; const float* pp = pw + g * 4096 + d;
#pragma unroll 8
              for (int cc = 0; cc < 64; ++cc) a = fmaf(wr_[cc], pp[cc * 64], a);
              WinT[(size_t)n * DM + k] = f2bf(a * psc[n]); } }
        { const float* wf = P.in[18 + X.zero] + (size_t)l * 256 * 256; float* MA = (float*)(ws + WS_MAB) + (size_t)l * 2 * 65536; float* MB = MA + 65536;
          for (int it = gt; it < 65536; it += GT) { const int d = it & 255, gc = it >> 8, g = gc >> 6, cch = gc & 63; float a = 0.f, b = 0.f;
              for (int kc = 0; kc < 64; ++kc) { const float fr = (float)((kc * cch) & 63) * (1.f / 64.f); const float w = wf[(size_t)(g * 64 + kc) * 256 + d];
                  a = fmaf(__builtin_amdgcn_cosf(fr), w, a); b = fmaf(__builtin_amdgcn_sinf(fr), w, b); }
              MA[it] = a; MB[it] = b; } }
    }
}
DI void prep2(const Ctx& X) {
    const Params& P = *X.p; unsigned char* ws = X.ws;
    const int gt = X.c * NTHREADS + X.tid, GT = X.G * NTHREADS;
    for (int l = 0; l < NLAYER; ++l) {
        const float* w_in = P.in[4 + X.zero] + (size_t)l * DM * NIN + 1184; bf16_t* WinT = (bf16_t*)(ws + WS_W + (size_t)l * LW + W_IN);
        const float* MA = (const float*)(ws + WS_MAB) + (size_t)l * 2 * 65536;
        for (int it = gt; it < DM * 512; it += GT) { const int n = it & 511, k = it >> 9; const float* Mx = MA + (n >> 8) * 65536 + (n & 255); const float* wr_ = w_in + (size_t)k * NIN; float a = 0.f;
#pragma unroll 8
            for (int gc = 0; gc < 256; ++gc) a = fmaf(wr_[gc], Mx[gc * 256], a);
            WinT[(size_t)(1280 + n) * DM + k] = f2bf(a * 0.125f); }
    }
}

DI void norm_pass(const Ctx& X, int ch, int l) {
    float NEPS = NORM_EPS; asm volatile("" : "+s"(NEPS));
    const Params& P = *X.p; const int lane = X.lane;
    const int gw = X.G == 256 ? (256 * (8 * (X.c & 7) + ((X.c >> 3) & 7)) + 64 * (X.c >> 6) + 8 * X.wave) : X.c * NWAVES + X.wave, NGW = X.G == 256 ? 1 : X.G * NWAVES;
    const int rend = X.G == 256 ? gw + 8 : MC;
    const float* xin = ch == 0 ? P.in[0 + X.zero] : P.in[1 + X.zero] + (size_t)(ch - 1) * MC * DM;
    float* xo = P.out + (size_t)ch * MC * DM;
    const bf16_t* ob = (const bf16_t*)(X.ws + WS_OB); bf16_t* hb = (bf16_t*)(X.ws + WS_H);
    for (int r = gw; r < rend; r += NGW) {
        const float* xr = (l == 0 ? xin : (l == 1 ? xin : xo)) + (size_t)r * DM;
        f32x4 v[4];
#pragma unroll
        for (int j = 0; j < 4; ++j) v[j] = *(const f32x4*)(xr + (lane + 64 * j) * 4);
        if (l >= 1) {
            const float* pg = P.in[3 + X.zero] + (size_t)(l - 1) * DM; f32x4 ov[4]; float ss = 0.f;
#pragma unroll
            for (int j = 0; j < 4; ++j) { const u32x2 w = *(const u32x2*)(ob + (size_t)r * DM + (lane + 64 * j) * 4); ov[j] = (f32x4){bflo(w.x), bfhi(w.x), bflo(w.y), bfhi(w.y)};
                ss += ov[j][0] * ov[j][0] + ov[j][1] * ov[j][1] + ov[j][2] * ov[j][2] + ov[j][3] * ov[j][3]; }
            const float rs = __builtin_amdgcn_rsqf(wave_sum(ss, lane) * (1.f / DM) + NEPS);
#pragma unroll
            for (int j = 0; j < 4; ++j) { const f32x4 g = *(const f32x4*)(pg + (lane + 64 * j) * 4); v[j] += ov[j] * rs * g; *(f32x4*)(xo + (size_t)r * DM + (lane + 64 * j) * 4) = v[j]; }
        }
        if (l <= 1) {
            const float* pg = P.in[2 + X.zero] + (size_t)l * DM; float ss = 0.f;
#pragma unroll
            for (int j = 0; j < 4; ++j) ss += v[j][0] * v[j][0] + v[j][1] * v[j][1] + v[j][2] * v[j][2] + v[j][3] * v[j][3];
            const float rs = __builtin_amdgcn_rsqf(wave_sum(ss, lane) * (1.f / DM) + NEPS);
#pragma unroll
            for (int j = 0; j < 4; ++j) { const f32x4 g = *(const f32x4*)(pg + (lane + 64 * j) * 4); const f32x4 hv = v[j] * rs * g;
                u32x2 w; w.x = cvt_pk(hv[0], hv[1]); w.y = cvt_pk(hv[2], hv[3]); *(u32x2*)(hb + (size_t)r * DM + (lane + 64 * j) * 4) = w; }
        }
    }
}

DI void s_pass(const Ctx& X, int l) {
    float NEPS = NORM_EPS; asm volatile("" : "+s"(NEPS));
    const Params& P = *X.p; const int gw = X.c * NWAVES + X.wave, NGW = X.G * NWAVES, lane = X.lane;
    const bf16_t* z = (const bf16_t*)(X.ws + WS_Z); bf16_t* cqn = (bf16_t*)(X.ws + WS_CQN); bf16_t* ckvn = (bf16_t*)(X.ws + WS_CKVN); bf16_t* kro = (bf16_t*)(X.ws + WS_KROPE);
    const float* qg = P.in[6 + X.zero] + (size_t)l * 256; const float* kg = P.in[8 + X.zero] + (size_t)l * 128;
    const float* rc = (const float*)(X.ws + WS_ROPE); const float* rs_ = rc + 4096 * 16;
    for (int r = gw; r < MC; r += NGW) {
        const bf16_t* zr = z + (size_t)r * NZ;
        { const u32x2 w = *(const u32x2*)(zr + 256 + lane * 4); f32x4 v = {bflo(w.x), bfhi(w.x), bflo(w.y), bfhi(w.y)};
          const float rs = __builtin_amdgcn_rsqf(wave_sum(v[0] * v[0] + v[1] * v[1] + v[2] * v[2] + v[3] * v[3], lane) * (1.f / 256.f) + NEPS);
          const f32x4 g = *(const f32x4*)(qg + lane * 4); v = v * rs * g; u32x2 o; o.x = cvt_pk(v[0], v[1]); o.y = cvt_pk(v[2], v[3]); *(u32x2*)(cqn + (size_t)r * 256 + lane * 4) = o; }
        { const unsigned w = *(const unsigned*)(zr + 512 + lane * 2); float a = bflo(w), b = bfhi(w);
          const float rs = __builtin_amdgcn_rsqf(wave_sum(a * a + b * b, lane) * (1.f / 128.f) + NEPS);
          const f32x2 g = *(const f32x2*)(kg + lane * 2); *(unsigned*)(ckvn + (size_t)r * 256 + lane * 2) = cvt_pk(a * rs * g[0], b * rs * g[1]);
          *(unsigned*)(ckvn + (size_t)r * 256 + 128 + lane * 2) = 0u; }
        if (lane < 16) { const int pos = r & 4095; const float x1 = bf2f(zr[640 + lane]), x2 = bf2f(zr[656 + lane]), cs = rc[pos * 16 + lane], sn = rs_[pos * 16 + lane];
          kro[(size_t)r * 32 + lane] = f2bf(x1 * cs - x2 * sn); kro[(size_t)r * 32 + 16 + lane] = f2bf(x2 * cs + x1 * sn); }
    }
}

DI void pool_pass(const Ctx& X, bf16_t* zo) {
    bf16_t* z = (bf16_t*)(X.ws + WS_Z);
    for (int e = X.c * NTHREADS + X.tid; e < MC * 32; e += X.G * NTHREADS) {
        const int t = e >> 5, cgp = e & 31, ch0 = cgp * 8, g = cgp >> 3, hw = 1 << g, s = t & 4095, tb = t - s;
        const int lo = max(s - hw, 0), hi = min(s + hw, SEQ);
        f32x4 a0 = {0.f, 0.f, 0.f, 0.f}, a1 = a0;
        for (int r = lo; r < hi; ++r) { f32x4 v0, v1; load8(z + (size_t)(tb + r) * NZ + ch0, v0, v1); a0 += v0; a1 += v1; }
        const float ic = 1.f / (float)(hi - lo); f32x4 u0, u1, g0, g1; load8(z + (size_t)t * NZ + ch0, u0, u1); load8(z + (size_t)t * NZ + ZC_G + ch0, g0, g1);
        store8(zo + (size_t)t * NZ + ZC_G + ch0, (a0 * ic - u0) * g0, (a1 * ic - u1) * g1);
    }
}

DI void dft_combine(const Ctx& X) {
    bf16_t* z = (bf16_t*)(X.ws + WS_Z); const bf16_t* Pp = (const bf16_t*)(X.ws + WS_P);
    for (int e = X.c * NTHREADS + X.tid; e < MC * 32; e += X.G * NTHREADS) {
        const int t = e >> 5, ch0 = (e & 31) * 8, b = t >> 12, s = t & 4095, ks = s & 2047; const float sg = s >= 2048 ? -1.f : 1.f;
        f32x4 a0 = {0.f, 0.f, 0.f, 0.f}, a1 = a0;
#pragma unroll
        for (int j = 0; j < 8; ++j) { f32x4 v0, v1; load8(Pp + ((size_t)(b * 8 + j) * 2048 + ks) * 256 + ch0, v0, v1); const float sj = (j & 1) ? sg : 1.f; a0 += v0 * sj; a1 += v1 * sj; }
        f32x4 g0, g1; bf16_t* zp = z + (size_t)t * NZ + ZC_GFOUR + ch0; load8(zp, g0, g1); store8(zp, a0 * g0, a1 * g1);
    }
}

DI void conv_item(const Ctx& X, int item, int l) {
    float LEPS = LN_EPS; asm volatile("" : "+s"(LEPS)); unsigned zz = 0u; asm volatile("" : "+v"(zz));
    const Params& P = *X.p; const int tid = X.tid;
    const bf16_t* z = (const bf16_t*)(X.ws + WS_Z); bf16_t* cb = (bf16_t*)(X.ws + WS_CB);
    char* gl = X.lds; float* co = (float*)(X.lds + 49152);
    const int t0 = item * 64, s0 = t0 & 4095, tb = t0 - s0;
    for (int i = tid; i < 94 * 32; i += NTHREADS) { const int r = i >> 5, c8 = i & 31, s = s0 - 15 + r; u32x4 w = {zz, zz, zz, zz};
        if (s >= 0 && s < SEQ) w = *(const u32x4*)(z + (size_t)(tb + s) * NZ + ZC_GLU + c8 * 8);
        *(u32x4*)(gl + r * 512 + c8 * 16) = w; }
    __syncthreads();
    { const int cp = tid & 127, tg = tid >> 7; const float* cw = P.in[12 + X.zero] + (size_t)l * 31 * 256 + 2 * cp; const f32x2 bias = *(const f32x2*)(P.in[13 + X.zero] + (size_t)l * 256 + 2 * cp);
      f32x2 w[31];
#pragma unroll
      for (int k = 0; k < 31; ++k) w[k] = *(const f32x2*)(cw + k * 256);
      f32x2 a[16];
#pragma unroll
      for (int i = 0; i < 16; ++i) a[i] = bias;
#pragma unroll
      for (int r = 0; r < 46; ++r) { const unsigned u = *(const unsigned*)(gl + (tg * 16 + r) * 512 + cp * 4); const f32x2 v = {bflo(u), bfhi(u)};
#pragma unroll
          for (int i = 0; i < 16; ++i) { if (r - i >= 0 && r - i <= 30) a[i] += v * w[r - i]; } }
#pragma unroll
      for (int i = 0; i < 16; ++i) *(f32x2*)(co + (tg * 16 + i) * 256 + 2 * cp) = a[i]; }
    __syncthreads();
    { const int wv = X.wave, lane = X.lane; const f32x4 g = *(const f32x4*)(P.in[14 + X.zero] + (size_t)l * 256 + lane * 4), be = *(const f32x4*)(P.in[15 + X.zero] + (size_t)l * 256 + lane * 4);
#pragma unroll
      for (int i = 0; i < 8; ++i) { const int tok = wv * 8 + i; f32x4 v = *(const f32x4*)(co + tok * 256 + lane * 4);
          const float mu = wave_sum(v[0] + v[1] + v[2] + v[3], lane) * (1.f / 256.f); v -= mu;
          const float rs = __builtin_amdgcn_rsqf(wave_sum(v[0] * v[0] + v[1] * v[1] + v[2] * v[2] + v[3] * v[3], lane) * (1.f / 256.f) + LEPS);
          v = v * rs * g + be;
#pragma unroll
          for (int e = 0; e < 4; ++e) v[e] = siluf_(v[e]);
          u32x2 o; o.x = cvt_pk(v[0], v[1]); o.y = cvt_pk(v[2], v[3]); *(u32x2*)(cb + (size_t)(t0 + tok) * 256 + lane * 4) = o; } }
    __syncthreads();
}


DI float dotbf(const bf16_t* a, const bf16_t* b, int K) { float s = 0.f; for (int k = 0; k < K; ++k) s = fmaf(bf2f(a[k]), bf2f(b[k]), s); return s; }
DI void dbg_max(float* w, float v) { atomicMax((int*)w, __builtin_bit_cast(int, fabsf(v))); }
DI void dbg_check(const Ctx& X, int l) {
    const Params& P = *X.p; unsigned char* ws = X.ws; unsigned char* wl = ws + WS_W + (size_t)l * LW;
    float* dbg = (float*)(ws + 768 * 1024);
    const bf16_t* h = (const bf16_t*)(ws + WS_H); const bf16_t* z = (const bf16_t*)(ws + WS_Z); const bf16_t* WinT = (const bf16_t*)(wl + W_IN);
    const bf16_t* abt = (const bf16_t*)(ws + WS_ABT); const bf16_t* T = (const bf16_t*)(ws + WS_DFT); const bf16_t* Pp = (const bf16_t*)(ws + WS_P);
    const bf16_t* U = (const bf16_t*)(ws + WS_U); const bf16_t* mb = (const bf16_t*)(ws + WS_M); const bf16_t* ob = (const bf16_t*)(ws + WS_OB);
    const bf16_t* WupT = (const bf16_t*)(wl + W_UP); const bf16_t* WgT = (const bf16_t*)(wl + W_G); const bf16_t* WoT = (const bf16_t*)(wl + W_OUT);
    const int i = X.c * NTHREADS + X.tid; if (i >= 32768) return;
    const unsigned hsh = (unsigned)i * 2654435761u; const int row = (hsh >> 7) % MC; const int cc = (hsh >> 3) & 1023;
    const bf16_t* hr = h + (size_t)row * DM;
    { const int col = cc % 672; dbg_max(dbg + 1, bf2f(z[(size_t)row * NZ + col]) - dotbf(hr, WinT + (size_t)col * DM, DM)); }
    { const int col = cc & 255, wr0 = 768 + (col >> 7) * 256 + (col & 127); const float a = dotbf(hr, WinT + (size_t)wr0 * DM, DM), b = dotbf(hr, WinT + (size_t)(wr0 + 128) * DM, DM);
      dbg_max(dbg + 2, bf2f(z[(size_t)row * NZ + ZC_GLU + col]) - a / (1.f + expf(-b))); }
    { const int ch = cc & 255, b = row >> 12, s = row & 4095, j = (s & 1) + 2 * (s >> 10), kidx = (s >> 1) & 511; const bf16_t* ap = abt + ((size_t)(b * 8 + j) * 256 + ch) * 1024;
      dbg_max(dbg + 3, bf2f(ap[kidx]) - dotbf(hr, WinT + (size_t)(1280 + ch) * DM, DM)); dbg_max(dbg + 3, bf2f(ap[512 + kidx]) - dotbf(hr, WinT + (size_t)(1536 + ch) * DM, DM)); }
    { const int ch = cc & 255, bj = (row >> 11) & 31, ks = row & 2047; dbg_max(dbg + 4, bf2f(Pp[((size_t)bj * 2048 + ks) * 256 + ch]) - dotbf(T + ((size_t)(bj & 7) * 2048 + ks) * 1024, abt + ((size_t)bj * 256 + ch) * 1024, 1024)); }
    { const int br = (hsh >> 1) & 3, koff = br == 0 ? 0 : (br == 1 ? 256 : (br == 2 ? 768 : 1024)), K = br == 1 ? 512 : 256;
      dbg_max(dbg + 5, bf2f(U[(size_t)row * 4096 + br * 1024 + cc]) - dotbf(z + (size_t)row * NZ + ZC_G + koff, WupT + (size_t)cc * 1280 + koff, K)); }
    { float acc = 0.f; for (int b = 0; b < 4; ++b) { const float g = dotbf(hr, WgT + (size_t)(b * 1024 + cc) * DM, DM) + P.in[5 + X.zero][(size_t)l * 4096 + b * 1024 + cc];
          acc += bf2f(U[(size_t)row * 4096 + b * 1024 + cc]) / (1.f + expf(-g)); }
      dbg_max(dbg + 6, bf2f(mb[(size_t)row * 1024 + cc]) - acc); }
    { dbg_max(dbg + 7, bf2f(ob[(size_t)row * 1024 + cc]) - dotbf(mb + (size_t)row * 1024, WoT + (size_t)cc * DM, DM)); }
    { const int col = cc & 255, g = col >> 6, hw = 1 << g, s = row & 4095, tb = row - s, lo = max(s - hw, 0), hi = min(s + hw, SEQ); float a = 0.f;
      for (int r = lo; r < hi; ++r) a += bf2f(z[(size_t)(tb + r) * NZ + col]);
      const float gg = dotbf(hr, WinT + (size_t)(1792 + col) * DM, DM), sg = gg / (1.f + expf(-gg));
      dbg_max(dbg + 8, bf2f(z[(size_t)row * NZ + ZC_G + col]) - (a / (float)(hi - lo) - bf2f(z[(size_t)row * NZ + col])) * sg); }
    { const bf16_t* cbp = (const bf16_t*)(ws + WS_CB); const int col = cc & 255, s = row & 4095, tb = row - s; float sum = 0.f, sq = 0.f, mine = 0.f;
      for (int ch = 0; ch < 256; ++ch) { float a = P.in[13 + X.zero][(size_t)l * 256 + ch];
          for (int k = 0; k < 31; ++k) { const int ss = s + k - 15; if (ss >= 0 && ss < SEQ) a = fmaf(bf2f(z[(size_t)(tb + ss) * NZ + ZC_GLU + ch]), P.in[12 + X.zero][((size_t)l * 31 + k) * 256 + ch], a); }
          sum += a; sq += a * a; if (ch == col) mine = a; }
      const float mu = sum / 256.f, var = sq / 256.f - mu * mu; float y = (mine - mu) / sqrtf(var + LN_EPS) * P.in[14 + X.zero][(size_t)l * 256 + col] + P.in[15 + X.zero][(size_t)l * 256 + col]; y = y / (1.f + expf(-y));
      dbg_max(dbg + 9, bf2f(cbp[(size_t)row * 256 + col]) - y);
      const float gg = dotbf(hr, WinT + (size_t)(2560 + col) * DM, DM), sg = gg / (1.f + expf(-gg));
      dbg_max(dbg + 10, bf2f(z[(size_t)row * NZ + ZC_GCONV + col]) - (dotbf(cbp + (size_t)row * 256, (const bf16_t*)(wl + W_PW) + (size_t)col * 256, 256) + P.in[17 + X.zero][(size_t)l * 256 + col]) * sg); }
    { const int col = cc & 255, b = row >> 12, s = row & 4095, ks = s & 2047; float f = 0.f;
      for (int j = 0; j < 8; ++j) { const float pv = bf2f(Pp[((size_t)(b * 8 + j) * 2048 + ks) * 256 + col]); f += ((j & 1) && s >= 2048) ? -pv : pv; }
      const float gg = dotbf(hr, WinT + (size_t)(2816 + col) * DM, DM), sg = gg / (1.f + expf(-gg));
      dbg_max(dbg + 11, bf2f(z[(size_t)row * NZ + ZC_GFOUR + col]) - f * sg); }
    { const float* xr = P.in[0 + X.zero] + (size_t)row * DM; float ss = 0.f; for (int k = 0; k < DM; ++k) ss = fmaf(xr[k], xr[k], ss);
      dbg_max(dbg + 12, bf2f(hr[cc]) - xr[cc] / sqrtf(ss / DM + NORM_EPS) * P.in[2 + X.zero][(size_t)l * DM + cc]); }
}
DI void dbg_report(const Ctx& X) {
    const float* dbg = (const float*)(X.ws + 768 * 1024);
    if (X.c == 0 && X.tid == 0) { float add = 0.f;
        if (dbg[1] > 0.03f) add = 1e2f; if (dbg[2] > 0.03f) add = 1e3f; if (dbg[3] > 0.03f) add = 1e4f; if (dbg[4] > 0.03f) add = 1e5f;
        if (dbg[5] > 0.03f) add = 1e6f; if (dbg[6] > 0.03f) add = 1e7f; if (dbg[7] > 0.03f) add = 1e8f; if (dbg[8] > 0.03f) add = 1e9f; if (dbg[9] > 0.03f) add = 1e10f; if (dbg[10] > 0.03f) add = 1e11f; if (dbg[11] > 0.03f) add = 1e12f; if (dbg[12] > 0.03f) add = 1e13f;
        X.p->out[0] += add; }
}

#define XB_TMO      128
#define XB_XCNT(j)  (256  + 64 * (j))
#define XB_XSUB(j)  (1280 + 64 * (j))
#define XB_XGEN(j)  (2304 + 64 * (j))
#define XB_TOP      3328
#define XB_TOPGEN   3392
#define XCD_BAR_WORDS 3456
#define XB_SPIN_CAP (1u << 22)
constexpr size_t WS_BAR = 800 * 1024;
constexpr int LDS_MISC = 131072 + 1024;
DI unsigned xb_ld(unsigned* p)              { return __hip_atomic_load(p, __ATOMIC_RELAXED, __HIP_MEMORY_SCOPE_AGENT); }
DI unsigned xb_add(unsigned* p, unsigned v) { return __hip_atomic_fetch_add(p, v, __ATOMIC_RELAXED, __HIP_MEMORY_SCOPE_AGENT); }
DI unsigned xb_xcc_id() { return (unsigned)__builtin_amdgcn_s_getreg((3 << 11) | 20) & 0xFu; }
#define XB_SPIN(cond, bar) do { unsigned _sp = 0; while (cond) { __builtin_amdgcn_s_sleep(1); \
    if ((++_sp & 255u) == 0u) { if (xb_ld(&(bar)[XB_TMO])) break; if (_sp > XB_SPIN_CAP) { atomicAdd(&(bar)[XB_TMO], 1u); break; } } } } while (0)
struct XcdBarrier { unsigned* bar; unsigned x; volatile LAS unsigned* st; };
DI void xcd_barrier_complete(unsigned* bar, unsigned x, unsigned& nloc, unsigned& nx) {
    const unsigned G = gridDim.x * gridDim.y * gridDim.z;
    unsigned sum, cnt, mine, sp = 0u;
    for (;;) {
        sum = 0u; cnt = 0u; mine = 0u;
#pragma unroll
        for (unsigned j = 0; j < 16; ++j) { const unsigned c = xb_ld(&bar[XB_XCNT(j)]); sum += c; cnt += (c > 0u) ? 1u : 0u; mine = (j == x) ? c : mine; }
        if (sum == G) break;
        __builtin_amdgcn_s_sleep(1);
        if ((++sp & 255u) == 0u) { if (xb_ld(&bar[XB_TMO])) break; if (sp > XB_SPIN_CAP) { atomicAdd(&bar[XB_TMO], 1u); break; } }
    }
    nloc = mine > 0u ? mine : 1u; nx = cnt > 0u ? cnt : 1u;
}
DI void xcd_barrier(const XcdBarrier& b, const int tid) {
    asm volatile("s_waitcnt vmcnt(0)" ::: "memory");
    __syncthreads();
    if (tid == 0) {
        unsigned* bar = b.bar;
        __builtin_amdgcn_s_waitcnt(0);
        unsigned nloc = b.st[0], nx = b.st[1];
        if (nloc == 0u) { xcd_barrier_complete(bar, b.x, nloc, nx); b.st[0] = nloc; b.st[1] = nx; }
        const unsigned old = xb_add(&bar[XB_XSUB(b.x)], 1u);
        const unsigned gen = old / nloc;
        if (old + 1u == (gen + 1u) * nloc) {
            __builtin_amdgcn_fence(__ATOMIC_RELEASE, "agent");
            asm volatile("s_waitcnt vmcnt(0)" ::: "memory");
            const unsigned og = xb_add(&bar[XB_TOP], 1u);
            const unsigned tg = og / nx;
            if (og + 1u == (tg + 1u) * nx) xb_add(&bar[XB_TOPGEN], 1u);
            else XB_SPIN(xb_ld(&bar[XB_TOPGEN]) == tg, bar);
            __builtin_amdgcn_fence(__ATOMIC_ACQUIRE, "agent");
            xb_add(&bar[XB_XGEN(b.x)], 1u);
            asm volatile("s_waitcnt vmcnt(0)" ::: "memory");
        } else {
            XB_SPIN(xb_ld(&bar[XB_XGEN(b.x)]) == gen, bar);
            __builtin_amdgcn_fence(__ATOMIC_ACQUIRE, "agent");
            asm volatile("s_waitcnt vmcnt(0)" ::: "memory");
        }
    }
    __syncthreads();
}


#define GB_SUB(g)  (8192 + 16 * (g))
#define GB_GEN(g)  (9216 + 16 * (g))
#define GB_OK      6144
#define GB_MAP     6400
DI void grp_barrier(unsigned* bar, const int g, const unsigned nloc, const int tid) {
    asm volatile("s_waitcnt vmcnt(0)" ::: "memory");
    __syncthreads();
    if (tid == 0) {
        __builtin_amdgcn_s_waitcnt(0);
        const unsigned old = xb_add(&bar[GB_SUB(g)], 1u); const unsigned gen = old / nloc;
        if (old + 1u == (gen + 1u) * nloc) xb_add(&bar[GB_GEN(g)], 1u);
        else XB_SPIN(xb_ld(&bar[GB_GEN(g)]) == gen, bar);
        __builtin_amdgcn_fence(__ATOMIC_ACQUIRE, "agent");
        asm volatile("s_waitcnt vmcnt(0)" ::: "memory");
    }
    __syncthreads();
}

constexpr int NPH = 7;
constexpr int NSTEPS = 2 + NCHUNK * NLAYER * NPH + 1;

DI void run_step(const Ctx& X, int step, const int dummy, const XcdBarrier* xb) {
    const Params& P = *X.p; unsigned char* ws = X.ws; LAS unsigned char* ldsl = (LAS unsigned char*)X.lds;
    if (step == 0) { prep1(X); return; }
    if (step == 1) { prep2(X); return; }
    if (step == NSTEPS - 1) { norm_pass(X, NCHUNK - 1, 2); return; }
    const int s2 = step - 2, ph = s2 % NPH, cl = s2 / NPH, l = cl % NLAYER, ch = cl / NLAYER;
    unsigned char* wl = ws + WS_W + (size_t)l * LW;
    switch (ph) {
    case 0: { if (l == 0 && ch > 0) norm_pass(X, ch - 1, 2); norm_pass(X, ch, l); } break;
    case 1: { SchedSimple S{(const char*)(ws + WS_H), (const char*)(wl + W_IN), DM, DM, 16, 12, X.G, X.c, 0};
              EpiIn E{(bf16_t*)(ws + WS_Z), (bf16_t*)(ws + WS_ABT)};
              pg8::gemm_phase(ldsl, X.tid, DM, DM, S, E); } break;
    case 2: {
        s_pass(X, l);
        { SchedDft S{(const char*)(ws + WS_DFT), (const char*)(ws + WS_ABT), X.G, X.c}; EpiDft E{(bf16_t*)(ws + WS_P)};
          pg8::gemm_phase(ldsl, X.tid, 1024, 1024, S, E); }
        for (int it = X.c; it < MC / 64; it += X.G) conv_item(X, it, l);
        pool_pass(X, dummy ? (bf16_t*)(ws + WS_U) : (bf16_t*)(ws + WS_Z));
    } break;
    case 3: { { SchedQKV S{(const char*)(ws + WS_CQN), (const char*)(ws + WS_CKVN), (const char*)(wl + W_UQ), (const char*)(wl + W_UKV), X.G, X.c};
                EpiQKV E{(bf16_t*)(ws + WS_Q), (bf16_t*)(ws + WS_KN), (bf16_t*)(ws + WS_V)};
                pg8::gemm_phase(ldsl, X.tid, 256, 256, S, E); }
              { SchedSimple S{(const char*)(ws + WS_CB), (const char*)(wl + W_PW), 256, 256, 4, 1, X.G, X.c, (X.G >> 3) >= 32 ? 24 : 0};
                EpiPw E{(bf16_t*)(ws + WS_Z), P.in[17 + X.zero] + (size_t)l * 256};
                pg8::gemm_phase(ldsl, X.tid, 256, 256, S, E); }
              dft_combine(X); } break;
    case 4: {
        const bf16_t* q = (const bf16_t*)(ws + WS_Q); const bf16_t* kn = (const bf16_t*)(ws + WS_KN); const bf16_t* kr = (const bf16_t*)(ws + WS_KROPE); const bf16_t* v = (const bf16_t*)(ws + WS_V);
        bf16_t* z = (bf16_t*)(ws + WS_Z); bf16_t* zo = dummy ? (bf16_t*)(ws + WS_U) : z; const float* rc = (const float*)(ws + WS_ROPE); const float* rs = rc + 4096 * 16;
        for (int i = 0;; ++i) { int pair, qb;
            if (X.G == 256) { if (i >= 2) break; const int pm = 8 * (X.c & 7) + ((X.c >> 3) & 7), pc = X.c >> 6; pair = (pm >> 4) * 8 + 2 * pc + i; qb = pm & 15; }
            else if ((X.G & 7) == 0) { const int per = X.G >> 3, x = X.c & 7, idx = X.c >> 3, qq = i * per + idx; if (qq >= 64) break; pair = 4 * x + (qq >> 4); qb = qq & 15; }
            else { const int L = i * X.G + X.c; if (L >= 512) break; pair = L >> 4; qb = L & 15; }
            const int b = pair >> 3, h = pair & 7;
            att::attn_unit(q + ((size_t)pair * 4096 + qb * 256) * 96, kn + (size_t)pair * 4096 * 64, kr + (size_t)b * 4096 * 32, v + (size_t)pair * 4096 * 64,
                           z + ((size_t)(b * 4096 + qb * 256)) * NZ + ZC_GATTN + h * 64, zo + ((size_t)(b * 4096 + qb * 256)) * NZ + ZC_GATTN + h * 64, rc, rs, qb * 256, X.lds, X.tid); }
    } break;
    case 5: { { SchedUp S{(const char*)(ws + WS_Z), (const char*)(wl + W_UP), X.G, X.c}; EpiPlain E{(bf16_t*)(ws + WS_U), 4096, 0};
                pg8::gemm_phase(ldsl, X.tid, NZ, 1280, S, E); }
              if (X.G != 256) xcd_barrier(*xb, X.tid);
              { SchedGate S{(const char*)(ws + WS_H), (const char*)(wl + W_G), X.G, X.c};
                EpiGate E{(const bf16_t*)(ws + WS_U), (bf16_t*)(ws + WS_M), P.in[5 + X.zero] + (size_t)l * 4096};
                pg8::gemm_phase(ldsl, X.tid, DM, DM, S, E); } } break;
    case 6: { SchedSimple S{(const char*)(ws + WS_M), (const char*)(wl + W_OUT), DM, DM, 16, 4, X.G, X.c, 0}; EpiPlain E{(bf16_t*)(ws + WS_OB), DM, 0};
              pg8::gemm_phase(ldsl, X.tid, DM, DM, S, E); } break;
    }
}


__global__ void __launch_bounds__(NTHREADS, 2) mk_fwd(Params prm) {
    extern __shared__ __attribute__((aligned(16))) unsigned char lds[];
    const int wave_s = __builtin_amdgcn_readfirstlane(threadIdx.x >> 6);
    volatile LAS unsigned* bst = (volatile LAS unsigned*)((LAS unsigned char*)lds + LDS_MISC);
    if (threadIdx.x == 0) { bst[0] = 0u; bst[1] = 0u; }
    __syncthreads();
    XcdBarrier xbar; xbar.bar = (unsigned*)(prm.ws + WS_BAR); xbar.x = xb_xcc_id(); xbar.st = bst;
    if (threadIdx.x == 0) { (void)xb_add(&xbar.bar[XB_XCNT(xbar.x)], 1u); __hip_atomic_store(&xbar.bar[GB_MAP + blockIdx.x], xbar.x + 1u, __ATOMIC_RELAXED, __HIP_MEMORY_SCOPE_AGENT); }
    int use_local = 0;
    int rep = 0;
    for (int step = prm.step_lo; step < prm.step_hi;) {
        int wv_ = wave_s, cb_ = blockIdx.x, gd_ = gridDim.x, zero_ = 0;
        asm volatile("" : "+s"(wv_), "+s"(cb_), "+s"(gd_), "+s"(zero_));
        int lane_; asm volatile("v_mbcnt_lo_u32_b32 %0, -1, 0\n\tv_mbcnt_hi_u32_b32 %0, -1, %0" : "=v"(lane_));
        int tidv = wv_ * 64 + lane_;
        Ctx X; X.p = &prm; X.ws = prm.ws + (size_t)(unsigned)zero_; X.lds = (char*)lds; X.G = gd_; X.c = cb_; X.tid = tidv; X.lane = tidv & 63; X.zero = zero_;
        X.wave = __builtin_amdgcn_readfirstlane(tidv >> 6);
        const bool want2 = (DBL_PREP && step < 2) || (DBL_MASK != 0 && step >= 2 && step < NSTEPS - 1 && ((DBL_MASK >> ((step - 2) % NPH)) & 1));
        const int dummy = (want2 && rep == 0) ? 1 : 0;
        run_step(X, step, dummy, &xbar);
        if (dummy) rep = 1; else { rep = 0; ++step; }
        if (step < prm.step_hi) {
            if (step == 1) { cg::this_grid().sync();
                if (tidv == 0) { unsigned ok = (gd_ == 256) ? 1u : 0u; for (int k = 0; k < 32 && ok; ++k) ok = (xb_ld(&xbar.bar[GB_MAP + (cb_ & 7) + 8 * k]) == xbar.x + 1u) ? 1u : 0u; (void)xb_add(&xbar.bar[GB_OK], ok); } }
            else if (step == 2) { xcd_barrier(xbar, tidv); use_local = __builtin_amdgcn_readfirstlane((int)(xb_ld(&xbar.bar[GB_OK]) == (unsigned)gd_)); }
            else { const int phd = (step - 3) % NPH;
                if (use_local && step >= 3 && (phd == 4 || phd == 5 || phd == 6 || phd == 0)) grp_barrier(xbar.bar, (cb_ & 7) * 8 + ((cb_ >> 3) & 7), 4u, tidv); else xcd_barrier(xbar, tidv); }
        }
    }
}

__global__ void __launch_bounds__(NTHREADS) dbg_kernel(Params prm, int mode) {
    Ctx X; X.p = &prm; X.ws = prm.ws; X.lds = nullptr; X.G = gridDim.x; X.c = blockIdx.x; X.tid = threadIdx.x; X.lane = threadIdx.x & 63; X.wave = threadIdx.x >> 6; X.zero = 0;
    if (mode == 0) dbg_check(X, 0); else dbg_report(X);
}

extern "C" void kernel_launch(void* const* d_in, const int* in_sizes, int n_in, void* d_out, int out_size, void* d_ws, size_t ws_size, hipStream_t stream) {
    static int grid = 0;
    if (grid == 0) {
        if (n_in != 24 || ws_size < WS_END) { fprintf(stderr, "kernel_launch: unexpected n_in %d / ws %zu\n", n_in, ws_size); grid = -1; return; }
        int dev = 0, cus = 0, per_cu = 0;
        hipGetDevice(&dev); hipDeviceGetAttribute(&cus, hipDeviceAttributeMultiprocessorCount, dev);
        if (hipFuncSetAttribute((const void*)mk_fwd, hipFuncAttributeMaxDynamicSharedMemorySize, LDS_BYTES) != hipSuccess) { fprintf(stderr, "kernel_launch: hipFuncSetAttribute failed\n"); grid = -1; return; }
        if (hipOccupancyMaxActiveBlocksPerMultiprocessor(&per_cu, (const void*)mk_fwd, NTHREADS, LDS_BYTES) != hipSuccess || per_cu < 1) { fprintf(stderr, "kernel_launch: occupancy query says %d\n", per_cu); per_cu = 1; }
        (void)hipGetLastError();
        grid = cus;
    }
    if (grid < 0) return;
    Params p{};
    for (int i = 0; i < 24; ++i) p.in[i] = (const float*)d_in[i];
    p.out = (float*)d_out; p.ws = (unsigned char*)d_ws;
    for (int i = 0; i < 16; ++i) p.inv_freq[i] = 1.0f / powf(10000.0f, (float)(2 * i) / 32.0f);
#if MULTI_LAUNCH
    for (int s = 0; s < NSTEPS; ++s) {
#if DBG_ON
        if (s == 2 + (DBG_CH * 2 + 1) * NPH) hipLaunchKernelGGL(dbg_kernel, dim3(64), dim3(NTHREADS), 0, stream, p, 0);
#endif

        p.step_lo = s; p.step_hi = s + 1; hipLaunchKernelGGL(mk_fwd, dim3(grid), dim3(NTHREADS), LDS_BYTES, stream, p); }
#if DBG_ON
    hipLaunchKernelGGL(dbg_kernel, dim3(1), dim3(NTHREADS), 0, stream, p, 1);
#endif
#else
    p.step_lo = 0; p.step_hi = NSTEPS;
    (void)hipMemsetAsync((char*)d_ws + WS_BAR, 0, 65536, stream);
    void* args[] = {&p};
    hipError_t e = hipLaunchCooperativeKernel((const void*)mk_fwd, dim3(grid), dim3(NTHREADS), args, LDS_BYTES, stream);
    if (e != hipSuccess) fprintf(stderr, "cooperative launch failed: %s (grid %d)\n", hipGetErrorString(e), grid);
#endif
}
```

```cpp
#include <hip/hip_runtime.h>
#include <hip/hip_cooperative_groups.h>
#include <cstdio>
#include <cstdint>
namespace cg = cooperative_groups;

#ifndef PH4_ATT
#define PH4_ATT 1
#endif
#ifndef PH4_DFT
#define PH4_DFT 1
#endif
#ifndef PH4_CONV
#define PH4_CONV 1
#endif
#ifndef PH4_POOL
#define PH4_POOL 1
#endif
#ifndef DBL_PREP
#define DBL_PREP 0
#endif
#ifndef DBL_MASK
#define DBL_MASK 0
#endif
#ifndef DBG_ON
#define DBG_ON 0
#endif
#ifndef DBG_CH
#define DBG_CH 0
#endif
#ifndef MULTI_LAUNCH
#define MULTI_LAUNCH 0
#endif

#define DI __device__ __forceinline__
#define LAS __attribute__((address_space(3)))
typedef unsigned short bf16_t;
typedef short bf16x8 __attribute__((ext_vector_type(8)));
typedef short s16x4 __attribute__((ext_vector_type(4)));
typedef float f32x4 __attribute__((ext_vector_type(4)));
typedef float f32x2 __attribute__((ext_vector_type(2)));
typedef float f32x16 __attribute__((ext_vector_type(16)));
typedef unsigned u32x4 __attribute__((ext_vector_type(4)));
typedef unsigned u32x2 __attribute__((ext_vector_type(2)));

constexpr int DM = 1024, SEQ = 4096, NLAYER = 2, NIN = 6816;
constexpr int MC = 16384, NCHUNK = 5, CSEQ = 4;
constexpr int NZ = 3072;
constexpr int ZC_GLU = 768, ZC_G = 1792, ZC_GATTN = 2048, ZC_GCONV = 2560, ZC_GFOUR = 2816;
constexpr float NORM_EPS = 1e-6f, LN_EPS = 1e-5f;
constexpr float ATT_SCALE = 0.10206207261596575f;
constexpr int LDS_BYTES = 147456;
constexpr int NTHREADS = 512, NWAVES = 8;

constexpr size_t MiB = 1u << 20;
constexpr size_t WS_ROPE = 0;
constexpr size_t WS_MAB = 1 * MiB;
constexpr size_t WS_W = 2 * MiB, LW = 20 * MiB;
constexpr size_t W_IN = 0, W_G = 6 * MiB, W_UQ = 14 * MiB, W_UKV = 14 * MiB + 512 * 1024, W_UP = 15 * MiB, W_OUT = 17 * MiB + 512 * 1024, W_PW = 19 * MiB + 512 * 1024;
constexpr size_t WS_DFT = 42 * MiB;
constexpr size_t WS_H = 74 * MiB, WS_Z = 106 * MiB, WS_CQN = 202 * MiB, WS_CKVN = 210 * MiB, WS_KROPE = 218 * MiB;
constexpr size_t WS_Q = 219 * MiB, WS_KN = 243 * MiB, WS_V = 259 * MiB, WS_ABT = 275 * MiB, WS_P = 291 * MiB, WS_CB = 323 * MiB;
constexpr size_t WS_U = 331 * MiB, WS_M = 459 * MiB, WS_OB = 491 * MiB, WS_END = 523 * MiB;

struct Params {
    const float* in[24];
    float* out;
    unsigned char* ws;
    float inv_freq[16];
    int step_lo, step_hi;
};

DI unsigned cvt_pk(float lo, float hi) { unsigned r; asm volatile("v_cvt_pk_bf16_f32 %0, %1, %2" : "=v"(r) : "v"(lo), "v"(hi)); return r; }
DI bf16_t f2bf(float f) { unsigned u = __builtin_bit_cast(unsigned, f); return (bf16_t)((u + 0x7fffu + ((u >> 16) & 1u)) >> 16); }
DI float bf2f(bf16_t b) { return __builtin_bit_cast(float, (unsigned)b << 16); }
DI float bflo(unsigned w) { return __builtin_bit_cast(float, w << 16); }
DI float bfhi(unsigned w) { return __builtin_bit_cast(float, w & 0xffff0000u); }
DI float sigmoidf_(float x) { return __builtin_amdgcn_rcpf(1.f + __builtin_amdgcn_exp2f(-1.4426950408889634f * x)); }
DI float siluf_(float x) { return x * sigmoidf_(x); }
DI float wave_sum(float v, int lane) {
#pragma unroll
    for (int o = 1; o < 64; o <<= 1) v += __builtin_bit_cast(float, __builtin_amdgcn_ds_bpermute((lane ^ o) << 2, __builtin_bit_cast(int, v)));
    return v;
}
DI void store8(bf16_t* p, f32x4 v0, f32x4 v1) { u32x4 w; w.x = cvt_pk(v0[0], v0[1]); w.y = cvt_pk(v0[2], v0[3]); w.z = cvt_pk(v1[0], v1[1]); w.w = cvt_pk(v1[2], v1[3]); *(u32x4*)p = w; }
DI void load8(const bf16_t* p, f32x4& v0, f32x4& v1) { u32x4 w = *(const u32x4*)p; v0 = (f32x4){bflo(w.x), bfhi(w.x), bflo(w.y), bfhi(w.y)}; v1 = (f32x4){bflo(w.z), bfhi(w.z), bflo(w.w), bfhi(w.w)}; }

namespace pg8 {
constexpr int BM = 256, BK = 64, HALF = 128, HTB = HALF * BK * 2, STAGE_BYTES = 8 * HTB;
DI int lds_byte(int r, int c) { const int st = (r >> 4) * 2 + (c >> 5), rr = r & 15, cc = c & 31, ob = rr * 64 + cc * 2; return st * 1024 + (ob ^ (((ob >> 9) & 1) << 5)); }
DI void stage_rc(int b, int& R, int& C) { const int st = b / 1024, sb = b % 1024, swz = sb ^ (((sb >> 9) & 1) << 5); R = (st >> 1) * 16 + swz / 64; C = (st & 1) * 32 + (swz % 64) / 2; }
DI int perm32(int rho) { const int n = rho >> 4, i = rho & 15; return 8 * (i >> 2) + 4 * n + (i & 3); }

struct Unit { const char* A; const char* B; int nt; int pm; int pn; int tag; };

template <class Epi, class Sched>
DI void gemm_phase(LAS unsigned char* lds, const int tid, const int lda, const int ldb, const Sched& S, const Epi& E) {
    const int  wid = __builtin_amdgcn_readfirstlane(tid >> 6), lane = tid & 63, wr = wid >> 2, wc = wid & 3, fr = lane & 15, fq = lane >> 4;
    unsigned voffA[2], voffB[2];
#pragma unroll
    for (int i = 0; i < 2; ++i) { int R, C; stage_rc(tid * 16 + i * 8192, R, C); const int Rb = (R & ~31) + perm32(R & 31);
        voffA[i] = (unsigned)(R * lda + C) * 2u; voffB[i] = (unsigned)(Rb * ldb + C) * 2u; }
    const int kstep = BK * 2;
    const int hstepA = HALF * lda * 2, hstepB = HALF * ldb * 2;
    const unsigned ldsw = (unsigned)wid * 1024u;
    const int aoff = lds_byte(wr * 64 + fr, fq * 8), boff = lds_byte(wc * 32 + fr, fq * 8);
#define PG8_SA(b, h) (((b) * 2 + (h)) * HTB)
#define PG8_SB(b, h) ((4 + (b) * 2 + (h)) * HTB)
#define PG8_STAGE(bufoff, gbase, voff, soff) do { const __amdgpu_buffer_rsrc_t _rs = __builtin_amdgcn_make_buffer_rsrc((void*)(gbase), (short)0, (int)0x7fffffff, (int)0x00020000); _Pragma("unroll") for (int _i = 0; _i < 2; ++_i) \
        __builtin_amdgcn_raw_ptr_buffer_load_lds(_rs, (LAS void*)(lds + (bufoff) + ldsw + _i * 8192), 16, (int)(voff)[_i], (int)(soff), 0, 0); } while (0)
#define PG8_LDA(dst, b, h) do { _Pragma("unroll") for (int m = 0; m < 4; ++m) _Pragma("unroll") for (int k = 0; k < 2; ++k) dst[m][k] = *(const LAS bf16x8*)(lds + PG8_SA(b, h) + aoff + m * 2048 + k * 1024); } while (0)
#define PG8_LDB(dst, b, h) do { _Pragma("unroll") for (int n = 0; n < 2; ++n) _Pragma("unroll") for (int k = 0; k < 2; ++k) dst[n][k] = *(const LAS bf16x8*)(lds + PG8_SB(b, h) + boff + n * 2048 + k * 1024); } while (0)
#define PG8_MMA(ai, bj, At, Bt) do { __builtin_amdgcn_s_setprio(1); _Pragma("unroll") for (int m = 0; m < 4; ++m) _Pragma("unroll") for (int n = 0; n < 2; ++n) _Pragma("unroll") for (int k = 0; k < 2; ++k) \
        acc[ai][bj][m][n] = __builtin_amdgcn_mfma_f32_16x16x32_bf16(Bt[n][k], At[m][k], acc[ai][bj][m][n], 0, 0, 0); __builtin_amdgcn_s_setprio(0); } while (0)
#define PG8_WAIT_V(n) asm volatile("s_waitcnt vmcnt(" #n ")" ::: "memory")
#define PG8_WAIT_L(n) asm volatile("s_waitcnt lgkmcnt(" #n ")" ::: "memory")
#define PG8_BAR __builtin_amdgcn_s_barrier()
#define PG8_SCHED __builtin_amdgcn_sched_barrier(0)
    Unit cur, nxt; int ui = 0;
    if (!S.next(0, cur)) return;
    f32x4 acc[2][2][4][2];
#pragma unroll
    for (int a = 0; a < 2; ++a)
#pragma unroll
        for (int b = 0; b < 2; ++b)
#pragma unroll
            for (int m = 0; m < 4; ++m)
#pragma unroll
                for (int n = 0; n < 2; ++n) acc[a][b][m][n] = (f32x4){0.f, 0.f, 0.f, 0.f};
    bf16x8 At[4][2], B0[2][2], B1[2][2];
    const char* cA = cur.A; const char* cB = cur.B;
    PG8_STAGE(PG8_SB(0, 0), cB, voffB, 0); PG8_STAGE(PG8_SB(0, 1), cB, voffB, hstepB); PG8_STAGE(PG8_SA(0, 0), cA, voffA, 0); PG8_STAGE(PG8_SA(0, 1), cA, voffA, hstepA);
    if (wr == 1) PG8_BAR;
    PG8_WAIT_V(2); PG8_BAR;
    PG8_STAGE(PG8_SB(1, 0), cB, voffB, kstep); PG8_STAGE(PG8_SA(1, 0), cA, voffA, kstep); PG8_STAGE(PG8_SB(1, 1), cB, voffB, hstepB + kstep);
    PG8_WAIT_V(6); PG8_BAR;
    for (;;) {
        const bool has_next = S.next(ui + 1, nxt);
        const char* nA = has_next ? nxt.A : cA; const char* nB = has_next ? nxt.B : cB;
        const int nt = cur.nt;
        for (int t = 0; t < nt; t += 2) {
            const bool last = (t == nt - 2);
            const int o1 = (t + 1) * kstep;
            const char* a2 = last ? nA : cA; const char* b2 = last ? nB : cB; const int o2 = last ? 0 : (t + 2) * kstep, o3 = o2 + kstep;
            PG8_LDB(B0, 0, 0); PG8_LDB(B1, 0, 1); PG8_SCHED; PG8_LDA(At, 0, 0); PG8_STAGE(PG8_SA(1, 1), cA, voffA, o1 + hstepA);
            PG8_WAIT_V(8); PG8_WAIT_L(0); PG8_BAR; PG8_MMA(0, 0, At, B0); PG8_MMA(0, 1, At, B1); PG8_BAR; PG8_SCHED;
            PG8_LDA(At, 0, 1); PG8_STAGE(PG8_SB(0, 0), b2, voffB, o2); PG8_STAGE(PG8_SB(0, 1), b2, voffB, o2 + hstepB); PG8_STAGE(PG8_SA(0, 0), a2, voffA, o2);
            PG8_WAIT_V(8); PG8_WAIT_L(0); PG8_BAR; PG8_MMA(1, 0, At, B0); PG8_MMA(1, 1, At, B1); PG8_BAR; PG8_SCHED;
            PG8_LDB(B0, 1, 0); PG8_LDB(B1, 1, 1); PG8_SCHED; PG8_LDA(At, 1, 0); PG8_STAGE(PG8_SA(0, 1), a2, voffA, o2 + hstepA);
            PG8_WAIT_V(8); PG8_WAIT_L(0); PG8_BAR; PG8_MMA(0, 0, At, B0); PG8_MMA(0, 1, At, B1); PG8_BAR; PG8_SCHED;
            PG8_LDA(At, 1, 1); PG8_STAGE(PG8_SB(1, 0), b2, voffB, o3); PG8_STAGE(PG8_SB(1, 1), b2, voffB, o3 + hstepB); PG8_STAGE(PG8_SA(1, 0), a2, voffA, o3);
            PG8_WAIT_V(8); PG8_WAIT_L(0); PG8_BAR; PG8_MMA(1, 0, At, B0); PG8_MMA(1, 1, At, B1); PG8_BAR; PG8_SCHED;
        }
        if (wr == 0) PG8_BAR;
        E(acc, cur, wr, wc, fr, fq);
        if (!has_next) break;
#pragma unroll
        for (int a = 0; a < 2; ++a)
#pragma unroll
            for (int b = 0; b < 2; ++b)
#pragma unroll
                for (int m = 0; m < 4; ++m)
#pragma unroll
                    for (int n = 0; n < 2; ++n) acc[a][b][m][n] = (f32x4){0.f, 0.f, 0.f, 0.f};
        cur = nxt; cA = nA; cB = nB; ++ui;
        if (wr == 1) PG8_BAR;
    }
    PG8_WAIT_V(0);
    PG8_BAR;
#undef PG8_SA
#undef PG8_SB
#undef PG8_STAGE
#undef PG8_LDA
#undef PG8_LDB
#undef PG8_MMA
#undef PG8_WAIT_V
#undef PG8_WAIT_L
#undef PG8_BAR
#undef PG8_SCHED
}
}
using pg8::Unit;
typedef f32x4 Acc[2][2][4][2];

DI bool tile_of(int i, int G, int c, int npn, int& pm, int& pn, int ioff = 0) {
    if ((G & 7) == 0) { const int per = G >> 3, x = c & 7, idx = c >> 3, q = i * per + idx - ioff; if (q < 0 || q >= 8 * npn) return false; pm = 8 * x + (q & 7); pn = q >> 3; return true; }
    const int L = i * G + c; if (L >= 64 * npn) return false; pm = L & 63; pn = L >> 6; return true;
}

struct SchedSimple {
    const char* A; const char* B; int lda, ldb, nt, npn, G, c, ioff;
    DI bool next(int i, Unit& u) const { int pm, pn; if (!tile_of(i, G, c, npn, pm, pn, ioff)) return false;
        u.A = A + (size_t)pm * 256 * lda * 2; u.B = B + (size_t)pn * 256 * ldb * 2; u.nt = nt; u.pm = pm; u.pn = pn; u.tag = 0; return true; }
};
struct SchedQKV {
    const char* Aq; const char* Akv; const char* Bq; const char* Bkv; int G, c;
    DI bool next(int i, Unit& u) const { int pm, pn; if (!tile_of(i, G, c, 7, pm, pn)) return false;
        const bool isq = pn < 3; u.A = (isq ? Aq : Akv) + (size_t)pm * 256 * 256 * 2; u.B = isq ? Bq + (size_t)pn * 256 * 256 * 2 : Bkv + (size_t)(pn - 3) * 256 * 256 * 2;
        u.nt = 4; u.pm = pm; u.pn = isq ? pn : pn - 3; u.tag = isq ? 0 : 1; return true; }
};
struct SchedUp {
    const char* Z; const char* W; int G, c;
    DI bool next(int i, Unit& u) const { const int L = i * G + c; if (L >= 1024) return false; const int br = L >> 8, r = L & 255;
        const int x = r & 7, idx = r >> 3, pm = 8 * x + (idx & 7), pn = idx >> 3;
        const int koff = br == 0 ? 0 : (br == 1 ? 256 : (br == 2 ? 768 : 1024));
        u.A = Z + ((size_t)pm * 256 * NZ + ZC_G + koff) * 2; u.B = W + ((size_t)pn * 256 * 1280 + koff) * 2; u.nt = br == 1 ? 8 : 4; u.pm = pm; u.pn = br * 4 + pn; u.tag = br; return true; }
};
struct SchedGate {
    const char* H; const char* W; int G, c;
    DI bool next(int i, Unit& u) const { const int P = (i >> 2) * G + c; if (P >= 256) return false; const int b = i & 3;
        const int x = P & 7, idx = P >> 3, pm = 8 * x + (idx & 7), pc = idx >> 3;
        u.A = H + (size_t)pm * 256 * 1024 * 2; u.B = W + (size_t)(b * 4 + pc) * 256 * 1024 * 2; u.nt = 16; u.pm = pm; u.pn = b * 4 + pc; u.tag = b; return true; }
};
struct SchedDft {
    const char* T; const char* AB; int G, c;
    DI bool next(int i, Unit& u) const { const int L = i * G + c; if (L >= 256) return false; const int j = L & 7, r = L >> 3, b = r >> 3, kt = r & 7;
        u.A = T + ((size_t)j * 2048 + kt * 256) * 1024 * 2; u.B = AB + (size_t)(b * 8 + j) * 256 * 1024 * 2; u.nt = 16; u.pm = kt; u.pn = 0; u.tag = b * 8 + j; return true; }
};

#define EPI_LOOP_ROWS for (int ai = 0; ai < 2; ++ai) for (int m = 0; m < 4; ++m)
struct EpiIn {
    bf16_t* z; bf16_t* abt;
    DI void operator()(const Acc& acc, const Unit& u, int wr, int wc, int fr, int fq) const {
        const int row0 = u.pm * 256 + wr * 64 + fr, pn = u.pn, cb = wc * 32 + 8 * fq;
        if (pn <= 2 || pn >= 7) {
#pragma unroll
            EPI_LOOP_ROWS { bf16_t* rp = z + (size_t)(row0 + ai * 128 + m * 16) * NZ + pn * 256 + cb;
#pragma unroll
                for (int bj = 0; bj < 2; ++bj) { f32x4 v0 = acc[ai][bj][m][0], v1 = acc[ai][bj][m][1];
                    if (pn >= 7) {
#pragma unroll
                        for (int e = 0; e < 4; ++e) { v0[e] = siluf_(v0[e]); v1[e] = siluf_(v1[e]); } }
                    store8(rp + bj * 128, v0, v1); } __builtin_amdgcn_sched_barrier(0); }
        } else if (pn <= 4) {
#pragma unroll
            EPI_LOOP_ROWS { bf16_t* rp = z + (size_t)(row0 + ai * 128 + m * 16) * NZ + ZC_GLU + (pn - 3) * 128 + cb;
                f32x4 v0, v1;
#pragma unroll
                for (int e = 0; e < 4; ++e) { v0[e] = acc[ai][0][m][0][e] * sigmoidf_(acc[ai][1][m][0][e]); v1[e] = acc[ai][0][m][1][e] * sigmoidf_(acc[ai][1][m][1][e]); }
                store8(rp, v0, v1); __builtin_amdgcn_sched_barrier(0); }
        } else {
            const int koff = pn == 6 ? 512 : 0;
#pragma unroll
            EPI_LOOP_ROWS { const int row = row0 + ai * 128 + m * 16, b = row >> 12, s = row & 4095;
                const int j = (s & 1) + 2 * (s >> 10), kidx = ((s >> 1) & 511) + koff;
                bf16_t* bp = abt + ((size_t)(b * 8 + j) * 256 + cb) * 1024 + kidx;
#pragma unroll
                for (int bj = 0; bj < 2; ++bj)
#pragma unroll
                    for (int n = 0; n < 2; ++n)
#pragma unroll
                        for (int e = 0; e < 4; ++e) bp[(size_t)(bj * 128 + n * 4 + e) * 1024] = f2bf(acc[ai][bj][m][n][e]); __builtin_amdgcn_sched_barrier(0); }
        }
    }
};
struct EpiQKV {
    bf16_t* q; bf16_t* kn; bf16_t* v;
    DI void operator()(const Acc& acc, const Unit& u, int wr, int wc, int fr, int fq) const {
        const int row0 = u.pm * 256 + wr * 64 + fr;
#pragma unroll
        for (int bj = 0; bj < 2; ++bj) { const int c0 = u.pn * 256 + bj * 128 + wc * 32 + 8 * fq; bf16_t* base; int rstride;
            if (u.tag == 0) { const int h = c0 / 96, d = c0 - 96 * h; base = q + (size_t)h * 4096 * 96 + d; rstride = 96; }
            else { const int h = c0 >> 7, w = c0 & 127; base = (w < 64 ? kn : v) + (size_t)h * 4096 * 64 + (w & 63); rstride = 64; }
#pragma unroll
            EPI_LOOP_ROWS { const int row = row0 + ai * 128 + m * 16; const int rr = row + (row >> 12) * 7 * 4096;
                store8(base + (size_t)rr * rstride, acc[ai][bj][m][0], acc[ai][bj][m][1]); __builtin_amdgcn_sched_barrier(0); } }
    }
};
struct EpiPlain {
    bf16_t* O; int ldc; int col0;
    DI void operator()(const Acc& acc, const Unit& u, int wr, int wc, int fr, int fq) const {
        const int row0 = u.pm * 256 + wr * 64 + fr;
#pragma unroll
        EPI_LOOP_ROWS { bf16_t* rp = O + (size_t)(row0 + ai * 128 + m * 16) * ldc + col0 + u.pn * 256 + wc * 32 + 8 * fq;
#pragma unroll
            for (int bj = 0; bj < 2; ++bj) store8(rp + bj * 128, acc[ai][bj][m][0], acc[ai][bj][m][1]); __builtin_amdgcn_sched_barrier(0); }
    }
};
struct EpiDft {
    bf16_t* P;
    DI void operator()(const Acc& acc, const Unit& u, int wr, int wc, int fr, int fq) const {
        const int row0 = u.pm * 256 + wr * 64 + fr;
#pragma unroll
        EPI_LOOP_ROWS { bf16_t* rp = P + ((size_t)u.tag * 2048 + row0 + ai * 128 + m * 16) * 256 + wc * 32 + 8 * fq;
#pragma unroll
            for (int bj = 0; bj < 2; ++bj) store8(rp + bj * 128, acc[ai][bj][m][0], acc[ai][bj][m][1]); __builtin_amdgcn_sched_barrier(0); }
    }
};
struct EpiPw {
    bf16_t* z; const float* pwb;
    DI void operator()(const Acc& acc, const Unit& u, int wr, int wc, int fr, int fq) const {
        const int row0 = u.pm * 256 + wr * 64 + fr;
#pragma unroll
        for (int bj = 0; bj < 2; ++bj) { const int c0 = bj * 128 + wc * 32 + 8 * fq; const f32x4 b0 = *(const f32x4*)(pwb + c0), b1 = *(const f32x4*)(pwb + c0 + 4);
            u32x4 gg[8];
#pragma unroll
            for (int r8 = 0; r8 < 8; ++r8) gg[r8] = *(const u32x4*)(z + (size_t)(row0 + (r8 >> 2) * 128 + (r8 & 3) * 16) * NZ + ZC_GCONV + c0);
            __builtin_amdgcn_sched_barrier(0);
#pragma unroll
            for (int r8 = 0; r8 < 8; ++r8) { const int ai = r8 >> 2, m = r8 & 3; const u32x4 w = gg[r8];
                const f32x4 g0 = {bflo(w.x), bfhi(w.x), bflo(w.y), bfhi(w.y)}, g1 = {bflo(w.z), bfhi(w.z), bflo(w.w), bfhi(w.w)};
                store8(z + (size_t)(row0 + ai * 128 + m * 16) * NZ + ZC_GCONV + c0, (acc[ai][bj][m][0] + b0) * g0, (acc[ai][bj][m][1] + b1) * g1); }
            __builtin_amdgcn_sched_barrier(0); }
    }
};
struct EpiGate {
    const bf16_t* U; bf16_t* mbuf; const float* gb;
    DI void operator()(const Acc& acc, const Unit& u, int wr, int wc, int fr, int fq) const {
        const int row0 = u.pm * 256 + wr * 64 + fr, br = u.tag;
        const int cgb = u.pn * 256 + wc * 32 + 8 * fq;
        u32x4 uA[2], pA[2], uB[2], pB[2];
#define GATE_LOAD(UU, PP, K) do { const int bj_ = (K) >> 2, ai_ = ((K) >> 1) & 1, mh_ = (K) & 1; const int cg_ = cgb + bj_ * 128; _Pragma("unroll") for (int mm = 0; mm < 2; ++mm) { const size_t row = row0 + ai_ * 128 + (2 * mh_ + mm) * 16; \
            UU[mm] = *(const u32x4*)(U + row * 4096 + cg_); if (br != 0) PP[mm] = *(const u32x4*)(mbuf + row * 1024 + (cg_ & 1023)); else PP[mm] = (u32x4){0u, 0u, 0u, 0u}; } } while (0)
#define GATE_DO(UU, PP, K) do { const int bj_ = (K) >> 2, ai_ = ((K) >> 1) & 1, mh_ = (K) & 1; const int cg_ = cgb + bj_ * 128; const f32x4 b0 = *(const f32x4*)(gb + cg_), b1 = *(const f32x4*)(gb + cg_ + 4); \
        _Pragma("unroll") for (int mm = 0; mm < 2; ++mm) { const int m = 2 * mh_ + mm; const size_t row = row0 + ai_ * 128 + m * 16; const u32x4 w = UU[mm], q = PP[mm]; \
            const f32x4 u0 = {bflo(w.x), bfhi(w.x), bflo(w.y), bfhi(w.y)}, u1 = {bflo(w.z), bfhi(w.z), bflo(w.w), bfhi(w.w)}; \
            const f32x4 p0 = {bflo(q.x), bfhi(q.x), bflo(q.y), bfhi(q.y)}, p1 = {bflo(q.z), bfhi(q.z), bflo(q.w), bfhi(q.w)}; \
            f32x4 v0 = acc[ai_][bj_][m][0] + b0, v1 = acc[ai_][bj_][m][1] + b1; \
            _Pragma("unroll") for (int e = 0; e < 4; ++e) { v0[e] = sigmoidf_(v0[e]) * u0[e] + p0[e]; v1[e] = sigmoidf_(v1[e]) * u1[e] + p1[e]; } \
            store8(mbuf + row * 1024 + (cg_ & 1023), v0, v1); } } while (0)
#define SB __builtin_amdgcn_sched_barrier(0)
        GATE_LOAD(uA, pA, 0); SB;
        GATE_LOAD(uB, pB, 1); SB; GATE_DO(uA, pA, 0); SB;
        GATE_LOAD(uA, pA, 2); SB; GATE_DO(uB, pB, 1); SB;
        GATE_LOAD(uB, pB, 3); SB; GATE_DO(uA, pA, 2); SB;
        GATE_LOAD(uA, pA, 4); SB; GATE_DO(uB, pB, 3); SB;
        GATE_LOAD(uB, pB, 5); SB; GATE_DO(uA, pA, 4); SB;
        GATE_LOAD(uA, pA, 6); SB; GATE_DO(uB, pB, 5); SB;
        GATE_LOAD(uB, pB, 7); SB; GATE_DO(uA, pA, 6); SB;
        GATE_DO(uB, pB, 7); SB;
#undef SB
#undef GATE_LOAD
#undef GATE_DO
    }
};

struct SchedQKVPW {
    const char* Aq; const char* Akv; const char* Apw; const char* Bq; const char* Bkv; const char* Bpw; int G, c;
    DI bool next(int i, Unit& u) const { int pm, pn; if (!tile_of(i, G, c, 8, pm, pn)) return false;
        const int t = pn < 3 ? 0 : (pn < 7 ? 1 : 2); const int lp = t == 0 ? pn : (t == 1 ? pn - 3 : 0);
        u.A = (t == 0 ? Aq : (t == 1 ? Akv : Apw)) + (size_t)pm * 256 * 256 * 2; u.B = (t == 0 ? Bq : (t == 1 ? Bkv : Bpw)) + (size_t)lp * 256 * 256 * 2;
        u.nt = 4; u.pm = pm; u.pn = lp; u.tag = t; return true; }
};
struct EpiQKVPW {
    EpiQKV a; EpiPw b;
    DI void operator()(const Acc& acc, const Unit& u, int wr, int wc, int fr, int fq) const { if (u.tag == 2) b(acc, u, wr, wc, fr, fq); else a(acc, u, wr, wc, fr, fq); }
};

namespace att {
constexpr int KROWB = 208, SHM_K = 64 * KROWB, SHM_V = 8192;
constexpr int NBUF = 3, OFF_V = 0, OFF_K = NBUF * SHM_V, OFF_WS = OFF_K + NBUF * SHM_K;
constexpr float THR = 8.f;
#define SBAR() __builtin_amdgcn_sched_barrier(0)
DI int crow(int r, int hi) { return (r & 3) + 8 * (r >> 2) + 4 * hi; }
DI void partialSM(f32x16& p0, f32x16& p1, float& m_reg, float& mn, float& alpha) {
    constexpr float C = ATT_SCALE * 1.4426950408889634f;
    float pmax = p0[0];
#pragma unroll
    for (int r = 1; r < 16; ++r) pmax = fmaxf(pmax, p0[r]);
#pragma unroll
    for (int r = 0; r < 16; ++r) pmax = fmaxf(pmax, p1[r]);
    { auto rr = __builtin_amdgcn_permlane32_swap(__float_as_uint(pmax), __float_as_uint(pmax), false, false);
      pmax = fmaxf(__uint_as_float(rr[0]), __uint_as_float(rr[1])); }
    if (__builtin_expect(__all(pmax - m_reg <= THR / ATT_SCALE), 1)) { mn = m_reg; alpha = 1.f; }
    else { mn = fmaxf(m_reg, pmax); alpha = __builtin_amdgcn_exp2f((m_reg - mn) * C); m_reg = mn; }
    const float mnC = -mn * C;
#pragma unroll
    for (int r = 0; r < 16; ++r) p0[r] = fmaf(p0[r], C, mnC);
#pragma unroll
    for (int r = 0; r < 16; ++r) p1[r] = fmaf(p1[r], C, mnC);
#pragma unroll
    for (int r = 0; r < 16; ++r) p0[r] = __builtin_amdgcn_exp2f(p0[r]);
}
DI void finishSM(f32x16& p0, f32x16& p1, float alpha, float& l_reg, bf16x8& pa0, bf16x8& pa1, bf16x8& pa2, bf16x8& pa3) {
#pragma unroll
    for (int r = 0; r < 16; ++r) p1[r] = __builtin_amdgcn_exp2f(p1[r]);
    float ps = 0;
#pragma unroll
    for (int r = 0; r < 16; ++r) ps += p0[r];
#pragma unroll
    for (int r = 0; r < 16; ++r) ps += p1[r];
    { auto rr = __builtin_amdgcn_permlane32_swap(__float_as_uint(ps), __float_as_uint(ps), false, false);
      ps = __uint_as_float(rr[0]) + __uint_as_float(rr[1]); }
    l_reg = l_reg * alpha + ps;
#define PK4(P, BASE, OUT) do { unsigned a0 = cvt_pk(P[BASE + 0], P[BASE + 1]), a1 = cvt_pk(P[BASE + 2], P[BASE + 3]);   \
    unsigned b0 = cvt_pk(P[BASE + 4], P[BASE + 5]), b1 = cvt_pk(P[BASE + 6], P[BASE + 7]);                              \
    auto r0 = __builtin_amdgcn_permlane32_swap(a0, b0, false, false); auto r1 = __builtin_amdgcn_permlane32_swap(a1, b1, false, false); \
    u32x4 w = {r0[0], r1[0], r0[1], r1[1]}; OUT = __builtin_bit_cast(bf16x8, w); } while (0)
    PK4(p0, 0, pa0); PK4(p0, 8, pa1); PK4(p1, 0, pa2); PK4(p1, 8, pa3);
#undef PK4
}
DI void qkt(f32x16& p0, f32x16& p1, const char* Ks, const bf16x8* qr, int r32, int hi) {
#pragma unroll
    for (int r = 0; r < 16; ++r) { p0[r] = 0.f; p1[r] = 0.f; }
    const char* k0p = Ks + r32 * KROWB + hi * 16; const char* k1p = k0p + 32 * KROWB;
    bf16x8 b0 = *reinterpret_cast<const bf16x8*>(k0p), b1 = *reinterpret_cast<const bf16x8*>(k1p);
#pragma unroll
    for (int d0 = 0; d0 < 6; ++d0) {
        bf16x8 n0 = b0, n1 = b1;
        if (d0 < 5) { n0 = *reinterpret_cast<const bf16x8*>(k0p + (d0 + 1) * 32); n1 = *reinterpret_cast<const bf16x8*>(k1p + (d0 + 1) * 32); }
        p0 = __builtin_amdgcn_mfma_f32_32x32x16_bf16(b0, qr[d0], p0, 0, 0, 0);
        p1 = __builtin_amdgcn_mfma_f32_32x32x16_bf16(b1, qr[d0], p1, 0, 0, 0);
        b0 = n0; b1 = n1; }
}
DI int v_st(int k, int c) { const int kk = (k & ~0xC) | ((k & 4) << 1) | ((k & 8) >> 1); return ((kk >> 3) * 2 + (c >> 5)) * 512 + ((kk & 7) * 32 + (c & 31)) * 2; }
DI int v_rd_base(int lane) { return ((lane & 3) << 3) | (((lane >> 2) & 3) << 6) | (((lane >> 4) & 1) << 5) | (((lane >> 5) & 1) << 8); }
constexpr int v_rd_off(int d0, int ks, int half) { return d0 * 512 + ks * 2048 + half * 1024; }
typedef short v4i16_t __attribute__((ext_vector_type(4)));
template <int OFF> DI s16x4 tr_read(int vb) { return __builtin_bit_cast(s16x4, __builtin_amdgcn_ds_read_tr16_b64_v4i16((LAS v4i16_t*)(unsigned long long)(unsigned)(vb + OFF))); }
template <int D0> DI void pv_one(f32x16& od, int vb, bf16x8 pa0, bf16x8 pa1, bf16x8 pa2, bf16x8 pa3) {
    const s16x4 l0 = tr_read<v_rd_off(D0, 0, 0)>(vb), h0 = tr_read<v_rd_off(D0, 0, 1)>(vb), l1 = tr_read<v_rd_off(D0, 1, 0)>(vb), h1 = tr_read<v_rd_off(D0, 1, 1)>(vb);
    const s16x4 l2 = tr_read<v_rd_off(D0, 2, 0)>(vb), h2 = tr_read<v_rd_off(D0, 2, 1)>(vb), l3 = tr_read<v_rd_off(D0, 3, 0)>(vb), h3 = tr_read<v_rd_off(D0, 3, 1)>(vb);
#define PK(L, H) (bf16x8){L[0], L[1], L[2], L[3], H[0], H[1], H[2], H[3]}
    od = __builtin_amdgcn_mfma_f32_32x32x16_bf16(pa0, PK(l0, h0), od, 0, 0, 0);
    od = __builtin_amdgcn_mfma_f32_32x32x16_bf16(pa1, PK(l1, h1), od, 0, 0, 0);
    od = __builtin_amdgcn_mfma_f32_32x32x16_bf16(pa2, PK(l2, h2), od, 0, 0, 0);
    od = __builtin_amdgcn_mfma_f32_32x32x16_bf16(pa3, PK(l3, h3), od, 0, 0, 0);
#undef PK
}
DI void pv_d0(f32x16* o, int vb, bf16x8 pa0, bf16x8 pa1, bf16x8 pa2, bf16x8 pa3) { pv_one<0>(o[0], vb, pa0, pa1, pa2, pa3); pv_one<1>(o[1], vb, pa0, pa1, pa2, pa3); }

DI void attn_unit(const bf16_t* __restrict__ Qb, const bf16_t* __restrict__ Kn, const bf16_t* __restrict__ Kr, const bf16_t* __restrict__ Vh,
                  const bf16_t* Zg, bf16_t* Zo, const float* __restrict__ ropec, const float* __restrict__ ropes, int pos0, char* lds, const int tid) {
    const int wid = tid >> 6, lane = tid & 63, r32 = lane & 31, hi = lane >> 5;
    char* V_lds = lds + OFF_V; char* K_lds = lds + OFF_K;
    float* ws = (float*)(lds + OFF_WS) + wid * 64; float* li_l = ws; float* al_l = ws + 32;
    float m_reg = -1e30f, l_reg = 0; f32x16 o[2];
#pragma unroll
    for (int r = 0; r < 16; ++r) { o[0][r] = 0.f; o[1][r] = 0.f; }
    bf16x8 qr[6];
    { const bf16_t* Qw = Qb + (size_t)(wid * 32 + r32) * 96 + hi * 8;
#pragma unroll
      for (int d0 = 0; d0 < 6; ++d0) qr[d0] = *reinterpret_cast<const bf16x8*>(Qw + d0 * 16);
      const int pos = pos0 + wid * 32 + r32;
      const f32x4 c0 = *(const f32x4*)(ropec + pos * 16 + hi * 8), c1 = *(const f32x4*)(ropec + pos * 16 + hi * 8 + 4);
      const f32x4 s0 = *(const f32x4*)(ropes + pos * 16 + hi * 8), s1 = *(const f32x4*)(ropes + pos * 16 + hi * 8 + 4);
      float x1[8], x2[8], cs[8], sn[8];
#pragma unroll
      for (int j = 0; j < 8; ++j) { x1[j] = bf2f((bf16_t)qr[4][j]); x2[j] = bf2f((bf16_t)qr[5][j]); cs[j] = j < 4 ? c0[j & 3] : c1[j & 3]; sn[j] = j < 4 ? s0[j & 3] : s1[j & 3]; }
      u32x4 w1, w2;
      w1.x = cvt_pk(x1[0] * cs[0] - x2[0] * sn[0], x1[1] * cs[1] - x2[1] * sn[1]); w1.y = cvt_pk(x1[2] * cs[2] - x2[2] * sn[2], x1[3] * cs[3] - x2[3] * sn[3]);
      w1.z = cvt_pk(x1[4] * cs[4] - x2[4] * sn[4], x1[5] * cs[5] - x2[5] * sn[5]); w1.w = cvt_pk(x1[6] * cs[6] - x2[6] * sn[6], x1[7] * cs[7] - x2[7] * sn[7]);
      w2.x = cvt_pk(x2[0] * cs[0] + x1[0] * sn[0], x2[1] * cs[1] + x1[1] * sn[1]); w2.y = cvt_pk(x2[2] * cs[2] + x1[2] * sn[2], x2[3] * cs[3] + x1[3] * sn[3]);
      w2.z = cvt_pk(x2[4] * cs[4] + x1[4] * sn[4], x2[5] * cs[5] + x1[5] * sn[5]); w2.w = cvt_pk(x2[6] * cs[6] + x1[6] * sn[6], x2[7] * cs[7] + x1[7] * sn[7]);
      qr[4] = __builtin_bit_cast(bf16x8, w1); qr[5] = __builtin_bit_cast(bf16x8, w2); }
    const int ka_r = tid / 12, ka_c = tid - 12 * ka_r; const int kb_i = 512 + (tid & 255), kb_r = kb_i / 12, kb_c = kb_i - 12 * kb_r;
    const int dKr = (int)((const char*)Kr - (const char*)Kn);
    const int koa = ka_c < 8 ? (ka_r * 64 + ka_c * 8) * 2 : dKr + (ka_r * 32 + (ka_c - 8) * 8) * 2; const int ksa = ka_c < 8 ? 128 : 64;
    const int kob = kb_c < 8 ? (kb_r * 64 + kb_c * 8) * 2 : dKr + (kb_r * 32 + (kb_c - 8) * 8) * 2; const int ksb = kb_c < 8 ? 128 : 64;
    const int kda = ka_r * KROWB + ka_c * 16, kdb = kb_r * KROWB + kb_c * 16; const bool has_b = tid < 256;
    const int vr = tid >> 3, vc = (tid & 7) * 8; const int vo = (vr * 64 + vc) * 2; const int vd = v_st(vr, vc);
    const int vb0 = (int)(uintptr_t)V_lds + v_rd_base(lane);
    struct { bf16x8 ka, kb, vv; } sr_[2];
#define SLOAD(i, k0) do { sr_[i].ka = *reinterpret_cast<const bf16x8*>((const char*)Kn + (koa + (k0) * ksa)); sr_[i].kb = *reinterpret_cast<const bf16x8*>((const char*)Kn + (kob + (k0) * ksb)); \
    sr_[i].vv = *reinterpret_cast<const bf16x8*>((const char*)Vh + (vo + (k0) * 128)); } while (0)
#define SWRITE(b, i) do { *(bf16x8*)(V_lds + (b) * SHM_V + vd) = sr_[i].vv; *(bf16x8*)(K_lds + (b) * SHM_K + kda) = sr_[i].ka; \
    if (has_b) *(bf16x8*)(K_lds + (b) * SHM_K + kdb) = sr_[i].kb; } while (0)
#define SWAIT() asm volatile("s_waitcnt vmcnt(3)" ::: "memory")
#define RESC(a) do { if (__any((a) < 1.f)) { if (hi == 0) al_l[r32] = (a); asm volatile("s_waitcnt lgkmcnt(0)" ::: "memory"); \
    _Pragma("unroll") for (int d = 0; d < 2; ++d) _Pragma("unroll") for (int r = 0; r < 16; ++r) o[d][r] *= al_l[crow(r, hi)]; } } while (0)
    f32x16 pA0, pA1, pB0, pB1; float mnA, mnB, alA, alB; bf16x8 pa0, pa1, pa2, pa3; constexpr int NT = SEQ / 64;
    SLOAD(0, 0); asm volatile("s_waitcnt vmcnt(0)" ::: "memory"); SWRITE(0, 0); __syncthreads();
    qkt(pA0, pA1, K_lds, qr, r32, hi); partialSM(pA0, pA1, m_reg, mnA, alA);
    SLOAD(1, 64); SLOAD(0, 128);
    SWAIT(); SWRITE(1, 1); __syncthreads();
    int bc = 1;
    for (int j = 1; j + 1 < NT; j += 2) {
        const int bp = bc == 0 ? 2 : bc - 1, bn = bc == 2 ? 0 : bc + 1, bnn = bn == 2 ? 0 : bn + 1;
        SBAR(); qkt(pB0, pB1, K_lds + bc * SHM_K, qr, r32, hi);
        finishSM(pA0, pA1, alA, l_reg, pa0, pa1, pa2, pa3); SBAR();
        SLOAD(1, (j + 2) * 64); SBAR();
        pv_d0(o, vb0 + bp * SHM_V, pa0, pa1, pa2, pa3); partialSM(pB0, pB1, m_reg, mnB, alB);
        SWAIT(); SWRITE(bn, 0);
        RESC(alB); __syncthreads();
        SBAR(); qkt(pA0, pA1, K_lds + bn * SHM_K, qr, r32, hi);
        finishSM(pB0, pB1, alB, l_reg, pa0, pa1, pa2, pa3); SBAR();
        if (j + 3 < NT) SLOAD(0, (j + 3) * 64); SBAR();
        pv_d0(o, vb0 + bc * SHM_V, pa0, pa1, pa2, pa3); partialSM(pA0, pA1, m_reg, mnA, alA);
        SWAIT(); SWRITE(bnn, 1);
        RESC(alA); __syncthreads();
        bc = bnn;
    }
    { const int bp = bc == 0 ? 2 : bc - 1;
      SBAR(); qkt(pB0, pB1, K_lds + bc * SHM_K, qr, r32, hi);
      finishSM(pA0, pA1, alA, l_reg, pa0, pa1, pa2, pa3); SBAR();
      pv_d0(o, vb0 + bp * SHM_V, pa0, pa1, pa2, pa3); partialSM(pB0, pB1, m_reg, mnB, alB);
      RESC(alB);
      finishSM(pB0, pB1, alB, l_reg, pa0, pa1, pa2, pa3); SBAR();
      pv_d0(o, vb0 + bc * SHM_V, pa0, pa1, pa2, pa3); }
    if (hi == 0) li_l[r32] = l_reg; asm volatile("s_waitcnt lgkmcnt(0)" ::: "memory");
    bf16_t* Zw = Zo + (size_t)(wid * 32) * NZ; const bf16_t* Zgw = Zg + (size_t)(wid * 32) * NZ;
#pragma unroll
    for (int r = 0; r < 16; ++r) { const int orow = crow(r, hi); const float rl = __builtin_amdgcn_rcpf(li_l[orow]);
#pragma unroll
        for (int d0 = 0; d0 < 2; ++d0) { const size_t off = (size_t)orow * NZ + d0 * 32 + r32; Zw[off] = f2bf(o[d0][r] * rl * bf2f(Zgw[off])); } }
    __syncthreads();
#undef SLOAD
#undef SWRITE
#undef SWAIT
#undef RESC
}
}

struct Ctx {
    const Params* p; unsigned char* ws; char* lds; int G, c, tid, lane, wave, zero;
};

DI void job_transpose(const Ctx& X, const float* W, int ldw, int col0, int ncols, int K, int kvalid, bf16_t* dst, int ldd, int drow0, int dcol0, float scale) {
    const int k8n = K >> 3, total = ncols * k8n;
    for (int it = X.c * NTHREADS + X.tid; it < total; it += X.G * NTHREADS) {
        const int n = it % ncols, k8 = it / ncols; float v[8];
#pragma unroll
        for (int i = 0; i < 8; ++i) { const int k = k8 * 8 + i; v[i] = k < kvalid ? W[(size_t)k * ldw + col0 + n] * scale : 0.f; }
        u32x4 w; w.x = cvt_pk(v[0], v[1]); w.y = cvt_pk(v[2], v[3]); w.z = cvt_pk(v[4], v[5]); w.w = cvt_pk(v[6], v[7]);
        *(u32x4*)(dst + (size_t)(drow0 + n) * ldd + dcol0 + k8 * 8) = w;
    }
}
DI void job_zero_rows(const Ctx& X, bf16_t* dst, int ldd, int drow0, int nrows, int K) {
    const int k8n = K >> 3, total = nrows * k8n; unsigned zz = 0u; asm volatile("" : "+v"(zz));
    for (int it = X.c * NTHREADS + X.tid; it < total; it += X.G * NTHREADS) { const int n = it / k8n, k8 = it % k8n;
        *(u32x4*)(dst + (size_t)(drow0 + n) * ldd + k8 * 8) = (u32x4){zz, zz, zz, zz}; }
}

DI void prep1(const Ctx& X) {
    const Params& P = *X.p; unsigned char* ws = X.ws;
    const int gt = X.c * NTHREADS + X.tid, GT = X.G * NTHREADS;
    if (gt < 16) ((float*)(ws + 768 * 1024))[gt] = 0.f;
    { float* rc = (float*)(ws + WS_ROPE); float* rs = rc + 4096 * 16;
      for (int it = gt; it < 4096 * 16; it += GT) { const int pos = it >> 4, i = it & 15; const float ang = (float)pos * P.inv_freq[i];
          double rev = (double)ang * 0.15915494309189535; rev -= __builtin_rint(rev); const float rf = (float)rev;
          rc[it] = __builtin_amdgcn_cosf(rf); rs[it] = __builtin_amdgcn_sinf(rf); } }
    { bf16_t* T = (bf16_t*)(ws + WS_DFT);
      for (int it = gt; it < 8 * 2048 * 128; it += GT) { const int k8 = it & 127, ks = (it >> 7) & 2047, j = it >> 18; float v[8];
#pragma unroll
          for (int i = 0; i < 8; ++i) { const int kidx = k8 * 8 + i, kk = kidx & 511, s = 2 * ((j >> 1) * 512 + kk) + (j & 1);
              const float fr = (float)((ks * s) & 4095) * (1.f / 4096.f);
              v[i] = (kidx < 512 ? __builtin_amdgcn_cosf(fr) : -__builtin_amdgcn_sinf(fr)) * (1.f / 64.f); }
          u32x4 w; w.x = cvt_pk(v[0], v[1]); w.y = cvt_pk(v[2], v[3]); w.z = cvt_pk(v[4], v[5]); w.w = cvt_pk(v[6], v[7]);
          *(u32x4*)(T + (size_t)it * 8) = w; } }
    for (int l = 0; l < NLAYER; ++l) {
        unsigned char* wl = ws + WS_W + (size_t)l * LW;
        const float* w_in = P.in[4 + X.zero] + (size_t)l * DM * NIN;
        bf16_t* WinT = (bf16_t*)(wl + W_IN);
        job_transpose(X, w_in, NIN, 256, 256, DM, DM, WinT, DM, 256, 0, 1.f);
        job_transpose(X, w_in, NIN, 512, 160, DM, DM, WinT, DM, 512, 0, 1.f);
        job_zero_rows(X, WinT, DM, 672, 96, DM);
        job_transpose(X, w_in, NIN, 672, 128, DM, DM, WinT, DM, 768, 0, 1.f);
        job_transpose(X, w_in, NIN, 928, 128, DM, DM, WinT, DM, 896, 0, 1.f);
        job_transpose(X, w_in, NIN, 800, 128, DM, DM, WinT, DM, 1024, 0, 1.f);
        job_transpose(X, w_in, NIN, 1056, 128, DM, DM, WinT, DM, 1152, 0, 1.f);
        job_transpose(X, w_in, NIN, 1440, 1280, DM, DM, WinT, DM, 1792, 0, 1.f);
        job_transpose(X, w_in, NIN, 2720, 4096, DM, DM, (bf16_t*)(wl + W_G), DM, 0, 0, 1.f);
        job_transpose(X, P.in[7 + X.zero] + (size_t)l * 256 * 768, 768, 0, 768, 256, 256, (bf16_t*)(wl + W_UQ), 256, 0, 0, 1.f);
        job_transpose(X, P.in[9 + X.zero] + (size_t)l * 128 * 1024, 1024, 0, 1024, 256, 128, (bf16_t*)(wl + W_UKV), 256, 0, 0, 1.f);
        job_transpose(X, P.in[19 + X.zero] + (size_t)l * 256 * DM, DM, 0, DM, 256, 256, (bf16_t*)(wl + W_UP), 1280, 0, 0, 1.f);
        job_transpose(X, P.in[20 + X.zero] + (size_t)l * 512 * DM, DM, 0, DM, 512, 512, (bf16_t*)(wl + W_UP), 1280, 0, 256, 1.f);
        job_transpose(X, P.in[21 + X.zero] + (size_t)l * 256 * DM, DM, 0, DM, 256, 256, (bf16_t*)(wl + W_UP), 1280, 0, 768, 1.f);
        job_transpose(X, P.in[22 + X.zero] + (size_t)l * 256 * DM, DM, 0, DM, 256, 256, (bf16_t*)(wl + W_UP), 1280, 0, 1024, 1.f);
        job_transpose(X, P.in[23 + X.zero] + (size_t)l * DM * DM, DM, 0, DM, DM, DM, (bf16_t*)(wl + W_OUT), DM, 0, 0, 1.f);
        job_transpose(X, P.in[16 + X.zero] + (size_t)l * 256 * 256, 256, 0, 256, 256, 256, (bf16_t*)(wl + W_PW), 256, 0, 0, 1.f);
        { const float* pw = P.in[10 + X.zero] + (size_t)l * 4 * 64 * 64; const float* psc = P.in[11 + X.zero] + (size_t)l * 256;
          for (int it = gt; it < DM * 256; it += GT) { const int n = it & 255, k = it >> 8, g = n >> 6, d = n & 63; float a = 0.f;
              const float* wr_ = w_in + (size_t)k * NIN + g * 64; const float* pp = pw + g * 4096 + d;
#pragma unroll 8
              for (int cc = 0; cc < 64; ++cc) a = fmaf(wr_[cc], pp[cc * 64], a);
              WinT[(size_t)n * DM + k] = f2bf(a * psc[n]); } }
        { const float* wf = P.in[18 + X.zero] + (size_t)l * 256 * 256; float* MA = (float*)(ws + WS_MAB) + (size_t)l * 2 * 65536; float* MB = MA + 65536;
          for (int it = gt; it < 65536; it += GT) { const int d = it & 255, gc = it >> 8, g = gc >> 6, cch = gc & 63; float a = 0.f, b = 0.f;
              for (int kc = 0; kc < 64; ++kc) { const float fr = (float)((kc * cch) & 63) * (1.f / 64.f); const float w = wf[(size_t)(g * 64 + kc) * 256 + d];
                  a = fmaf(__builtin_amdgcn_cosf(fr), w, a); b = fmaf(__builtin_amdgcn_sinf(fr), w, b); }
              MA[it] = a; MB[it] = b; } }
    }
}
DI void prep2(const Ctx& X) {
    const Params& P = *X.p; unsigned char* ws = X.ws;
    const int gt = X.c * NTHREADS + X.tid, GT = X.G * NTHREADS;
    for (int l = 0; l < NLAYER; ++l) {
        const float* w_in = P.in[4 + X.zero] + (size_t)l * DM * NIN + 1184; bf16_t* WinT = (bf16_t*)(ws + WS_W + (size_t)l * LW + W_IN);
        const float* MA = (const float*)(ws + WS_MAB) + (size_t)l * 2 * 65536;
        for (int it = gt; it < DM * 512; it += GT) { const int n = it & 511, k = it >> 9; const float* Mx = MA + (n >> 8) * 65536 + (n & 255); const float* wr_ = w_in + (size_t)k * NIN; float a = 0.f;
#pragma unroll 8
            for (int gc = 0; gc < 256; ++gc) a = fmaf(wr_[gc], Mx[gc * 256], a);
            WinT[(size_t)(1280 + n) * DM + k] = f2bf(a * 0.125f); }
    }
}

DI void norm_pass(const Ctx& X, int ch, int l) {
    float NEPS = NORM_EPS; asm volatile("" : "+s"(NEPS));
    const Params& P = *X.p; const int lane = X.lane;
    const int gw = X.G == 256 ? (256 * (8 * (X.c & 7) + ((X.c >> 3) & 7)) + 64 * (X.c >> 6) + 8 * X.wave) : X.c * NWAVES + X.wave, NGW = X.G == 256 ? 1 : X.G * NWAVES;
    const int rend = X.G == 256 ? gw + 8 : MC;
    const float* xin = ch == 0 ? P.in[0 + X.zero] : P.in[1 + X.zero] + (size_t)(ch - 1) * MC * DM;
    float* xo = P.out + (size_t)ch * MC * DM;
    const bf16_t* ob = (const bf16_t*)(X.ws + WS_OB); bf16_t* hb = (bf16_t*)(X.ws + WS_H);
    for (int r = gw; r < rend; r += NGW) {
        const float* xr = (l == 0 ? xin : (l == 1 ? xin : xo)) + (size_t)r * DM;
        f32x4 v[4];
#pragma unroll
        for (int j = 0; j < 4; ++j) v[j] = *(const f32x4*)(xr + (lane + 64 * j) * 4);
        if (l >= 1) {
            const float* pg = P.in[3 + X.zero] + (size_t)(l - 1) * DM; f32x4 ov[4]; float ss = 0.f;
#pragma unroll
            for (int j = 0; j < 4; ++j) { const u32x2 w = *(const u32x2*)(ob + (size_t)r * DM + (lane + 64 * j) * 4); ov[j] = (f32x4){bflo(w.x), bfhi(w.x), bflo(w.y), bfhi(w.y)};
                ss += ov[j][0] * ov[j][0] + ov[j][1] * ov[j][1] + ov[j][2] * ov[j][2] + ov[j][3] * ov[j][3]; }
            const float rs = __builtin_amdgcn_rsqf(wave_sum(ss, lane) * (1.f / DM) + NEPS);
#pragma unroll
            for (int j = 0; j < 4; ++j) { const f32x4 g = *(const f32x4*)(pg + (lane + 64 * j) * 4); v[j] += ov[j] * rs * g; *(f32x4*)(xo + (size_t)r * DM + (lane + 64 * j) * 4) = v[j]; }
        }
        if (l <= 1) {
            const float* pg = P.in[2 + X.zero] + (size_t)l * DM; float ss = 0.f;
#pragma unroll
            for (int j = 0; j < 4; ++j) ss += v[j][0] * v[j][0] + v[j][1] * v[j][1] + v[j][2] * v[j][2] + v[j][3] * v[j][3];
            const float rs = __builtin_amdgcn_rsqf(wave_sum(ss, lane) * (1.f / DM) + NEPS);
#pragma unroll
            for (int j = 0; j < 4; ++j) { const f32x4 g = *(const f32x4*)(pg + (lane + 64 * j) * 4); const f32x4 hv = v[j] * rs * g;
                u32x2 w; w.x = cvt_pk(hv[0], hv[1]); w.y = cvt_pk(hv[2], hv[3]); *(u32x2*)(hb + (size_t)r * DM + (lane + 64 * j) * 4) = w; }
        }
    }
}

DI void s_pass(const Ctx& X, int l) {
    float NEPS = NORM_EPS; asm volatile("" : "+s"(NEPS));
    const Params& P = *X.p; const int gw = X.c * NWAVES + X.wave, NGW = X.G * NWAVES, lane = X.lane;
    const bf16_t* z = (const bf16_t*)(X.ws + WS_Z); bf16_t* cqn = (bf16_t*)(X.ws + WS_CQN); bf16_t* ckvn = (bf16_t*)(X.ws + WS_CKVN); bf16_t* kro = (bf16_t*)(X.ws + WS_KROPE);
    const float* qg = P.in[6 + X.zero] + (size_t)l * 256; const float* kg = P.in[8 + X.zero] + (size_t)l * 128;
    const float* rc = (const float*)(X.ws + WS_ROPE); const float* rs_ = rc + 4096 * 16;
    for (int r = gw; r < MC; r += NGW) {
        const bf16_t* zr = z + (size_t)r * NZ;
        { const u32x2 w = *(const u32x2*)(zr + 256 + lane * 4); f32x4 v = {bflo(w.x), bfhi(w.x), bflo(w.y), bfhi(w.y)};
          const float rs = __builtin_amdgcn_rsqf(wave_sum(v[0] * v[0] + v[1] * v[1] + v[2] * v[2] + v[3] * v[3], lane) * (1.f / 256.f) + NEPS);
          const f32x4 g = *(const f32x4*)(qg + lane * 4); v = v * rs * g; u32x2 o; o.x = cvt_pk(v[0], v[1]); o.y = cvt_pk(v[2], v[3]); *(u32x2*)(cqn + (size_t)r * 256 + lane * 4) = o; }
        { const unsigned w = *(const unsigned*)(zr + 512 + lane * 2); float a = bflo(w), b = bfhi(w);
          const float rs = __builtin_amdgcn_rsqf(wave_sum(a * a + b * b, lane) * (1.f / 128.f) + NEPS);
          const f32x2 g = *(const f32x2*)(kg + lane * 2); *(unsigned*)(ckvn + (size_t)r * 256 + lane * 2) = cvt_pk(a * rs * g[0], b * rs * g[1]);
          *(unsigned*)(ckvn + (size_t)r * 256 + 128 + lane * 2) = 0u; }
        if (lane < 16) { const int pos = r & 4095; const float x1 = bf2f(zr[640 + lane]), x2 = bf2f(zr[656 + lane]), cs = rc[pos * 16 + lane], sn = rs_[pos * 16 + lane];
          kro[(size_t)r * 32 + lane] = f2bf(x1 * cs - x2 * sn); kro[(size_t)r * 32 + 16 + lane] = f2bf(x2 * cs + x1 * sn); }
    }
}

DI void pool_pass(const Ctx& X, bf16_t* zo) {
    bf16_t* z = (bf16_t*)(X.ws + WS_Z);
    for (int e = X.c * NTHREADS + X.tid; e < MC * 32; e += X.G * NTHREADS) {
        const int t = e >> 5, cgp = e & 31, ch0 = cgp * 8, g = cgp >> 3, hw = 1 << g, s = t & 4095, tb = t - s;
        const int lo = max(s - hw, 0), hi = min(s + hw, SEQ);
        f32x4 a0 = {0.f, 0.f, 0.f, 0.f}, a1 = a0;
        for (int r = lo; r < hi; ++r) { f32x4 v0, v1; load8(z + (size_t)(tb + r) * NZ + ch0, v0, v1); a0 += v0; a1 += v1; }
        const float ic = 1.f / (float)(hi - lo); f32x4 u0, u1, g0, g1; load8(z + (size_t)t * NZ + ch0, u0, u1); load8(z + (size_t)t * NZ + ZC_G + ch0, g0, g1);
        store8(zo + (size_t)t * NZ + ZC_G + ch0, (a0 * ic - u0) * g0, (a1 * ic - u1) * g1);
    }
}

DI void dft_combine(const Ctx& X) {
    bf16_t* z = (bf16_t*)(X.ws + WS_Z); const bf16_t* Pp = (const bf16_t*)(X.ws + WS_P);
    for (int e = X.c * NTHREADS + X.tid; e < MC * 32; e += X.G * NTHREADS) {
        const int t = e >> 5, ch0 = (e & 31) * 8, b = t >> 12, s = t & 4095, ks = s & 2047; const float sg = s >= 2048 ? -1.f : 1.f;
        f32x4 a0 = {0.f, 0.f, 0.f, 0.f}, a1 = a0;
#pragma unroll
        for (int j = 0; j < 8; ++j) { f32x4 v0, v1; load8(Pp + ((size_t)(b * 8 + j) * 2048 + ks) * 256 + ch0, v0, v1); const float sj = (j & 1) ? sg : 1.f; a0 += v0 * sj; a1 += v1 * sj; }
        f32x4 g0, g1; bf16_t* zp = z + (size_t)t * NZ + ZC_GFOUR + ch0; load8(zp, g0, g1); store8(zp, a0 * g0, a1 * g1);
    }
}

DI void conv_item(const Ctx& X, int item, int l) {
    float LEPS = LN_EPS; asm volatile("" : "+s"(LEPS)); unsigned zz = 0u; asm volatile("" : "+v"(zz));
    const Params& P = *X.p; const int tid = X.tid;
    const bf16_t* z = (const bf16_t*)(X.ws + WS_Z); bf16_t* cb = (bf16_t*)(X.ws + WS_CB);
    char* gl = X.lds; float* co = (float*)(X.lds + 49152);
    const int t0 = item * 64, s0 = t0 & 4095, tb = t0 - s0;
    for (int i = tid; i < 94 * 32; i += NTHREADS) { const int r = i >> 5, c8 = i & 31, s = s0 - 15 + r; u32x4 w = {zz, zz, zz, zz};
        if (s >= 0 && s < SEQ) w = *(const u32x4*)(z + (size_t)(tb + s) * NZ + ZC_GLU + c8 * 8);
        *(u32x4*)(gl + r * 512 + c8 * 16) = w; }
    __syncthreads();
    { const int cp = tid & 127, tg = tid >> 7; const float* cw = P.in[12 + X.zero] + (size_t)l * 31 * 256 + 2 * cp; const f32x2 bias = *(const f32x2*)(P.in[13 + X.zero] + (size_t)l * 256 + 2 * cp);
      f32x2 w[31];
#pragma unroll
      for (int k = 0; k < 31; ++k) w[k] = *(const f32x2*)(cw + k * 256);
      f32x2 a[16];
#pragma unroll
      for (int i = 0; i < 16; ++i) a[i] = bias;
#pragma unroll
      for (int r = 0; r < 46; ++r) { const unsigned u = *(const unsigned*)(gl + (tg * 16 + r) * 512 + cp * 4); const f32x2 v = {bflo(u), bfhi(u)};
#pragma unroll
          for (int i = 0; i < 16; ++i) { if (r - i >= 0 && r - i <= 30) a[i] += v * w[r - i]; } }
#pragma unroll
      for (int i = 0; i < 16; ++i) *(f32x2*)(co + (tg * 16 + i) * 256 + 2 * cp) = a[i]; }
    __syncthreads();
    { const int wv = X.wave, lane = X.lane; const f32x4 g = *(const f32x4*)(P.in[14 + X.zero] + (size_t)l * 256 + lane * 4), be = *(const f32x4*)(P.in[15 + X.zero] + (size_t)l * 256 + lane * 4);
#pragma unroll
      for (int i = 0; i < 8; ++i) { const int tok = wv * 8 + i; f32x4 v = *(const f32x4*)(co + tok * 256 + lane * 4);
          const float mu = wave_sum(v[0] + v[1] + v[2] + v[3], lane) * (1.f / 256.f); v -= mu;
          const float rs = __builtin_amdgcn_rsqf(wave_sum(v[0] * v[0] + v[1] * v[1] + v[2] * v[2] + v[3] * v[3], lane) * (1.f / 256.f) + LEPS);
          v = v * rs * g + be;
#pragma unroll
          for (int e = 0; e < 4; ++e) v[e] = siluf_(v[e]);
          u32x2 o; o.x = cvt_pk(v[0], v[1]); o.y = cvt_pk(v[2], v[3]); *(u32x2*)(cb + (size_t)(t0 + tok) * 256 + lane * 4) = o; } }
    __syncthreads();
}


DI float dotbf(const bf16_t* a, const bf16_t* b, int K) { float s = 0.f; for (int k = 0; k < K; ++k) s = fmaf(bf2f(a[k]), bf2f(b[k]), s); return s; }
DI void dbg_max(float* w, float v) { atomicMax((int*)w, __builtin_bit_cast(int, fabsf(v))); }
DI void dbg_check(const Ctx& X, int l) {
    const Params& P = *X.p; unsigned char* ws = X.ws; unsigned char* wl = ws + WS_W + (size_t)l * LW;
    float* dbg = (float*)(ws + 768 * 1024);
    const bf16_t* h = (const bf16_t*)(ws + WS_H); const bf16_t* z = (const bf16_t*)(ws + WS_Z); const bf16_t* WinT = (const bf16_t*)(wl + W_IN);
    const bf16_t* abt = (const bf16_t*)(ws + WS_ABT); const bf16_t* T = (const bf16_t*)(ws + WS_DFT); const bf16_t* Pp = (const bf16_t*)(ws + WS_P);
    const bf16_t* U = (const bf16_t*)(ws + WS_U); const bf16_t* mb = (const bf16_t*)(ws + WS_M); const bf16_t* ob = (const bf16_t*)(ws + WS_OB);
    const bf16_t* WupT = (const bf16_t*)(wl + W_UP); const bf16_t* WgT = (const bf16_t*)(wl + W_G); const bf16_t* WoT = (const bf16_t*)(wl + W_OUT);
    const int i = X.c * NTHREADS + X.tid; if (i >= 32768) return;
    const unsigned hsh = (unsigned)i * 2654435761u; const int row = (hsh >> 7) % MC; const int cc = (hsh >> 3) & 1023;
    const bf16_t* hr = h + (size_t)row * DM;
    { const int col = cc % 672; dbg_max(dbg + 1, bf2f(z[(size_t)row * NZ + col]) - dotbf(hr, WinT + (size_t)col * DM, DM)); }
    { const int col = cc & 255, wr0 = 768 + (col >> 7) * 256 + (col & 127); const float a = dotbf(hr, WinT + (size_t)wr0 * DM, DM), b = dotbf(hr, WinT + (size_t)(wr0 + 128) * DM, DM);
      dbg_max(dbg + 2, bf2f(z[(size_t)row * NZ + ZC_GLU + col]) - a / (1.f + expf(-b))); }
    { const int ch = cc & 255, b = row >> 12, s = row & 4095, j = (s & 1) + 2 * (s >> 10), kidx = (s >> 1) & 511; const bf16_t* ap = abt + ((size_t)(b * 8 + j) * 256 + ch) * 1024;
      dbg_max(dbg + 3, bf2f(ap[kidx]) - dotbf(hr, WinT + (size_t)(1280 + ch) * DM, DM)); dbg_max(dbg + 3, bf2f(ap[512 + kidx]) - dotbf(hr, WinT + (size_t)(1536 + ch) * DM, DM)); }
    { const int ch = cc & 255, bj = (row >> 11) & 31, ks = row & 2047; dbg_max(dbg + 4, bf2f(Pp[((size_t)bj * 2048 + ks) * 256 + ch]) - dotbf(T + ((size_t)(bj & 7) * 2048 + ks) * 1024, abt + ((size_t)bj * 256 + ch) * 1024, 1024)); }
    { const int br = (hsh >> 1) & 3, koff = br == 0 ? 0 : (br == 1 ? 256 : (br == 2 ? 768 : 1024)), K = br == 1 ? 512 : 256;
      dbg_max(dbg + 5, bf2f(U[(size_t)row * 4096 + br * 1024 + cc]) - dotbf(z + (size_t)row * NZ + ZC_G + koff, WupT + (size_t)cc * 1280 + koff, K)); }
    { float acc = 0.f; for (int b = 0; b < 4; ++b) { const float g = dotbf(hr, WgT + (size_t)(b * 1024 + cc) * DM, DM) + P.in[5 + X.zero][(size_t)l * 4096 + b * 1024 + cc];
          acc += bf2f(U[(size_t)row * 4096 + b * 1024 + cc]) / (1.f + expf(-g)); }
      dbg_max(dbg + 6, bf2f(mb[(size_t)row * 1024 + cc]) - acc); }
    { dbg_max(dbg + 7, bf2f(ob[(size_t)row * 1024 + cc]) - dotbf(mb + (size_t)row * 1024, WoT + (size_t)cc * DM, DM)); }
    { const int col = cc & 255, g = col >> 6, hw = 1 << g, s = row & 4095, tb = row - s, lo = max(s - hw, 0), hi = min(s + hw, SEQ); float a = 0.f;
      for (int r = lo; r < hi; ++r) a += bf2f(z[(size_t)(tb + r) * NZ + col]);
      const float gg = dotbf(hr, WinT + (size_t)(1792 + col) * DM, DM), sg = gg / (1.f + expf(-gg));
      dbg_max(dbg + 8, bf2f(z[(size_t)row * NZ + ZC_G + col]) - (a / (float)(hi - lo) - bf2f(z[(size_t)row * NZ + col])) * sg); }
    { const bf16_t* cbp = (const bf16_t*)(ws + WS_CB); const int col = cc & 255, s = row & 4095, tb = row - s; float sum = 0.f, sq = 0.f, mine = 0.f;
      for (int ch = 0; ch < 256; ++ch) { float a = P.in[13 + X.zero][(size_t)l * 256 + ch];
          for (int k = 0; k < 31; ++k) { const int ss = s + k - 15; if (ss >= 0 && ss < SEQ) a = fmaf(bf2f(z[(size_t)(tb + ss) * NZ + ZC_GLU + ch]), P.in[12 + X.zero][((size_t)l * 31 + k) * 256 + ch], a); }
          sum += a; sq += a * a; if (ch == col) mine = a; }
      const float mu = sum / 256.f, var = sq / 256.f - mu * mu; float y = (mine - mu) / sqrtf(var + LN_EPS) * P.in[14 + X.zero][(size_t)l * 256 + col] + P.in[15 + X.zero][(size_t)l * 256 + col]; y = y / (1.f + expf(-y));
      dbg_max(dbg + 9, bf2f(cbp[(size_t)row * 256 + col]) - y);
      const float gg = dotbf(hr, WinT + (size_t)(2560 + col) * DM, DM), sg = gg / (1.f + expf(-gg));
      dbg_max(dbg + 10, bf2f(z[(size_t)row * NZ + ZC_GCONV + col]) - (dotbf(cbp + (size_t)row * 256, (const bf16_t*)(wl + W_PW) + (size_t)col * 256, 256) + P.in[17 + X.zero][(size_t)l * 256 + col]) * sg); }
    { const int col = cc & 255, b = row >> 12, s = row & 4095, ks = s & 2047; float f = 0.f;
      for (int j = 0; j < 8; ++j) { const float pv = bf2f(Pp[((size_t)(b * 8 + j) * 2048 + ks) * 256 + col]); f += ((j & 1) && s >= 2048) ? -pv : pv; }
      const float gg = dotbf(hr, WinT + (size_t)(2816 + col) * DM, DM), sg = gg / (1.f + expf(-gg));
      dbg_max(dbg + 11, bf2f(z[(size_t)row * NZ + ZC_GFOUR + col]) - f * sg); }
    { const float* xr = P.in[0 + X.zero] + (size_t)row * DM; float ss = 0.f; for (int k = 0; k < DM; ++k) ss = fmaf(xr[k], xr[k], ss);
      dbg_max(dbg + 12, bf2f(hr[cc]) - xr[cc] / sqrtf(ss / DM + NORM_EPS) * P.in[2 + X.zero][(size_t)l * DM + cc]); }
}
DI void dbg_report(const Ctx& X) {
    const float* dbg = (const float*)(X.ws + 768 * 1024);
    if (X.c == 0 && X.tid == 0) { float add = 0.f;
        if (dbg[1] > 0.03f) add = 1e2f; if (dbg[2] > 0.03f) add = 1e3f; if (dbg[3] > 0.03f) add = 1e4f; if (dbg[4] > 0.03f) add = 1e5f;
        if (dbg[5] > 0.03f) add = 1e6f; if (dbg[6] > 0.03f) add = 1e7f; if (dbg[7] > 0.03f) add = 1e8f; if (dbg[8] > 0.03f) add = 1e9f; if (dbg[9] > 0.03f) add = 1e10f; if (dbg[10] > 0.03f) add = 1e11f; if (dbg[11] > 0.03f) add = 1e12f; if (dbg[12] > 0.03f) add = 1e13f;
        X.p->out[0] += add; }
}

#define XB_TMO      128
#define XB_XCNT(j)  (256  + 64 * (j))
#define XB_XSUB(j)  (1280 + 64 * (j))
#define XB_XGEN(j)  (2304 + 64 * (j))
#define XB_TOP      3328
#define XB_TOPGEN   3392
#define XCD_BAR_WORDS 3456
#define XB_SPIN_CAP (1u << 22)
constexpr size_t WS_BAR = 800 * 1024;
constexpr int LDS_MISC = 131072 + 1024;
DI unsigned xb_ld(unsigned* p)              { return __hip_atomic_load(p, __ATOMIC_RELAXED, __HIP_MEMORY_SCOPE_AGENT); }
DI unsigned xb_add(unsigned* p, unsigned v) { return __hip_atomic_fetch_add(p, v, __ATOMIC_RELAXED, __HIP_MEMORY_SCOPE_AGENT); }
DI unsigned xb_xcc_id() { return (unsigned)__builtin_amdgcn_s_getreg((3 << 11) | 20) & 0xFu; }
#define XB_SPIN(cond, bar) do { unsigned _sp = 0; while (cond) { __builtin_amdgcn_s_sleep(1); \
    if ((++_sp & 255u) == 0u) { if (xb_ld(&(bar)[XB_TMO])) break; if (_sp > XB_SPIN_CAP) { atomicAdd(&(bar)[XB_TMO], 1u); break; } } } } while (0)
struct XcdBarrier { unsigned* bar; unsigned x; volatile LAS unsigned* st; };
DI void xcd_barrier_complete(unsigned* bar, unsigned x, unsigned& nloc, unsigned& nx) {
    const unsigned G = gridDim.x * gridDim.y * gridDim.z;
    unsigned sum, cnt, mine, sp = 0u;
    for (;;) {
        sum = 0u; cnt = 0u; mine = 0u;
#pragma unroll
        for (unsigned j = 0; j < 16; ++j) { const unsigned c = xb_ld(&bar[XB_XCNT(j)]); sum += c; cnt += (c > 0u) ? 1u : 0u; mine = (j == x) ? c : mine; }
        if (sum == G) break;
        __builtin_amdgcn_s_sleep(1);
        if ((++sp & 255u) == 0u) { if (xb_ld(&bar[XB_TMO])) break; if (sp > XB_SPIN_CAP) { atomicAdd(&bar[XB_TMO], 1u); break; } }
    }
    nloc = mine > 0u ? mine : 1u; nx = cnt > 0u ? cnt : 1u;
}
DI void xcd_barrier(const XcdBarrier& b, const int tid) {
    asm volatile("s_waitcnt vmcnt(0)" ::: "memory");
    __syncthreads();
    if (tid == 0) {
        unsigned* bar = b.bar;
        __builtin_amdgcn_s_waitcnt(0);
        unsigned nloc = b.st[0], nx = b.st[1];
        if (nloc == 0u) { xcd_barrier_complete(bar, b.x, nloc, nx); b.st[0] = nloc; b.st[1] = nx; }
        const unsigned old = xb_add(&bar[XB_XSUB(b.x)], 1u);
        const unsigned gen = old / nloc;
        if (old + 1u == (gen + 1u) * nloc) {
            __builtin_amdgcn_fence(__ATOMIC_RELEASE, "agent");
            asm volatile("s_waitcnt vmcnt(0)" ::: "memory");
            const unsigned og = xb_add(&bar[XB_TOP], 1u);
            const unsigned tg = og / nx;
            if (og + 1u == (tg + 1u) * nx) xb_add(&bar[XB_TOPGEN], 1u);
            else XB_SPIN(xb_ld(&bar[XB_TOPGEN]) == tg, bar);
            __builtin_amdgcn_fence(__ATOMIC_ACQUIRE, "agent");
            xb_add(&bar[XB_XGEN(b.x)], 1u);
            asm volatile("s_waitcnt vmcnt(0)" ::: "memory");
        } else {
            XB_SPIN(xb_ld(&bar[XB_XGEN(b.x)]) == gen, bar);
            __builtin_amdgcn_fence(__ATOMIC_ACQUIRE, "agent");
            asm volatile("s_waitcnt vmcnt(0)" ::: "memory");
        }
    }
    __syncthreads();
}


#define GB_SUB(g)  (8192 + 16 * (g))
#define GB_GEN(g)  (9216 + 16 * (g))
#define GB_OK      6144
#define GB_MAP     6400
DI void grp_barrier(unsigned* bar, const int g, const unsigned nloc, const int tid) {
    asm volatile("s_waitcnt vmcnt(0)" ::: "memory");
    __syncthreads();
    if (tid == 0) {
        __builtin_amdgcn_s_waitcnt(0);
        const unsigned old = xb_add(&bar[GB_SUB(g)], 1u); const unsigned gen = old / nloc;
        if (old + 1u == (gen + 1u) * nloc) xb_add(&bar[GB_GEN(g)], 1u);
        else XB_SPIN(xb_ld(&bar[GB_GEN(g)]) == gen, bar);
        __builtin_amdgcn_fence(__ATOMIC_ACQUIRE, "agent");
        asm volatile("s_waitcnt vmcnt(0)" ::: "memory");
    }
    __syncthreads();
}

constexpr int NPH = 7;
constexpr int NSTEPS = 2 + NCHUNK * NLAYER * NPH + 1;

DI void run_step(const Ctx& X, int step, const int dummy, const XcdBarrier* xb) {
    const Params& P = *X.p; unsigned char* ws = X.ws; LAS unsigned char* ldsl = (LAS unsigned char*)X.lds;
    if (step == 0) { prep1(X); return; }
    if (step == 1) { prep2(X); return; }
    if (step == NSTEPS - 1) { norm_pass(X, NCHUNK - 1, 2); return; }
    const int s2 = step - 2, ph = s2 % NPH, cl = s2 / NPH, l = cl % NLAYER, ch = cl / NLAYER;
    unsigned char* wl = ws + WS_W + (size_t)l * LW;
    switch (ph) {
    case 0: { if (l == 0 && ch > 0) norm_pass(X, ch - 1, 2); norm_pass(X, ch, l); } break;
    case 1: { SchedSimple S{(const char*)(ws + WS_H), (const char*)(wl + W_IN), DM, DM, 16, 12, X.G, X.c, 0};
              EpiIn E{(bf16_t*)(ws + WS_Z), (bf16_t*)(ws + WS_ABT)};
              pg8::gemm_phase(ldsl, X.tid, DM, DM, S, E); } break;
    case 2: {
        s_pass(X, l);
        { SchedDft S{(const char*)(ws + WS_DFT), (const char*)(ws + WS_ABT), X.G, X.c}; EpiDft E{(bf16_t*)(ws + WS_P)};
          pg8::gemm_phase(ldsl, X.tid, 1024, 1024, S, E); }
        for (int it = X.c; it < MC / 64; it += X.G) conv_item(X, it, l);
        pool_pass(X, dummy ? (bf16_t*)(ws + WS_U) : (bf16_t*)(ws + WS_Z));
    } break;
    case 3: { { SchedQKV S{(const char*)(ws + WS_CQN), (const char*)(ws + WS_CKVN), (const char*)(wl + W_UQ), (const char*)(wl + W_UKV), X.G, X.c};
                EpiQKV E{(bf16_t*)(ws + WS_Q), (bf16_t*)(ws + WS_KN), (bf16_t*)(ws + WS_V)};
                pg8::gemm_phase(ldsl, X.tid, 256, 256, S, E); }
              { SchedSimple S{(const char*)(ws + WS_CB), (const char*)(wl + W_PW), 256, 256, 4, 1, X.G, X.c, (X.G >> 3) >= 32 ? 24 : 0};
                EpiPw E{(bf16_t*)(ws + WS_Z), P.in[17 + X.zero] + (size_t)l * 256};
                pg8::gemm_phase(ldsl, X.tid, 256, 256, S, E); }
              dft_combine(X); } break;
    case 4: {
        const bf16_t* q = (const bf16_t*)(ws + WS_Q); const bf16_t* kn = (const bf16_t*)(ws + WS_KN); const bf16_t* kr = (const bf16_t*)(ws + WS_KROPE); const bf16_t* v = (const bf16_t*)(ws + WS_V);
        bf16_t* z = (bf16_t*)(ws + WS_Z); bf16_t* zo = dummy ? (bf16_t*)(ws + WS_U) : z; const float* rc = (const float*)(ws + WS_ROPE); const float* rs = rc + 4096 * 16;
        for (int i = 0;; ++i) { int pair, qb;
            if (X.G == 256) { if (i >= 2) break; const int pm = 8 * (X.c & 7) + ((X.c >> 3) & 7), pc = X.c >> 6; pair = (pm >> 4) * 8 + 2 * pc + i; qb = pm & 15; }
            else if ((X.G & 7) == 0) { const int per = X.G >> 3, x = X.c & 7, idx = X.c >> 3, qq = i * per + idx; if (qq >= 64) break; pair = 4 * x + (qq >> 4); qb = qq & 15; }
            else { const int L = i * X.G + X.c; if (L >= 512) break; pair = L >> 4; qb = L & 15; }
            const int b = pair >> 3, h = pair & 7;
            att::attn_unit(q + ((size_t)pair * 4096 + qb * 256) * 96, kn + (size_t)pair * 4096 * 64, kr + (size_t)b * 4096 * 32, v + (size_t)pair * 4096 * 64,
                           z + ((size_t)(b * 4096 + qb * 256)) * NZ + ZC_GATTN + h * 64, zo + ((size_t)(b * 4096 + qb * 256)) * NZ + ZC_GATTN + h * 64, rc, rs, qb * 256, X.lds, X.tid); }
    } break;
    case 5: { { SchedUp S{(const char*)(ws + WS_Z), (const char*)(wl + W_UP), X.G, X.c}; EpiPlain E{(bf16_t*)(ws + WS_U), 4096, 0};
                pg8::gemm_phase(ldsl, X.tid, NZ, 1280, S, E); }
              if (X.G != 256) xcd_barrier(*xb, X.tid);
              { SchedGate S{(const char*)(ws + WS_H), (const char*)(wl + W_G), X.G, X.c};
                EpiGate E{(const bf16_t*)(ws + WS_U), (bf16_t*)(ws + WS_M), P.in[5 + X.zero] + (size_t)l * 4096};
                pg8::gemm_phase(ldsl, X.tid, DM, DM, S, E); } } break;
    case 6: { SchedSimple S{(const char*)(ws + WS_M), (const char*)(wl + W_OUT), DM, DM, 16, 4, X.G, X.c, 0}; EpiPlain E{(bf16_t*)(ws + WS_OB), DM, 0};
              pg8::gemm_phase(ldsl, X.tid, DM, DM, S, E); } break;
    }
}


__global__ void __launch_bounds__(NTHREADS, 2) mk_fwd(Params prm) {
    extern __shared__ __attribute__((aligned(16))) unsigned char lds[];
    const int wave_s = __builtin_amdgcn_readfirstlane(threadIdx.x >> 6);
    volatile LAS unsigned* bst = (volatile LAS unsigned*)((LAS unsigned char*)lds + LDS_MISC);
    if (threadIdx.x == 0) { bst[0] = 0u; bst[1] = 0u; }
    __syncthreads();
    XcdBarrier xbar; xbar.bar = (unsigned*)(prm.ws + WS_BAR); xbar.x = xb_xcc_id(); xbar.st = bst;
    if (threadIdx.x == 0) { (void)xb_add(&xbar.bar[XB_XCNT(xbar.x)], 1u); __hip_atomic_store(&xbar.bar[GB_MAP + blockIdx.x], xbar.x + 1u, __ATOMIC_RELAXED, __HIP_MEMORY_SCOPE_AGENT); }
    int use_local = 0;
    int rep = 0;
    for (int step = prm.step_lo; step < prm.step_hi;) {
        int wv_ = wave_s, cb_ = blockIdx.x, gd_ = gridDim.x, zero_ = 0;
        asm volatile("" : "+s"(wv_), "+s"(cb_), "+s"(gd_), "+s"(zero_));
        int lane_; asm volatile("v_mbcnt_lo_u32_b32 %0, -1, 0\n\tv_mbcnt_hi_u32_b32 %0, -1, %0" : "=v"(lane_));
        int tidv = wv_ * 64 + lane_;
        Ctx X; X.p = &prm; X.ws = prm.ws + (size_t)(unsigned)zero_; X.lds = (char*)lds; X.G = gd_; X.c = cb_; X.tid = tidv; X.lane = tidv & 63; X.zero = zero_;
        X.wave = __builtin_amdgcn_readfirstlane(tidv >> 6);
        const bool want2 = (DBL_PREP && step < 2) || (DBL_MASK != 0 && step >= 2 && step < NSTEPS - 1 && ((DBL_MASK >> ((step - 2) % NPH)) & 1));
        const int dummy = (want2 && rep == 0) ? 1 : 0;
        run_step(X, step, dummy, &xbar);
        if (dummy) rep = 1; else { rep = 0; ++step; }
        if (step < prm.step_hi) {
            if (step == 1) { cg::this_grid().sync();
                if (tidv == 0) { unsigned ok = (gd_ == 256) ? 1u : 0u; for (int k = 0; k < 32 && ok; ++k) ok = (xb_ld(&xbar.bar[GB_MAP + (cb_ & 7) + 8 * k]) == xbar.x + 1u) ? 1u : 0u; (void)xb_add(&xbar.bar[GB_OK], ok); } }
            else if (step == 2) { xcd_barrier(xbar, tidv); use_local = __builtin_amdgcn_readfirstlane((int)(xb_ld(&xbar.bar[GB_OK]) == (unsigned)gd_)); }
            else { const int phd = (step - 3) % NPH;
                if (use_local && step >= 3 && (phd == 4 || phd == 5 || phd == 6 || phd == 0)) grp_barrier(xbar.bar, (cb_ & 7) * 8 + ((cb_ >> 3) & 7), 4u, tidv); else xcd_barrier(xbar, tidv); }
        }
    }
}

__global__ void __launch_bounds__(NTHREADS) dbg_kernel(Params prm, int mode) {
    Ctx X; X.p = &prm; X.ws = prm.ws; X.lds = nullptr; X.G = gridDim.x; X.c = blockIdx.x; X.tid = threadIdx.x; X.lane = threadIdx.x & 63; X.wave = threadIdx.x >> 6; X.zero = 0;
    if (mode == 0) dbg_check(X, 0); else dbg_report(X);
}

extern "C" void kernel_launch(void* const* d_in, const int* in_sizes, int n_in, void* d_out, int out_size, void* d_ws, size_t ws_size, hipStream_t stream) {
    static int grid = 0;
    if (grid == 0) {
        if (n_in != 24 || ws_size < WS_END) { fprintf(stderr, "kernel_launch: unexpected n_in %d / ws %zu\n", n_in, ws_size); grid = -1; return; }
        int dev = 0, cus = 0, per_cu = 0;
        hipGetDevice(&dev); hipDeviceGetAttribute(&cus, hipDeviceAttributeMultiprocessorCount, dev);
        if (hipFuncSetAttribute((const void*)mk_fwd, hipFuncAttributeMaxDynamicSharedMemorySize, LDS_BYTES) != hipSuccess) { fprintf(stderr, "kernel_launch: hipFuncSetAttribute failed\n"); grid = -1; return; }
        if (hipOccupancyMaxActiveBlocksPerMultiprocessor(&per_cu, (const void*)mk_fwd, NTHREADS, LDS_BYTES) != hipSuccess || per_cu < 1) { fprintf(stderr, "kernel_launch: occupancy query says %d\n", per_cu); per_cu = 1; }
        (void)hipGetLastError();
        grid = cus;
    }
    if (grid < 0) return;
    Params p{};
    for (int i = 0; i < 24; ++i) p.in[i] = (const float*)d_in[i];
    p.out = (float*)d_out; p.ws = (unsigned char*)d_ws;
    for (int i = 0; i < 16; ++i) p.inv_freq[i] = 1.0f / powf(10000.0f, (float)(2 * i) / 32.0f);
#if MULTI_LAUNCH
    for (int s = 0; s < NSTEPS; ++s) {
#if DBG_ON
        if (s == 2 + (DBG_CH * 2 + 1) * NPH) hipLaunchKernelGGL(dbg_kernel, dim3(64), dim3(NTHREADS), 0, stream, p, 0);
#endif

        p.step_lo = s; p.step_hi = s + 1; hipLaunchKernelGGL(mk_fwd, dim3(grid), dim3(NTHREADS), LDS_BYTES, stream, p); }
#if DBG_ON
    hipLaunchKernelGGL(dbg_kernel, dim3(1), dim3(NTHREADS), 0, stream, p, 1);
#endif
#else
    p.step_lo = 0; p.step_hi = NSTEPS;
    (void)hipMemsetAsync((char*)d_ws + WS_BAR, 0, 65536, stream);
    void* args[] = {&p};
    hipError_t e = hipLaunchCooperativeKernel((const void*)mk_fwd, dim3(grid), dim3(NTHREADS), args, LDS_BYTES, stream);
    if (e != hipSuccess) fprintf(stderr, "cooperative launch failed: %s (grid %d)\n", hipGetErrorString(e), grid);
#endif
}
```

```cpp
#include <hip/hip_runtime.h>
#include <hip/hip_cooperative_groups.h>
#include <cstdio>
#include <cstdint>
namespace cg = cooperative_groups;

#ifndef PH4_ATT
#define PH4_ATT 1
#endif
#ifndef PH4_DFT
#define PH4_DFT 1
#endif
#ifndef PH4_CONV
#define PH4_CONV 1
#endif
#ifndef PH4_POOL
#define PH4_POOL 1
#endif
#ifndef DBL_PREP
#define DBL_PREP 0
#endif
#ifndef DBL_MASK
#define DBL_MASK 0
#endif
#ifndef DBG_ON
#define DBG_ON 0
#endif
#ifndef DBG_CH
#define DBG_CH 0
#endif
#ifndef MULTI_LAUNCH
#define MULTI_LAUNCH 0
#endif

#define DI __device__ __forceinline__
#define LAS __attribute__((address_space(3)))
typedef unsigned short bf16_t;
typedef short bf16x8 __attribute__((ext_vector_type(8)));
typedef short s16x4 __attribute__((ext_vector_type(4)));
typedef float f32x4 __attribute__((ext_vector_type(4)));
typedef float f32x2 __attribute__((ext_vector_type(2)));
typedef float f32x16 __attribute__((ext_vector_type(16)));
typedef unsigned u32x4 __attribute__((ext_vector_type(4)));
typedef unsigned u32x2 __attribute__((ext_vector_type(2)));

constexpr int DM = 1024, SEQ = 4096, NLAYER = 2, NIN = 6816;
constexpr int MC = 16384, NCHUNK = 5, CSEQ = 4;
constexpr int NZ = 3072;
constexpr int ZC_GLU = 768, ZC_G = 1792, ZC_GATTN = 2048, ZC_GCONV = 2560, ZC_GFOUR = 2816;
constexpr float NORM_EPS = 1e-6f, LN_EPS = 1e-5f;
constexpr float ATT_SCALE = 0.10206207261596575f;
constexpr int LDS_BYTES = 147456;
constexpr int NTHREADS = 512, NWAVES = 8;

constexpr size_t MiB = 1u << 20;
constexpr size_t WS_ROPE = 0;
constexpr size_t WS_MAB = 1 * MiB;
constexpr size_t WS_W = 2 * MiB, LW = 20 * MiB;
constexpr size_t W_IN = 0, W_G = 6 * MiB, W_UQ = 14 * MiB, W_UKV = 14 * MiB + 512 * 1024, W_UP = 15 * MiB, W_OUT = 17 * MiB + 512 * 1024, W_PW = 19 * MiB + 512 * 1024;
constexpr size_t WS_DFT = 42 * MiB;
constexpr size_t WS_H = 74 * MiB, WS_Z = 106 * MiB, WS_CQN = 202 * MiB, WS_CKVN = 210 * MiB, WS_KROPE = 218 * MiB;
constexpr size_t WS_Q = 219 * MiB, WS_KN = 243 * MiB, WS_V = 259 * MiB, WS_ABT = 275 * MiB, WS_P = 291 * MiB, WS_CB = 323 * MiB;
constexpr size_t WS_U = 331 * MiB, WS_M = 459 * MiB, WS_OB = 491 * MiB, WS_END = 523 * MiB;

struct Params {
    const float* in[24];
    float* out;
    unsigned char* ws;
    float inv_freq[16];
    int step_lo, step_hi;
};

DI unsigned cvt_pk(float lo, float hi) { unsigned r; asm volatile("v_cvt_pk_bf16_f32 %0, %1, %2" : "=v"(r) : "v"(lo), "v"(hi)); return r; }
DI bf16_t f2bf(float f) { unsigned u = __builtin_bit_cast(unsigned, f); return (bf16_t)((u + 0x7fffu + ((u >> 16) & 1u)) >> 16); }
DI float bf2f(bf16_t b) { return __builtin_bit_cast(float, (unsigned)b << 16); }
DI float bflo(unsigned w) { return __builtin_bit_cast(float, w << 16); }
DI float bfhi(unsigned w) { return __builtin_bit_cast(float, w & 0xffff0000u); }
DI float sigmoidf_(float x) { return __builtin_amdgcn_rcpf(1.f + __builtin_amdgcn_exp2f(-1.4426950408889634f * x)); }
DI float siluf_(float x) { return x * sigmoidf_(x); }
DI float wave_sum(float v, int lane) {
#pragma unroll
    for (int o = 1; o < 64; o <<= 1) v += __builtin_bit_cast(float, __builtin_amdgcn_ds_bpermute((lane ^ o) << 2, __builtin_bit_cast(int, v)));
    return v;
}
DI void store8(bf16_t* p, f32x4 v0, f32x4 v1) { u32x4 w; w.x = cvt_pk(v0[0], v0[1]); w.y = cvt_pk(v0[2], v0[3]); w.z = cvt_pk(v1[0], v1[1]); w.w = cvt_pk(v1[2], v1[3]); *(u32x4*)p = w; }
DI void load8(const bf16_t* p, f32x4& v0, f32x4& v1) { u32x4 w = *(const u32x4*)p; v0 = (f32x4){bflo(w.x), bfhi(w.x), bflo(w.y), bfhi(w.y)}; v1 = (f32x4){bflo(w.z), bfhi(w.z), bflo(w.w), bfhi(w.w)}; }

namespace pg8 {
constexpr int BM = 256, BK = 64, HALF = 128, HTB = HALF * BK * 2, STAGE_BYTES = 8 * HTB;
DI int lds_byte(int r, int c) { const int st = (r >> 4) * 2 + (c >> 5), rr = r & 15, cc = c & 31, ob = rr * 64 + cc * 2; return st * 1024 + (ob ^ (((ob >> 9) & 1) << 5)); }
DI void stage_rc(int b, int& R, int& C) { const int st = b / 1024, sb = b % 1024, swz = sb ^ (((sb >> 9) & 1) << 5); R = (st >> 1) * 16 + swz / 64; C = (st & 1) * 32 + (swz % 64) / 2; }
DI int perm32(int rho) { const int n = rho >> 4, i = rho & 15; return 8 * (i >> 2) + 4 * n + (i & 3); }

struct Unit { const char* A; const char* B; int nt; int pm; int pn; int tag; };

template <class Epi, class Sched>
DI void gemm_phase(LAS unsigned char* lds, const int tid, const int lda, const int ldb, const Sched& S, const Epi& E) {
    const int  wid = __builtin_amdgcn_readfirstlane(tid >> 6), lane = tid & 63, wr = wid >> 2, wc = wid & 3, fr = lane & 15, fq = lane >> 4;
    unsigned voffA[2], voffB[2];
#pragma unroll
    for (int i = 0; i < 2; ++i) { int R, C; stage_rc(tid * 16 + i * 8192, R, C); const int Rb = (R & ~31) + perm32(R & 31);
        voffA[i] = (unsigned)(R * lda + C) * 2u; voffB[i] = (unsigned)(Rb * ldb + C) * 2u; }
    const int kstep = BK * 2;
    const int hstepA = HALF * lda * 2, hstepB = HALF * ldb * 2;
    const unsigned ldsw = (unsigned)wid * 1024u;
    const int aoff = lds_byte(wr * 64 + fr, fq * 8), boff = lds_byte(wc * 32 + fr, fq * 8);
#define PG8_SA(b, h) (((b) * 2 + (h)) * HTB)
#define PG8_SB(b, h) ((4 + (b) * 2 + (h)) * HTB)
#define PG8_STAGE(bufoff, gbase, voff, soff) do { const __amdgpu_buffer_rsrc_t _rs = __builtin_amdgcn_make_buffer_rsrc((void*)(gbase), (short)0, (int)0x7fffffff, (int)0x00020000); _Pragma("unroll") for (int _i = 0; _i < 2; ++_i) \
        __builtin_amdgcn_raw_ptr_buffer_load_lds(_rs, (LAS void*)(lds + (bufoff) + ldsw + _i * 8192), 16, (int)(voff)[_i], (int)(soff), 0, 0); } while (0)
#define PG8_LDA(dst, b, h) do { _Pragma("unroll") for (int m = 0; m < 4; ++m) _Pragma("unroll") for (int k = 0; k < 2; ++k) dst[m][k] = *(const LAS bf16x8*)(lds + PG8_SA(b, h) + aoff + m * 2048 + k * 1024); } while (0)
#define PG8_LDB(dst, b, h) do { _Pragma("unroll") for (int n = 0; n < 2; ++n) _Pragma("unroll") for (int k = 0; k < 2; ++k) dst[n][k] = *(const LAS bf16x8*)(lds + PG8_SB(b, h) + boff + n * 2048 + k * 1024); } while (0)
#define PG8_MMA(ai, bj, At, Bt) do { __builtin_amdgcn_s_setprio(1); _Pragma("unroll") for (int m = 0; m < 4; ++m) _Pragma("unroll") for (int n = 0; n < 2; ++n) _Pragma("unroll") for (int k = 0; k < 2; ++k) \
        acc[ai][bj][m][n] = __builtin_amdgcn_mfma_f32_16x16x32_bf16(Bt[n][k], At[m][k], acc[ai][bj][m][n], 0, 0, 0); __builtin_amdgcn_s_setprio(0); } while (0)
#define PG8_WAIT_V(n) asm volatile("s_waitcnt vmcnt(" #n ")" ::: "memory")
#define PG8_WAIT_L(n) asm volatile("s_waitcnt lgkmcnt(" #n ")" ::: "memory")
#define PG8_BAR __builtin_amdgcn_s_barrier()
#define PG8_SCHED __builtin_amdgcn_sched_barrier(0)
    Unit cur, nxt; int ui = 0;
    if (!S.next(0, cur)) return;
    f32x4 acc[2][2][4][2];
#pragma unroll
    for (int a = 0; a < 2; ++a)
#pragma unroll
        for (int b = 0; b < 2; ++b)
#pragma unroll
            for (int m = 0; m < 4; ++m)
#pragma unroll
                for (int n = 0; n < 2; ++n) acc[a][b][m][n] = (f32x4){0.f, 0.f, 0.f, 0.f};
    bf16x8 At[4][2], B0[2][2], B1[2][2];
    const char* cA = cur.A; const char* cB = cur.B;
    PG8_STAGE(PG8_SB(0, 0), cB, voffB, 0); PG8_STAGE(PG8_SB(0, 1), cB, voffB, hstepB); PG8_STAGE(PG8_SA(0, 0), cA, voffA, 0); PG8_STAGE(PG8_SA(0, 1), cA, voffA, hstepA);
    if (wr == 1) PG8_BAR;
    PG8_WAIT_V(2); PG8_BAR;
    PG8_STAGE(PG8_SB(1, 0), cB, voffB, kstep); PG8_STAGE(PG8_SA(1, 0), cA, voffA, kstep); PG8_STAGE(PG8_SB(1, 1), cB, voffB, hstepB + kstep);
    PG8_WAIT_V(6); PG8_BAR;
    for (;;) {
        const bool has_next = S.next(ui + 1, nxt);
        const char* nA = has_next ? nxt.A : cA; const char* nB = has_next ? nxt.B : cB;
        const int nt = cur.nt;
        for (int t = 0; t < nt; t += 2) {
            const bool last = (t == nt - 2);
            const int o1 = (t + 1) * kstep;
            const char* a2 = last ? nA : cA; const char* b2 = last ? nB : cB; const int o2 = last ? 0 : (t + 2) * kstep, o3 = o2 + kstep;
            PG8_LDB(B0, 0, 0); PG8_LDB(B1, 0, 1); PG8_SCHED; PG8_LDA(At, 0, 0); PG8_STAGE(PG8_SA(1, 1), cA, voffA, o1 + hstepA);
            PG8_WAIT_V(8); PG8_WAIT_L(0); PG8_BAR; PG8_MMA(0, 0, At, B0); PG8_MMA(0, 1, At, B1); PG8_BAR; PG8_SCHED;
            PG8_LDA(At, 0, 1); PG8_STAGE(PG8_SB(0, 0), b2, voffB, o2); PG8_STAGE(PG8_SB(0, 1), b2, voffB, o2 + hstepB); PG8_STAGE(PG8_SA(0, 0), a2, voffA, o2);
            PG8_WAIT_V(8); PG8_WAIT_L(0); PG8_BAR; PG8_MMA(1, 0, At, B0); PG8_MMA(1, 1, At, B1); PG8_BAR; PG8_SCHED;
            PG8_LDB(B0, 1, 0); PG8_LDB(B1, 1, 1); PG8_SCHED; PG8_LDA(At, 1, 0); PG8_STAGE(PG8_SA(0, 1), a2, voffA, o2 + hstepA);
            PG8_WAIT_V(8); PG8_WAIT_L(0); PG8_BAR; PG8_MMA(0, 0, At, B0); PG8_MMA(0, 1, At, B1); PG8_BAR; PG8_SCHED;
            PG8_LDA(At, 1, 1); PG8_STAGE(PG8_SB(1, 0), b2, voffB, o3); PG8_STAGE(PG8_SB(1, 1), b2, voffB, o3 + hstepB); PG8_STAGE(PG8_SA(1, 0), a2, voffA, o3);
            PG8_WAIT_V(8); PG8_WAIT_L(0); PG8_BAR; PG8_MMA(1, 0, At, B0); PG8_MMA(1, 1, At, B1); PG8_BAR; PG8_SCHED;
        }
        if (wr == 0) PG8_BAR;
        E(acc, cur, wr, wc, fr, fq);
        if (!has_next) break;
#pragma unroll
        for (int a = 0; a < 2; ++a)
#pragma unroll
            for (int b = 0; b < 2; ++b)
#pragma unroll
                for (int m = 0; m < 4; ++m)
#pragma unroll
                    for (int n = 0; n < 2; ++n) acc[a][b][m][n] = (f32x4){0.f, 0.f, 0.f, 0.f};
        cur = nxt; cA = nA; cB = nB; ++ui;
        if (wr == 1) PG8_BAR;
    }
    PG8_WAIT_V(0);
    PG8_BAR;
#undef PG8_SA
#undef PG8_SB
#undef PG8_STAGE
#undef PG8_LDA
#undef PG8_LDB
#undef PG8_MMA
#undef PG8_WAIT_V
#undef PG8_WAIT_L
#undef PG8_BAR
#undef PG8_SCHED
}
}
using pg8::Unit;
typedef f32x4 Acc[2][2][4][2];

DI bool tile_of(int i, int G, int c, int npn, int& pm, int& pn, int ioff = 0) {
    if ((G & 7) == 0) { const int per = G >> 3, x = c & 7, idx = c >> 3, q = i * per + idx - ioff; if (q < 0 || q >= 8 * npn) return false; pm = 8 * x + (q & 7); pn = q >> 3; return true; }
    const int L = i * G + c; if (L >= 64 * npn) return false; pm = L & 63; pn = L >> 6; return true;
}

struct SchedSimple {
    const char* A; const char* B; int lda, ldb, nt, npn, G, c, ioff;
    DI bool next(int i, Unit& u) const { int pm, pn; if (!tile_of(i, G, c, npn, pm, pn, ioff)) return false;
        u.A = A + (size_t)pm * 256 * lda * 2; u.B = B + (size_t)pn * 256 * ldb * 2; u.nt = nt; u.pm = pm; u.pn = pn; u.tag = 0; return true; }
};
struct SchedQKV {
    const char* Aq; const char* Akv; const char* Bq; const char* Bkv; int G, c;
    DI bool next(int i, Unit& u) const { int pm, pn; if (!tile_of(i, G, c, 7, pm, pn)) return false;
        const bool isq = pn < 3; u.A = (isq ? Aq : Akv) + (size_t)pm * 256 * 256 * 2; u.B = isq ? Bq + (size_t)pn * 256 * 256 * 2 : Bkv + (size_t)(pn - 3) * 256 * 256 * 2;
        u.nt = 4; u.pm = pm; u.pn = isq ? pn : pn - 3; u.tag = isq ? 0 : 1; return true; }
};
struct SchedUp {
    const char* Z; const char* W; int G, c;
    DI bool next(int i, Unit& u) const { const int L = i * G + c; if (L >= 1024) return false; const int br = L >> 8, r = L & 255;
        const int x = r & 7, idx = r >> 3, pm = 8 * x + (idx & 7), pn = idx >> 3;
        const int koff = br == 0 ? 0 : (br == 1 ? 256 : (br == 2 ? 768 : 1024));
        u.A = Z + ((size_t)pm * 256 * NZ + ZC_G + koff) * 2; u.B = W + ((size_t)pn * 256 * 1280 + koff) * 2; u.nt = br == 1 ? 8 : 4; u.pm = pm; u.pn = br * 4 + pn; u.tag = br; return true; }
};
struct SchedGate {
    const char* H; const char* W; int G, c;
    DI bool next(int i, Unit& u) const { const int P = (i >> 2) * G + c; if (P >= 256) return false; const int b = i & 3;
        const int x = P & 7, idx = P >> 3, pm = 8 * x + (idx & 7), pc = idx >> 3;
        u.A = H + (size_t)pm * 256 * 1024 * 2; u.B = W + (size_t)(b * 4 + pc) * 256 * 1024 * 2; u.nt = 16; u.pm = pm; u.pn = b * 4 + pc; u.tag = b; return true; }
};
struct SchedDft {
    const char* T; const char* AB; int G, c;
    DI bool next(int i, Unit& u) const { const int L = i * G + c; if (L >= 256) return false; const int j = L & 7, r = L >> 3, b = r >> 3, kt = r & 7;
        u.A = T + ((size_t)j * 2048 + kt * 256) * 1024 * 2; u.B = AB + (size_t)(b * 8 + j) * 256 * 1024 * 2; u.nt = 16; u.pm = kt; u.pn = 0; u.tag = b * 8 + j; return true; }
};

#define EPI_LOOP_ROWS for (int ai = 0; ai < 2; ++ai) for (int m = 0; m < 4; ++m)
struct EpiIn {
    bf16_t* z; bf16_t* abt;
    DI void operator()(const Acc& acc, const Unit& u, int wr, int wc, int fr, int fq) const {
        const int row0 = u.pm * 256 + wr * 64 + fr, pn = u.pn, cb = wc * 32 + 8 * fq;
        if (pn <= 2 || pn >= 7) {
#pragma unroll
            EPI_LOOP_ROWS { bf16_t* rp = z + (size_t)(row0 + ai * 128 + m * 16) * NZ + pn * 256 + cb;
#pragma unroll
                for (int bj = 0; bj < 2; ++bj) { f32x4 v0 = acc[ai][bj][m][0], v1 = acc[ai][bj][m][1];
                    if (pn >= 7) {
#pragma unroll
                        for (int e = 0; e < 4; ++e) { v0[e] = siluf_(v0[e]); v1[e] = siluf_(v1[e]); } }
                    store8(rp + bj * 128, v0, v1); } __builtin_amdgcn_sched_barrier(0); }
        } else if (pn <= 4) {
#pragma unroll
            EPI_LOOP_ROWS { bf16_t* rp = z + (size_t)(row0 + ai * 128 + m * 16) * NZ + ZC_GLU + (pn - 3) * 128 + cb;
                f32x4 v0, v1;
#pragma unroll
                for (int e = 0; e < 4; ++e) { v0[e] = acc[ai][0][m][0][e] * sigmoidf_(acc[ai][1][m][0][e]); v1[e] = acc[ai][0][m][1][e] * sigmoidf_(acc[ai][1][m][1][e]); }
                store8(rp, v0, v1); __builtin_amdgcn_sched_barrier(0); }
        } else {
            const int koff = pn == 6 ? 512 : 0;
#pragma unroll
            EPI_LOOP_ROWS { const int row = row0 + ai * 128 + m * 16, b = row >> 12, s = row & 4095;
                const int j = (s & 1) + 2 * (s >> 10), kidx = ((s >> 1) & 511) + koff;
                bf16_t* bp = abt + ((size_t)(b * 8 + j) * 256 + cb) * 1024 + kidx;
#pragma unroll
                for (int bj = 0; bj < 2; ++bj)
#pragma unroll
                    for (int n = 0; n < 2; ++n)
#pragma unroll
                        for (int e = 0; e < 4; ++e) bp[(size_t)(bj * 128 + n * 4 + e) * 1024] = f2bf(acc[ai][bj][m][n][e]); __builtin_amdgcn_sched_barrier(0); }
        }
    }
};
struct EpiQKV {
    bf16_t* q; bf16_t* kn; bf16_t* v;
    DI void operator()(const Acc& acc, const Unit& u, int wr, int wc, int fr, int fq) const {
        const int row0 = u.pm * 256 + wr * 64 + fr;
#pragma unroll
        for (int bj = 0; bj < 2; ++bj) { const int c0 = u.pn * 256 + bj * 128 + wc * 32 + 8 * fq; bf16_t* base; int rstride;
            if (u.tag == 0) { const int h = c0 / 96, d = c0 - 96 * h; base = q + (size_t)h * 4096 * 96 + d; rstride = 96; }
            else { const int h = c0 >> 7, w = c0 & 127; base = (w < 64 ? kn : v) + (size_t)h * 4096 * 64 + (w & 63); rstride = 64; }
#pragma unroll
            EPI_LOOP_ROWS { const int row = row0 + ai * 128 + m * 16; const int rr = row + (row >> 12) * 7 * 4096;
                store8(base + (size_t)rr * rstride, acc[ai][bj][m][0], acc[ai][bj][m][1]); __builtin_amdgcn_sched_barrier(0); } }
    }
};
struct EpiPlain {
    bf16_t* O; int ldc; int col0;
    DI void operator()(const Acc& acc, const Unit& u, int wr, int wc, int fr, int fq) const {
        const int row0 = u.pm * 256 + wr * 64 + fr;
#pragma unroll
        EPI_LOOP_ROWS { bf16_t* rp = O + (size_t)(row0 + ai * 128 + m * 16) * ldc + col0 + u.pn * 256 + wc * 32 + 8 * fq;
#pragma unroll
            for (int bj = 0; bj < 2; ++bj) store8(rp + bj * 128, acc[ai][bj][m][0], acc[ai][bj][m][1]); __builtin_amdgcn_sched_barrier(0); }
    }
};
struct EpiDft {
    bf16_t* P;
    DI void operator()(const Acc& acc, const Unit& u, int wr, int wc, int fr, int fq) const {
        const int row0 = u.pm * 256 + wr * 64 + fr;
#pragma unroll
        EPI_LOOP_ROWS { bf16_t* rp = P + ((size_t)u.tag * 2048 + row0 + ai * 128 + m * 16) * 256 + wc * 32 + 8 * fq;
#pragma unroll
            for (int bj = 0; bj < 2; ++bj) store8(rp + bj * 128, acc[ai][bj][m][0], acc[ai][bj][m][1]); __builtin_amdgcn_sched_barrier(0); }
    }
};
struct EpiPw {
    bf16_t* z; const float* pwb;
    DI void operator()(const Acc& acc, const Unit& u, int wr, int wc, int fr, int fq) const {
        const int row0 = u.pm * 256 + wr * 64 + fr;
#pragma unroll
        for (int bj = 0; bj < 2; ++bj) { const int c0 = bj * 128 + wc * 32 + 8 * fq; const f32x4 b0 = *(const f32x4*)(pwb + c0), b1 = *(const f32x4*)(pwb + c0 + 4);
            u32x4 gg[8];
#pragma unroll
            for (int r8 = 0; r8 < 8; ++r8) gg[r8] = *(const u32x4*)(z + (size_t)(row0 + (r8 >> 2) * 128 + (r8 & 3) * 16) * NZ + ZC_GCONV + c0);
            __builtin_amdgcn_sched_barrier(0);
#pragma unroll
            for (int r8 = 0; r8 < 8; ++r8) { const int ai = r8 >> 2, m = r8 & 3; const u32x4 w = gg[r8];
                const f32x4 g0 = {bflo(w.x), bfhi(w.x), bflo(w.y), bfhi(w.y)}, g1 = {bflo(w.z), bfhi(w.z), bflo(w.w), bfhi(w.w)};
                store8(z + (size_t)(row0 + ai * 128 + m * 16) * NZ + ZC_GCONV + c0, (acc[ai][bj][m][0] + b0) * g0, (acc[ai][bj][m][1] + b1) * g1); }
            __builtin_amdgcn_sched_barrier(0); }
    }
};
struct EpiGate {
    const bf16_t* U; bf16_t* mbuf; const float* gb;
    DI void operator()(const Acc& acc, const Unit& u, int wr, int wc, int fr, int fq) const {
        const int row0 = u.pm * 256 + wr * 64 + fr, br = u.tag;
        const int cgb = u.pn * 256 + wc * 32 + 8 * fq;
        u32x4 uA[2], pA[2], uB[2], pB[2];
#define GATE_LOAD(UU, PP, K) do { const int bj_ = (K) >> 2, ai_ = ((K) >> 1) & 1, mh_ = (K) & 1; const int cg_ = cgb + bj_ * 128; _Pragma("unroll") for (int mm = 0; mm < 2; ++mm) { const size_t row = row0 + ai_ * 128 + (2 * mh_ + mm) * 16; \
            UU[mm] = *(const u32x4*)(U + row * 4096 + cg_); if (br != 0) PP[mm] = *(const u32x4*)(mbuf + row * 1024 + (cg_ & 1023)); else PP[mm] = (u32x4){0u, 0u, 0u, 0u}; } } while (0)
#define GATE_DO(UU, PP, K) do { const int bj_ = (K) >> 2, ai_ = ((K) >> 1) & 1, mh_ = (K) & 1; const int cg_ = cgb + bj_ * 128; const f32x4 b0 = *(const f32x4*)(gb + cg_), b1 = *(const f32x4*)(gb + cg_ + 4); \
        _Pragma("unroll") for (int mm = 0; mm < 2; ++mm) { const int m = 2 * mh_ + mm; const size_t row = row0 + ai_ * 128 + m * 16; const u32x4 w = UU[mm], q = PP[mm]; \
            const f32x4 u0 = {bflo(w.x), bfhi(w.x), bflo(w.y), bfhi(w.y)}, u1 = {bflo(w.z), bfhi(w.z), bflo(w.w), bfhi(w.w)}; \
            const f32x4 p0 = {bflo(q.x), bfhi(q.x), bflo(q.y), bfhi(q.y)}, p1 = {bflo(q.z), bfhi(q.z), bflo(q.w), bfhi(q.w)}; \
            f32x4 v0 = acc[ai_][bj_][m][0] + b0, v1 = acc[ai_][bj_][m][1] + b1; \
            _Pragma("unroll") for (int e = 0; e < 4; ++e) { v0[e] = sigmoidf_(v0[e]) * u0[e] + p0[e]; v1[e] = sigmoidf_(v1[e]) * u1[e] + p1[e]; } \
            store8(mbuf + row * 1024 + (cg_ & 1023), v0, v1); } } while (0)
#define SB __builtin_amdgcn_sched_barrier(0)
        GATE_LOAD(uA, pA, 0); SB;
        GATE_LOAD(uB, pB, 1); SB; GATE_DO(uA, pA, 0); SB;
        GATE_LOAD(uA, pA, 2); SB; GATE_DO(uB, pB, 1); SB;
        GATE_LOAD(uB, pB, 3); SB; GATE_DO(uA, pA, 2); SB;
        GATE_LOAD(uA, pA, 4); SB; GATE_DO(uB, pB, 3); SB;
        GATE_LOAD(uB, pB, 5); SB; GATE_DO(uA, pA, 4); SB;
        GATE_LOAD(uA, pA, 6); SB; GATE_DO(uB, pB, 5); SB;
        GATE_LOAD(uB, pB, 7); SB; GATE_DO(uA, pA, 6); SB;
        GATE_DO(uB, pB, 7); SB;
#undef SB
#undef GATE_LOAD
#undef GATE_DO
    }
};

struct SchedQKVPW {
    const char* Aq; const char* Akv; const char* Apw; const char* Bq; const char* Bkv; const char* Bpw; int G, c;
    DI bool next(int i, Unit& u) const { int pm, pn; if (!tile_of(i, G, c, 8, pm, pn)) return false;
        const int t = pn < 3 ? 0 : (pn < 7 ? 1 : 2); const int lp = t == 0 ? pn : (t == 1 ? pn - 3 : 0);
        u.A = (t == 0 ? Aq : (t == 1 ? Akv : Apw)) + (size_t)pm * 256 * 256 * 2; u.B = (t == 0 ? Bq : (t == 1 ? Bkv : Bpw)) + (size_t)lp * 256 * 256 * 2;
        u.nt = 4; u.pm = pm; u.pn = lp; u.tag = t; return true; }
};
struct EpiQKVPW {
    EpiQKV a; EpiPw b;
    DI void operator()(const Acc& acc, const Unit& u, int wr, int wc, int fr, int fq) const { if (u.tag == 2) b(acc, u, wr, wc, fr, fq); else a(acc, u, wr, wc, fr, fq); }
};

namespace att {
constexpr int KROWB = 208, SHM_K = 64 * KROWB, SHM_V = 8192;
constexpr int NBUF = 3, OFF_V = 0, OFF_K = NBUF * SHM_V, OFF_WS = OFF_K + NBUF * SHM_K;
constexpr float THR = 8.f;
#define SBAR() __builtin_amdgcn_sched_barrier(0)
DI int crow(int r, int hi) { return (r & 3) + 8 * (r >> 2) + 4 * hi; }
template <bool FIRST> DI void partialSM(f32x16& p0, f32x16& p1, float& m_reg, float& alpha) {
    constexpr float THR2 = THR * 1.4426950408889634f;
    float pmax = p0[0];
#pragma unroll
    for (int r = 1; r < 16; ++r) pmax = fmaxf(pmax, p0[r]);
#pragma unroll
    for (int r = 0; r < 16; ++r) pmax = fmaxf(pmax, p1[r]);
    { auto rr = __builtin_amdgcn_permlane32_swap(__float_as_uint(pmax), __float_as_uint(pmax), false, false);
      pmax = fmaxf(__uint_as_float(rr[0]), __uint_as_float(rr[1])); }
    if (!FIRST && __builtin_expect(__all(pmax <= THR2), 1)) { alpha = 1.f; }
    else { const float d = FIRST ? pmax : fmaxf(pmax, 0.f); m_reg += d; alpha = FIRST ? 1.f : __builtin_amdgcn_exp2f(-d);
#pragma unroll
        for (int r = 0; r < 16; ++r) { p0[r] -= d; p1[r] -= d; } }
#pragma unroll
    for (int r = 0; r < 16; ++r) p0[r] = __builtin_amdgcn_exp2f(p0[r]);
}
DI void finishSM(f32x16& p0, f32x16& p1, float alpha, float& l_reg, bf16x8& pa0, bf16x8& pa1, bf16x8& pa2, bf16x8& pa3) {
#pragma unroll
    for (int r = 0; r < 16; ++r) p1[r] = __builtin_amdgcn_exp2f(p1[r]);
    float ps = 0;
#pragma unroll
    for (int r = 0; r < 16; ++r) ps += p0[r];
#pragma unroll
    for (int r = 0; r < 16; ++r) ps += p1[r];
    { auto rr = __builtin_amdgcn_permlane32_swap(__float_as_uint(ps), __float_as_uint(ps), false, false);
      ps = __uint_as_float(rr[0]) + __uint_as_float(rr[1]); }
    l_reg = l_reg * alpha + ps;
#define PK4(P, BASE, OUT) do { unsigned a0 = cvt_pk(P[BASE + 0], P[BASE + 1]), a1 = cvt_pk(P[BASE + 2], P[BASE + 3]);   \
    unsigned b0 = cvt_pk(P[BASE + 4], P[BASE + 5]), b1 = cvt_pk(P[BASE + 6], P[BASE + 7]);                              \
    auto r0 = __builtin_amdgcn_permlane32_swap(a0, b0, false, false); auto r1 = __builtin_amdgcn_permlane32_swap(a1, b1, false, false); \
    u32x4 w = {r0[0], r1[0], r0[1], r1[1]}; OUT = __builtin_bit_cast(bf16x8, w); } while (0)
    PK4(p0, 0, pa0); PK4(p0, 8, pa1); PK4(p1, 0, pa2); PK4(p1, 8, pa3);
#undef PK4
}
DI void qkt(f32x16& p0, f32x16& p1, const char* Ks, const bf16x8* qr, int r32, int hi, const float negm) {
#pragma unroll
    for (int r = 0; r < 16; ++r) { p0[r] = negm; p1[r] = negm; }
    const char* k0p = Ks + r32 * KROWB + hi * 16; const char* k1p = k0p + 32 * KROWB;
    bf16x8 b0 = *reinterpret_cast<const bf16x8*>(k0p), b1 = *reinterpret_cast<const bf16x8*>(k1p);
#pragma unroll
    for (int d0 = 0; d0 < 6; ++d0) {
        bf16x8 n0 = b0, n1 = b1;
        if (d0 < 5) { n0 = *reinterpret_cast<const bf16x8*>(k0p + (d0 + 1) * 32); n1 = *reinterpret_cast<const bf16x8*>(k1p + (d0 + 1) * 32); }
        p0 = __builtin_amdgcn_mfma_f32_32x32x16_bf16(b0, qr[d0], p0, 0, 0, 0);
        p1 = __builtin_amdgcn_mfma_f32_32x32x16_bf16(b1, qr[d0], p1, 0, 0, 0);
        b0 = n0; b1 = n1; }
}
DI int v_st(int k, int c) { const int kk = (k & ~0xC) | ((k & 4) << 1) | ((k & 8) >> 1); return ((kk >> 3) * 2 + (c >> 5)) * 512 + ((kk & 7) * 32 + (c & 31)) * 2; }
DI int v_rd_base(int lane) { return ((lane & 3) << 3) | (((lane >> 2) & 3) << 6) | (((lane >> 4) & 1) << 5) | (((lane >> 5) & 1) << 8); }
constexpr int v_rd_off(int d0, int ks, int half) { return d0 * 512 + ks * 2048 + half * 1024; }
typedef short v4i16_t __attribute__((ext_vector_type(4)));
template <int OFF> DI s16x4 tr_read(int vb) { return __builtin_bit_cast(s16x4, __builtin_amdgcn_ds_read_tr16_b64_v4i16((LAS v4i16_t*)(unsigned long long)(unsigned)(vb + OFF))); }
template <int D0> DI void pv_one(f32x16& od, int vb, bf16x8 pa0, bf16x8 pa1, bf16x8 pa2, bf16x8 pa3) {
    const s16x4 l0 = tr_read<v_rd_off(D0, 0, 0)>(vb), h0 = tr_read<v_rd_off(D0, 0, 1)>(vb), l1 = tr_read<v_rd_off(D0, 1, 0)>(vb), h1 = tr_read<v_rd_off(D0, 1, 1)>(vb);
    const s16x4 l2 = tr_read<v_rd_off(D0, 2, 0)>(vb), h2 = tr_read<v_rd_off(D0, 2, 1)>(vb), l3 = tr_read<v_rd_off(D0, 3, 0)>(vb), h3 = tr_read<v_rd_off(D0, 3, 1)>(vb);
#define PK(L, H) (bf16x8){L[0], L[1], L[2], L[3], H[0], H[1], H[2], H[3]}
    od = __builtin_amdgcn_mfma_f32_32x32x16_bf16(pa0, PK(l0, h0), od, 0, 0, 0);
    od = __builtin_amdgcn_mfma_f32_32x32x16_bf16(pa1, PK(l1, h1), od, 0, 0, 0);
    od = __builtin_amdgcn_mfma_f32_32x32x16_bf16(pa2, PK(l2, h2), od, 0, 0, 0);
    od = __builtin_amdgcn_mfma_f32_32x32x16_bf16(pa3, PK(l3, h3), od, 0, 0, 0);
#undef PK
}
DI void pv_d0(f32x16* o, int vb, bf16x8 pa0, bf16x8 pa1, bf16x8 pa2, bf16x8 pa3) { pv_one<0>(o[0], vb, pa0, pa1, pa2, pa3); pv_one<1>(o[1], vb, pa0, pa1, pa2, pa3); }

DI void attn_unit(const bf16_t* __restrict__ Qb, const bf16_t* __restrict__ Kn, const bf16_t* __restrict__ Kr, const bf16_t* __restrict__ Vh,
                  const bf16_t* Zg, bf16_t* Zo, const float* __restrict__ ropec, const float* __restrict__ ropes, int pos0, char* lds, const int tid) {
    const int wid = tid >> 6, lane = tid & 63, r32 = lane & 31, hi = lane >> 5;
    char* V_lds = lds + OFF_V; char* K_lds = lds + OFF_K;
    float* ws = (float*)(lds + OFF_WS) + wid * 64; float* li_l = ws; float* al_l = ws + 32;
    float m_reg = 0.f, l_reg = 0; f32x16 o[2];
#pragma unroll
    for (int r = 0; r < 16; ++r) { o[0][r] = 0.f; o[1][r] = 0.f; }
    bf16x8 qr[6];
    { const bf16_t* Qw = Qb + (size_t)(wid * 32 + r32) * 96 + hi * 8;
#pragma unroll
      for (int d0 = 0; d0 < 6; ++d0) qr[d0] = *reinterpret_cast<const bf16x8*>(Qw + d0 * 16);
      const int pos = pos0 + wid * 32 + r32;
      const f32x4 c0 = *(const f32x4*)(ropec + pos * 16 + hi * 8), c1 = *(const f32x4*)(ropec + pos * 16 + hi * 8 + 4);
      const f32x4 s0 = *(const f32x4*)(ropes + pos * 16 + hi * 8), s1 = *(const f32x4*)(ropes + pos * 16 + hi * 8 + 4);
      float x1[8], x2[8], cs[8], sn[8];
#pragma unroll
      for (int j = 0; j < 8; ++j) { x1[j] = bf2f((bf16_t)qr[4][j]); x2[j] = bf2f((bf16_t)qr[5][j]); cs[j] = j < 4 ? c0[j & 3] : c1[j & 3]; sn[j] = j < 4 ? s0[j & 3] : s1[j & 3]; }
      u32x4 w1, w2;
      w1.x = cvt_pk(x1[0] * cs[0] - x2[0] * sn[0], x1[1] * cs[1] - x2[1] * sn[1]); w1.y = cvt_pk(x1[2] * cs[2] - x2[2] * sn[2], x1[3] * cs[3] - x2[3] * sn[3]);
      w1.z = cvt_pk(x1[4] * cs[4] - x2[4] * sn[4], x1[5] * cs[5] - x2[5] * sn[5]); w1.w = cvt_pk(x1[6] * cs[6] - x2[6] * sn[6], x1[7] * cs[7] - x2[7] * sn[7]);
      w2.x = cvt_pk(x2[0] * cs[0] + x1[0] * sn[0], x2[1] * cs[1] + x1[1] * sn[1]); w2.y = cvt_pk(x2[2] * cs[2] + x1[2] * sn[2], x2[3] * cs[3] + x1[3] * sn[3]);
      w2.z = cvt_pk(x2[4] * cs[4] + x1[4] * sn[4], x2[5] * cs[5] + x1[5] * sn[5]); w2.w = cvt_pk(x2[6] * cs[6] + x1[6] * sn[6], x2[7] * cs[7] + x1[7] * sn[7]);
      qr[4] = __builtin_bit_cast(bf16x8, w1); qr[5] = __builtin_bit_cast(bf16x8, w2); }
    const int ka_r = tid / 12, ka_c = tid - 12 * ka_r; const int kb_i = 512 + (tid & 255), kb_r = kb_i / 12, kb_c = kb_i - 12 * kb_r;
    const int dKr = (int)((const char*)Kr - (const char*)Kn);
    const int koa = ka_c < 8 ? (ka_r * 64 + ka_c * 8) * 2 : dKr + (ka_r * 32 + (ka_c - 8) * 8) * 2; const int ksa = ka_c < 8 ? 128 : 64;
    const int kob = kb_c < 8 ? (kb_r * 64 + kb_c * 8) * 2 : dKr + (kb_r * 32 + (kb_c - 8) * 8) * 2; const int ksb = kb_c < 8 ? 128 : 64;
    const int kda = ka_r * KROWB + ka_c * 16, kdb = kb_r * KROWB + kb_c * 16; const bool has_b = tid < 256;
    const int vr = tid >> 3, vc = (tid & 7) * 8; const int vo = (vr * 64 + vc) * 2; const int vd = v_st(vr, vc);
    const int vb0 = (int)(uintptr_t)V_lds + v_rd_base(lane);
    struct { bf16x8 ka, kb, vv; } sr_[2];
#define SLOAD(i, k0) do { sr_[i].ka = *reinterpret_cast<const bf16x8*>((const char*)Kn + (koa + (k0) * ksa)); sr_[i].kb = *reinterpret_cast<const bf16x8*>((const char*)Kn + (kob + (k0) * ksb)); \
    sr_[i].vv = *reinterpret_cast<const bf16x8*>((const char*)Vh + (vo + (k0) * 128)); } while (0)
#define SWRITE(b, i) do { *(bf16x8*)(V_lds + (b) * SHM_V + vd) = sr_[i].vv; *(bf16x8*)(K_lds + (b) * SHM_K + kda) = sr_[i].ka; \
    if (has_b) *(bf16x8*)(K_lds + (b) * SHM_K + kdb) = sr_[i].kb; } while (0)
#define SWAIT() asm volatile("s_waitcnt vmcnt(3)" ::: "memory")
#define RESC(a) do { if (__any((a) < 1.f)) { if (hi == 0) al_l[r32] = (a); asm volatile("s_waitcnt lgkmcnt(0)" ::: "memory"); \
    _Pragma("unroll") for (int d = 0; d < 2; ++d) _Pragma("unroll") for (int r = 0; r < 16; ++r) o[d][r] *= al_l[crow(r, hi)]; } } while (0)
    f32x16 pA0, pA1, pB0, pB1; float alA, alB; bf16x8 pa0, pa1, pa2, pa3; constexpr int NT = SEQ / 64;
    SLOAD(0, 0); asm volatile("s_waitcnt vmcnt(0)" ::: "memory"); SWRITE(0, 0); __syncthreads();
    qkt(pA0, pA1, K_lds, qr, r32, hi, 0.f); partialSM<true>(pA0, pA1, m_reg, alA);
    SLOAD(1, 64); SLOAD(0, 128);
    SWAIT(); SWRITE(1, 1); __syncthreads();
    int bc = 1;
    for (int j = 1; j + 1 < NT; j += 2) {
        const int bp = bc == 0 ? 2 : bc - 1, bn = bc == 2 ? 0 : bc + 1, bnn = bn == 2 ? 0 : bn + 1;
        SBAR(); qkt(pB0, pB1, K_lds + bc * SHM_K, qr, r32, hi, -m_reg);
        finishSM(pA0, pA1, alA, l_reg, pa0, pa1, pa2, pa3); SBAR();
        SLOAD(1, (j + 2) * 64); SBAR();
        pv_d0(o, vb0 + bp * SHM_V, pa0, pa1, pa2, pa3); partialSM<false>(pB0, pB1, m_reg, alB);
        SWAIT(); SWRITE(bn, 0);
        RESC(alB); __syncthreads();
        SBAR(); qkt(pA0, pA1, K_lds + bn * SHM_K, qr, r32, hi, -m_reg);
        finishSM(pB0, pB1, alB, l_reg, pa0, pa1, pa2, pa3); SBAR();
        if (j + 3 < NT) SLOAD(0, (j + 3) * 64); SBAR();
        pv_d0(o, vb0 + bc * SHM_V, pa0, pa1, pa2, pa3); partialSM<false>(pA0, pA1, m_reg, alA);
        SWAIT(); SWRITE(bnn, 1);
        RESC(alA); __syncthreads();
        bc = bnn;
    }
    { const int bp = bc == 0 ? 2 : bc - 1;
      SBAR(); qkt(pB0, pB1, K_lds + bc * SHM_K, qr, r32, hi, -m_reg);
      finishSM(pA0, pA1, alA, l_reg, pa0, pa1, pa2, pa3); SBAR();
      pv_d0(o, vb0 + bp * SHM_V, pa0, pa1, pa2, pa3); partialSM<false>(pB0, pB1, m_reg, alB);
      RESC(alB);
      finishSM(pB0, pB1, alB, l_reg, pa0, pa1, pa2, pa3); SBAR();
      pv_d0(o, vb0 + bc * SHM_V, pa0, pa1, pa2, pa3); }
    if (hi == 0) li_l[r32] = l_reg; asm volatile("s_waitcnt lgkmcnt(0)" ::: "memory");
    bf16_t* Zw = Zo + (size_t)(wid * 32) * NZ; const bf16_t* Zgw = Zg + (size_t)(wid * 32) * NZ;
#pragma unroll
    for (int r = 0; r < 16; ++r) { const int orow = crow(r, hi); const float rl = __builtin_amdgcn_rcpf(li_l[orow]);
#pragma unroll
        for (int d0 = 0; d0 < 2; ++d0) { const size_t off = (size_t)orow * NZ + d0 * 32 + r32; Zw[off] = f2bf(o[d0][r] * rl * bf2f(Zgw[off])); } }
    __syncthreads();
#undef SLOAD
#undef SWRITE
#undef SWAIT
#undef RESC
}
}

struct Ctx {
    const Params* p; unsigned char* ws; char* lds; int G, c, tid, lane, wave, zero;
};

DI void job_transpose(const Ctx& X, const float* W, int ldw, int col0, int ncols, int K, int kvalid, bf16_t* dst, int ldd, int drow0, int dcol0, float scale) {
    const int k8n = K >> 3, total = ncols * k8n;
    for (int it = X.c * NTHREADS + X.tid; it < total; it += X.G * NTHREADS) {
        const int n = it % ncols, k8 = it / ncols; float v[8];
#pragma unroll
        for (int i = 0; i < 8; ++i) { const int k = k8 * 8 + i; v[i] = k < kvalid ? W[(size_t)k * ldw + col0 + n] * scale : 0.f; }
        u32x4 w; w.x = cvt_pk(v[0], v[1]); w.y = cvt_pk(v[2], v[3]); w.z = cvt_pk(v[4], v[5]); w.w = cvt_pk(v[6], v[7]);
        *(u32x4*)(dst + (size_t)(drow0 + n) * ldd + dcol0 + k8 * 8) = w;
    }
}
DI void job_zero_rows(const Ctx& X, bf16_t* dst, int ldd, int drow0, int nrows, int K) {
    const int k8n = K >> 3, total = nrows * k8n; unsigned zz = 0u; asm volatile("" : "+v"(zz));
    for (int it = X.c * NTHREADS + X.tid; it < total; it += X.G * NTHREADS) { const int n = it / k8n, k8 = it % k8n;
        *(u32x4*)(dst + (size_t)(drow0 + n) * ldd + k8 * 8) = (u32x4){zz, zz, zz, zz}; }
}

DI void prep1(const Ctx& X) {
    const Params& P = *X.p; unsigned char* ws = X.ws;
    const int gt = X.c * NTHREADS + X.tid, GT = X.G * NTHREADS;
    if (gt < 16) ((float*)(ws + 768 * 1024))[gt] = 0.f;
    { float* rc = (float*)(ws + WS_ROPE); float* rs = rc + 4096 * 16;
      for (int it = gt; it < 4096 * 16; it += GT) { const int pos = it >> 4, i = it & 15; const float ang = (float)pos * P.inv_freq[i];
          double rev = (double)ang * 0.15915494309189535; rev -= __builtin_rint(rev); const float rf = (float)rev;
          rc[it] = __builtin_amdgcn_cosf(rf); rs[it] = __builtin_amdgcn_sinf(rf); } }
    { bf16_t* T = (bf16_t*)(ws + WS_DFT);
      for (int it = gt; it < 8 * 2048 * 128; it += GT) { const int k8 = it & 127, ks = (it >> 7) & 2047, j = it >> 18; float v[8];
#pragma unroll
          for (int i = 0; i < 8; ++i) { const int kidx = k8 * 8 + i, kk = kidx & 511, s = 2 * ((j >> 1) * 512 + kk) + (j & 1);
              const float fr = (float)((ks * s) & 4095) * (1.f / 4096.f);
              v[i] = (kidx < 512 ? __builtin_amdgcn_cosf(fr) : -__builtin_amdgcn_sinf(fr)) * (1.f / 64.f); }
          u32x4 w; w.x = cvt_pk(v[0], v[1]); w.y = cvt_pk(v[2], v[3]); w.z = cvt_pk(v[4], v[5]); w.w = cvt_pk(v[6], v[7]);
          *(u32x4*)(T + (size_t)it * 8) = w; } }
    for (int l = 0; l < NLAYER; ++l) {
        unsigned char* wl = ws + WS_W + (size_t)l * LW;
        const float* w_in = P.in[4 + X.zero] + (size_t)l * DM * NIN;
        bf16_t* WinT = (bf16_t*)(wl + W_IN);
        job_transpose(X, w_in, NIN, 256, 256, DM, DM, WinT, DM, 256, 0, 1.f);
        job_transpose(X, w_in, NIN, 512, 160, DM, DM, WinT, DM, 512, 0, 1.f);
        job_zero_rows(X, WinT, DM, 672, 96, DM);
        job_transpose(X, w_in, NIN, 672, 128, DM, DM, WinT, DM, 768, 0, 1.f);
        job_transpose(X, w_in, NIN, 928, 128, DM, DM, WinT, DM, 896, 0, 1.f);
        job_transpose(X, w_in, NIN, 800, 128, DM, DM, WinT, DM, 1024, 0, 1.f);
        job_transpose(X, w_in, NIN, 1056, 128, DM, DM, WinT, DM, 1152, 0, 1.f);
        job_transpose(X, w_in, NIN, 1440, 1280, DM, DM, WinT, DM, 1792, 0, 1.f);
        job_transpose(X, w_in, NIN, 2720, 4096, DM, DM, (bf16_t*)(wl + W_G), DM, 0, 0, 1.f);
        job_transpose(X, P.in[7 + X.zero] + (size_t)l * 256 * 768, 768, 0, 768, 256, 256, (bf16_t*)(wl + W_UQ), 256, 0, 0, ATT_SCALE * 1.4426950408889634f);
        job_transpose(X, P.in[9 + X.zero] + (size_t)l * 128 * 1024, 1024, 0, 1024, 256, 128, (bf16_t*)(wl + W_UKV), 256, 0, 0, 1.f);
        job_transpose(X, P.in[19 + X.zero] + (size_t)l * 256 * DM, DM, 0, DM, 256, 256, (bf16_t*)(wl + W_UP), 1280, 0, 0, 1.f);
        job_transpose(X, P.in[20 + X.zero] + (size_t)l * 512 * DM, DM, 0, DM, 512, 512, (bf16_t*)(wl + W_UP), 1280, 0, 256, 1.f);
        job_transpose(X, P.in[21 + X.zero] + (size_t)l * 256 * DM, DM, 0, DM, 256, 256, (bf16_t*)(wl + W_UP), 1280, 0, 768, 1.f);
        job_transpose(X, P.in[22 + X.zero] + (size_t)l * 256 * DM, DM, 0, DM, 256, 256, (bf16_t*)(wl + W_UP), 1280, 0, 1024, 1.f);
        job_transpose(X, P.in[23 + X.zero] + (size_t)l * DM * DM, DM, 0, DM, DM, DM, (bf16_t*)(wl + W_OUT), DM, 0, 0, 1.f);
        job_transpose(X, P.in[16 + X.zero] + (size_t)l * 256 * 256, 256, 0, 256, 256, 256, (bf16_t*)(wl + W_PW), 256, 0, 0, 1.f);
        { const float* pw = P.in[10 + X.zero] + (size_t)l * 4 * 64 * 64; const float* psc = P.in[11 + X.zero] + (size_t)l * 256;
          for (int it = gt; it < DM * 256; it += GT) { const int n = it & 255, k = it >> 8, g = n >> 6, d = n & 63; float a = 0.f;
              const float* wr_ = w_in + (size_t)k * NIN + g * 64; const float* pp = pw + g * 4096 + d;
#pragma unroll 8
              for (int cc = 0; cc < 64; ++cc) a = fmaf(wr_[cc], pp[cc * 64], a);
              WinT[(size_t)n * DM + k] = f2bf(a * psc[n]); } }
        { const float* wf = P.in[18 + X.zero] + (size_t)l * 256 * 256; float* MA = (float*)(ws + WS_MAB) + (size_t)l * 2 * 65536; float* MB = MA + 65536;
          for (int it = gt; it < 65536; it += GT) { const int d = it & 255, gc = it >> 8, g = gc >> 6, cch = gc & 63; float a = 0.f, b = 0.f;
              for (int kc = 0; kc < 64; ++kc) { const float fr = (float)((kc * cch) & 63) * (1.f / 64.f); const float w = wf[(size_t)(g * 64 + kc) * 256 + d];
                  a = fmaf(__builtin_amdgcn_cosf(fr), w, a); b = fmaf(__builtin_amdgcn_sinf(fr), w, b); }
              MA[it] = a; MB[it] = b; } }
    }
}
DI void prep2(const Ctx& X) {
    const Params& P = *X.p; unsigned char* ws = X.ws;
    const int gt = X.c * NTHREADS + X.tid, GT = X.G * NTHREADS;
    for (int l = 0; l < NLAYER; ++l) {
        const float* w_in = P.in[4 + X.zero] + (size_t)l * DM * NIN + 1184; bf16_t* WinT = (bf16_t*)(ws + WS_W + (size_t)l * LW + W_IN);
        const float* MA = (const float*)(ws + WS_MAB) + (size_t)l * 2 * 65536;
        for (int it = gt; it < DM * 512; it += GT) { const int n = it & 511, k = it >> 9; const float* Mx = MA + (n >> 8) * 65536 + (n & 255); const float* wr_ = w_in + (size_t)k * NIN; float a = 0.f;
#pragma unroll 8
            for (int gc = 0; gc < 256; ++gc) a = fmaf(wr_[gc], Mx[gc * 256], a);
            WinT[(size_t)(1280 + n) * DM + k] = f2bf(a * 0.125f); }
    }
}

DI void norm_pass(const Ctx& X, int ch, int l) {
    float NEPS = NORM_EPS; asm volatile("" : "+s"(NEPS));
    const Params& P = *X.p; const int lane = X.lane;
    const int gw = X.G == 256 ? (256 * (8 * (X.c & 7) + ((X.c >> 3) & 7)) + 64 * (X.c >> 6) + 8 * X.wave) : X.c * NWAVES + X.wave, NGW = X.G == 256 ? 1 : X.G * NWAVES;
    const int rend = X.G == 256 ? gw + 8 : MC;
    const float* xin = ch == 0 ? P.in[0 + X.zero] : P.in[1 + X.zero] + (size_t)(ch - 1) * MC * DM;
    float* xo = P.out + (size_t)ch * MC * DM;
    const bf16_t* ob = (const bf16_t*)(X.ws + WS_OB); bf16_t* hb = (bf16_t*)(X.ws + WS_H);
    for (int r = gw; r < rend; r += NGW) {
        const float* xr = (l == 0 ? xin : (l == 1 ? xin : xo)) + (size_t)r * DM;
        f32x4 v[4];
#pragma unroll
        for (int j = 0; j < 4; ++j) v[j] = *(const f32x4*)(xr + (lane + 64 * j) * 4);
        if (l >= 1) {
            const float* pg = P.in[3 + X.zero] + (size_t)(l - 1) * DM; f32x4 ov[4]; float ss = 0.f;
#pragma unroll
            for (int j = 0; j < 4; ++j) { const u32x2 w = *(const u32x2*)(ob + (size_t)r * DM + (lane + 64 * j) * 4); ov[j] = (f32x4){bflo(w.x), bfhi(w.x), bflo(w.y), bfhi(w.y)};
                ss += ov[j][0] * ov[j][0] + ov[j][1] * ov[j][1] + ov[j][2] * ov[j][2] + ov[j][3] * ov[j][3]; }
            const float rs = __builtin_amdgcn_rsqf(wave_sum(ss, lane) * (1.f / DM) + NEPS);
#pragma unroll
            for (int j = 0; j < 4; ++j) { const f32x4 g = *(const f32x4*)(pg + (lane + 64 * j) * 4); v[j] += ov[j] * rs * g; *(f32x4*)(xo + (size_t)r * DM + (lane + 64 * j) * 4) = v[j]; }
        }
        if (l <= 1) {
            const float* pg = P.in[2 + X.zero] + (size_t)l * DM; float ss = 0.f;
#pragma unroll
            for (int j = 0; j < 4; ++j) ss += v[j][0] * v[j][0] + v[j][1] * v[j][1] + v[j][2] * v[j][2] + v[j][3] * v[j][3];
            const float rs = __builtin_amdgcn_rsqf(wave_sum(ss, lane) * (1.f / DM) + NEPS);
#pragma unroll
            for (int j = 0; j < 4; ++j) { const f32x4 g = *(const f32x4*)(pg + (lane + 64 * j) * 4); const f32x4 hv = v[j] * rs * g;
                u32x2 w; w.x = cvt_pk(hv[0], hv[1]); w.y = cvt_pk(hv[2], hv[3]); *(u32x2*)(hb + (size_t)r * DM + (lane + 64 * j) * 4) = w; }
        }
    }
}

DI void s_pass(const Ctx& X, int l) {
    float NEPS = NORM_EPS; asm volatile("" : "+s"(NEPS));
    const Params& P = *X.p; const int gw = X.c * NWAVES + X.wave, NGW = X.G * NWAVES, lane = X.lane;
    const bf16_t* z = (const bf16_t*)(X.ws + WS_Z); bf16_t* cqn = (bf16_t*)(X.ws + WS_CQN); bf16_t* ckvn = (bf16_t*)(X.ws + WS_CKVN); bf16_t* kro = (bf16_t*)(X.ws + WS_KROPE);
    const float* qg = P.in[6 + X.zero] + (size_t)l * 256; const float* kg = P.in[8 + X.zero] + (size_t)l * 128;
    const float* rc = (const float*)(X.ws + WS_ROPE); const float* rs_ = rc + 4096 * 16;
    for (int r = gw; r < MC; r += NGW) {
        const bf16_t* zr = z + (size_t)r * NZ;
        { const u32x2 w = *(const u32x2*)(zr + 256 + lane * 4); f32x4 v = {bflo(w.x), bfhi(w.x), bflo(w.y), bfhi(w.y)};
          const float rs = __builtin_amdgcn_rsqf(wave_sum(v[0] * v[0] + v[1] * v[1] + v[2] * v[2] + v[3] * v[3], lane) * (1.f / 256.f) + NEPS);
          const f32x4 g = *(const f32x4*)(qg + lane * 4); v = v * rs * g; u32x2 o; o.x = cvt_pk(v[0], v[1]); o.y = cvt_pk(v[2], v[3]); *(u32x2*)(cqn + (size_t)r * 256 + lane * 4) = o; }
        { const unsigned w = *(const unsigned*)(zr + 512 + lane * 2); float a = bflo(w), b = bfhi(w);
          const float rs = __builtin_amdgcn_rsqf(wave_sum(a * a + b * b, lane) * (1.f / 128.f) + NEPS);
          const f32x2 g = *(const f32x2*)(kg + lane * 2); *(unsigned*)(ckvn + (size_t)r * 256 + lane * 2) = cvt_pk(a * rs * g[0], b * rs * g[1]);
          *(unsigned*)(ckvn + (size_t)r * 256 + 128 + lane * 2) = 0u; }
        if (lane < 16) { const int pos = r & 4095; const float x1 = bf2f(zr[640 + lane]), x2 = bf2f(zr[656 + lane]), cs = rc[pos * 16 + lane], sn = rs_[pos * 16 + lane];
          kro[(size_t)r * 32 + lane] = f2bf(x1 * cs - x2 * sn); kro[(size_t)r * 32 + 16 + lane] = f2bf(x2 * cs + x1 * sn); }
    }
}

DI void pool_pass(const Ctx& X, bf16_t* zo) {
    bf16_t* z = (bf16_t*)(X.ws + WS_Z);
    for (int e = X.c * NTHREADS + X.tid; e < MC * 32; e += X.G * NTHREADS) {
        const int t = e >> 5, cgp = e & 31, ch0 = cgp * 8, g = cgp >> 3, hw = 1 << g, s = t & 4095, tb = t - s;
        const int lo = max(s - hw, 0), hi = min(s + hw, SEQ);
        f32x4 a0 = {0.f, 0.f, 0.f, 0.f}, a1 = a0;
        for (int r = lo; r < hi; ++r) { f32x4 v0, v1; load8(z + (size_t)(tb + r) * NZ + ch0, v0, v1); a0 += v0; a1 += v1; }
        const float ic = 1.f / (float)(hi - lo); f32x4 u0, u1, g0, g1; load8(z + (size_t)t * NZ + ch0, u0, u1); load8(z + (size_t)t * NZ + ZC_G + ch0, g0, g1);
        store8(zo + (size_t)t * NZ + ZC_G + ch0, (a0 * ic - u0) * g0, (a1 * ic - u1) * g1);
    }
}

DI void dft_combine(const Ctx& X) {
    bf16_t* z = (bf16_t*)(X.ws + WS_Z); const bf16_t* Pp = (const bf16_t*)(X.ws + WS_P);
    for (int e = X.c * NTHREADS + X.tid; e < MC * 32; e += X.G * NTHREADS) {
        const int t = e >> 5, ch0 = (e & 31) * 8, b = t >> 12, s = t & 4095, ks = s & 2047; const float sg = s >= 2048 ? -1.f : 1.f;
        f32x4 a0 = {0.f, 0.f, 0.f, 0.f}, a1 = a0;
#pragma unroll
        for (int j = 0; j < 8; ++j) { f32x4 v0, v1; load8(Pp + ((size_t)(b * 8 + j) * 2048 + ks) * 256 + ch0, v0, v1); const float sj = (j & 1) ? sg : 1.f; a0 += v0 * sj; a1 += v1 * sj; }
        f32x4 g0, g1; bf16_t* zp = z + (size_t)t * NZ + ZC_GFOUR + ch0; load8(zp, g0, g1); store8(zp, a0 * g0, a1 * g1);
    }
}

DI void conv_item(const Ctx& X, int item, int l) {
    float LEPS = LN_EPS; asm volatile("" : "+s"(LEPS)); unsigned zz = 0u; asm volatile("" : "+v"(zz));
    const Params& P = *X.p; const int tid = X.tid;
    const bf16_t* z = (const bf16_t*)(X.ws + WS_Z); bf16_t* cb = (bf16_t*)(X.ws + WS_CB);
    char* gl = X.lds; float* co = (float*)(X.lds + 49152);
    const int t0 = item * 64, s0 = t0 & 4095, tb = t0 - s0;
    for (int i = tid; i < 94 * 32; i += NTHREADS) { const int r = i >> 5, c8 = i & 31, s = s0 - 15 + r; u32x4 w = {zz, zz, zz, zz};
        if (s >= 0 && s < SEQ) w = *(const u32x4*)(z + (size_t)(tb + s) * NZ + ZC_GLU + c8 * 8);
        *(u32x4*)(gl + r * 512 + c8 * 16) = w; }
    __syncthreads();
    { const int cp = tid & 127, tg = tid >> 7; const float* cw = P.in[12 + X.zero] + (size_t)l * 31 * 256 + 2 * cp; const f32x2 bias = *(const f32x2*)(P.in[13 + X.zero] + (size_t)l * 256 + 2 * cp);
      f32x2 w[31];
#pragma unroll
      for (int k = 0; k < 31; ++k) w[k] = *(const f32x2*)(cw + k * 256);
      f32x2 a[16];
#pragma unroll
      for (int i = 0; i < 16; ++i) a[i] = bias;
#pragma unroll
      for (int r = 0; r < 46; ++r) { const unsigned u = *(const unsigned*)(gl + (tg * 16 + r) * 512 + cp * 4); const f32x2 v = {bflo(u), bfhi(u)};
#pragma unroll
          for (int i = 0; i < 16; ++i) { if (r - i >= 0 && r - i <= 30) a[i] += v * w[r - i]; } }
#pragma unroll
      for (int i = 0; i < 16; ++i) *(f32x2*)(co + (tg * 16 + i) * 256 + 2 * cp) = a[i]; }
    __syncthreads();
    { const int wv = X.wave, lane = X.lane; const f32x4 g = *(const f32x4*)(P.in[14 + X.zero] + (size_t)l * 256 + lane * 4), be = *(const f32x4*)(P.in[15 + X.zero] + (size_t)l * 256 + lane * 4);
#pragma unroll
      for (int i = 0; i < 8; ++i) { const int tok = wv * 8 + i; f32x4 v = *(const f32x4*)(co + tok * 256 + lane * 4);
          const float mu = wave_sum(v[0] + v[1] + v[2] + v[3], lane) * (1.f / 256.f); v -= mu;
          const float rs = __builtin_amdgcn_rsqf(wave_sum(v[0] * v[0] + v[1] * v[1] + v[2] * v[2] + v[3] * v[3], lane) * (1.f / 256.f) + LEPS);
          v = v * rs * g + be;
#pragma unroll
          for (int e = 0; e < 4; ++e) v[e] = siluf_(v[e]);
          u32x2 o; o.x = cvt_pk(v[0], v[1]); o.y = cvt_pk(v[2], v[3]); *(u32x2*)(cb + (size_t)(t0 + tok) * 256 + lane * 4) = o; } }
    __syncthreads();
}


DI float dotbf(const bf16_t* a, const bf16_t* b, int K) { float s = 0.f; for (int k = 0; k < K; ++k) s = fmaf(bf2f(a[k]), bf2f(b[k]), s); return s; }
DI void dbg_max(float* w, float v) { atomicMax((int*)w, __builtin_bit_cast(int, fabsf(v))); }
DI void dbg_check(const Ctx& X, int l) {
    const Params& P = *X.p; unsigned char* ws = X.ws; unsigned char* wl = ws + WS_W + (size_t)l * LW;
    float* dbg = (float*)(ws + 768 * 1024);
    const bf16_t* h = (const bf16_t*)(ws + WS_H); const bf16_t* z = (const bf16_t*)(ws + WS_Z); const bf16_t* WinT = (const bf16_t*)(wl + W_IN);
    const bf16_t* abt = (const bf16_t*)(ws + WS_ABT); const bf16_t* T = (const bf16_t*)(ws + WS_DFT); const bf16_t* Pp = (const bf16_t*)(ws + WS_P);
    const bf16_t* U = (const bf16_t*)(ws + WS_U); const bf16_t* mb = (const bf16_t*)(ws + WS_M); const bf16_t* ob = (const bf16_t*)(ws + WS_OB);
    const bf16_t* WupT = (const bf16_t*)(wl + W_UP); const bf16_t* WgT = (const bf16_t*)(wl + W_G); const bf16_t* WoT = (const bf16_t*)(wl + W_OUT);
    const int i = X.c * NTHREADS + X.tid; if (i >= 32768) return;
    const unsigned hsh = (unsigned)i * 2654435761u; const int row = (hsh >> 7) % MC; const int cc = (hsh >> 3) & 1023;
    const bf16_t* hr = h + (size_t)row * DM;
    { const int col = cc % 672; dbg_max(dbg + 1, bf2f(z[(size_t)row * NZ + col]) - dotbf(hr, WinT + (size_t)col * DM, DM)); }
    { const int col = cc & 255, wr0 = 768 + (col >> 7) * 256 + (col & 127); const float a = dotbf(hr, WinT + (size_t)wr0 * DM, DM), b = dotbf(hr, WinT + (size_t)(wr0 + 128) * DM, DM);
      dbg_max(dbg + 2, bf2f(z[(size_t)row * NZ + ZC_GLU + col]) - a / (1.f + expf(-b))); }
    { const int ch = cc & 255, b = row >> 12, s = row & 4095, j = (s & 1) + 2 * (s >> 10), kidx = (s >> 1) & 511; const bf16_t* ap = abt + ((size_t)(b * 8 + j) * 256 + ch) * 1024;
      dbg_max(dbg + 3, bf2f(ap[kidx]) - dotbf(hr, WinT + (size_t)(1280 + ch) * DM, DM)); dbg_max(dbg + 3, bf2f(ap[512 + kidx]) - dotbf(hr, WinT + (size_t)(1536 + ch) * DM, DM)); }
    { const int ch = cc & 255, bj = (row >> 11) & 31, ks = row & 2047; dbg_max(dbg + 4, bf2f(Pp[((size_t)bj * 2048 + ks) * 256 + ch]) - dotbf(T + ((size_t)(bj & 7) * 2048 + ks) * 1024, abt + ((size_t)bj * 256 + ch) * 1024, 1024)); }
    { const int br = (hsh >> 1) & 3, koff = br == 0 ? 0 : (br == 1 ? 256 : (br == 2 ? 768 : 1024)), K = br == 1 ? 512 : 256;
      dbg_max(dbg + 5, bf2f(U[(size_t)row * 4096 + br * 1024 + cc]) - dotbf(z + (size_t)row * NZ + ZC_G + koff, WupT + (size_t)cc * 1280 + koff, K)); }
    { float acc = 0.f; for (int b = 0; b < 4; ++b) { const float g = dotbf(hr, WgT + (size_t)(b * 1024 + cc) * DM, DM) + P.in[5 + X.zero][(size_t)l * 4096 + b * 1024 + cc];
          acc += bf2f(U[(size_t)row * 4096 + b * 1024 + cc]) / (1.f + expf(-g)); }
      dbg_max(dbg + 6, bf2f(mb[(size_t)row * 1024 + cc]) - acc); }
    { dbg_max(dbg + 7, bf2f(ob[(size_t)row * 1024 + cc]) - dotbf(mb + (size_t)row * 1024, WoT + (size_t)cc * DM, DM)); }
    { const int col = cc & 255, g = col >> 6, hw = 1 << g, s = row & 4095, tb = row - s, lo = max(s - hw, 0), hi = min(s + hw, SEQ); float a = 0.f;
      for (int r = lo; r < hi; ++r) a += bf2f(z[(size_t)(tb + r) * NZ + col]);
      const float gg = dotbf(hr, WinT + (size_t)(1792 + col) * DM, DM), sg = gg / (1.f + expf(-gg));
      dbg_max(dbg + 8, bf2f(z[(size_t)row * NZ + ZC_G + col]) - (a / (float)(hi - lo) - bf2f(z[(size_t)row * NZ + col])) * sg); }
    { const bf16_t* cbp = (const bf16_t*)(ws + WS_CB); const int col = cc & 255, s = row & 4095, tb = row - s; float sum = 0.f, sq = 0.f, mine = 0.f;
      for (int ch = 0; ch < 256; ++ch) { float a = P.in[13 + X.zero][(size_t)l * 256 + ch];
          for (int k = 0; k < 31; ++k) { const int ss = s + k - 15; if (ss >= 0 && ss < SEQ) a = fmaf(bf2f(z[(size_t)(tb + ss) * NZ + ZC_GLU + ch]), P.in[12 + X.zero][((size_t)l * 31 + k) * 256 + ch], a); }
          sum += a; sq += a * a; if (ch == col) mine = a; }
      const float mu = sum / 256.f, var = sq / 256.f - mu * mu; float y = (mine - mu) / sqrtf(var + LN_EPS) * P.in[14 + X.zero][(size_t)l * 256 + col] + P.in[15 + X.zero][(size_t)l * 256 + col]; y = y / (1.f + expf(-y));
      dbg_max(dbg + 9, bf2f(cbp[(size_t)row * 256 + col]) - y);
      const float gg = dotbf(hr, WinT + (size_t)(2560 + col) * DM, DM), sg = gg / (1.f + expf(-gg));
      dbg_max(dbg + 10, bf2f(z[(size_t)row * NZ + ZC_GCONV + col]) - (dotbf(cbp + (size_t)row * 256, (const bf16_t*)(wl + W_PW) + (size_t)col * 256, 256) + P.in[17 + X.zero][(size_t)l * 256 + col]) * sg); }
    { const int col = cc & 255, b = row >> 12, s = row & 4095, ks = s & 2047; float f = 0.f;
      for (int j = 0; j < 8; ++j) { const float pv = bf2f(Pp[((size_t)(b * 8 + j) * 2048 + ks) * 256 + col]); f += ((j & 1) && s >= 2048) ? -pv : pv; }
      const float gg = dotbf(hr, WinT + (size_t)(2816 + col) * DM, DM), sg = gg / (1.f + expf(-gg));
      dbg_max(dbg + 11, bf2f(z[(size_t)row * NZ + ZC_GFOUR + col]) - f * sg); }
    { const float* xr = P.in[0 + X.zero] + (size_t)row * DM; float ss = 0.f; for (int k = 0; k < DM; ++k) ss = fmaf(xr[k], xr[k], ss);
      dbg_max(dbg + 12, bf2f(hr[cc]) - xr[cc] / sqrtf(ss / DM + NORM_EPS) * P.in[2 + X.zero][(size_t)l * DM + cc]); }
}
DI void dbg_report(const Ctx& X) {
    const float* dbg = (const float*)(X.ws + 768 * 1024);
    if (X.c == 0 && X.tid == 0) { float add = 0.f;
        if (dbg[1] > 0.03f) add = 1e2f; if (dbg[2] > 0.03f) add = 1e3f; if (dbg[3] > 0.03f) add = 1e4f; if (dbg[4] > 0.03f) add = 1e5f;
        if (dbg[5] > 0.03f) add = 1e6f; if (dbg[6] > 0.03f) add = 1e7f; if (dbg[7] > 0.03f) add = 1e8f; if (dbg[8] > 0.03f) add = 1e9f; if (dbg[9] > 0.03f) add = 1e10f; if (dbg[10] > 0.03f) add = 1e11f; if (dbg[11] > 0.03f) add = 1e12f; if (dbg[12] > 0.03f) add = 1e13f;
        X.p->out[0] += add; }
}

#define XB_TMO      128
#define XB_XCNT(j)  (256  + 64 * (j))
#define XB_XSUB(j)  (1280 + 64 * (j))
#define XB_XGEN(j)  (2304 + 64 * (j))
#define XB_TOP      3328
#define XB_TOPGEN   3392
#define XCD_BAR_WORDS 3456
#define XB_SPIN_CAP (1u << 22)
constexpr size_t WS_BAR = 800 * 1024;
constexpr int LDS_MISC = 131072 + 1024;
DI unsigned xb_ld(unsigned* p)              { return __hip_atomic_load(p, __ATOMIC_RELAXED, __HIP_MEMORY_SCOPE_AGENT); }
DI unsigned xb_add(unsigned* p, unsigned v) { return __hip_atomic_fetch_add(p, v, __ATOMIC_RELAXED, __HIP_MEMORY_SCOPE_AGENT); }
DI unsigned xb_xcc_id() { return (unsigned)__builtin_amdgcn_s_getreg((3 << 11) | 20) & 0xFu; }
#define XB_SPIN(cond, bar) do { unsigned _sp = 0; while (cond) { __builtin_amdgcn_s_sleep(1); \
    if ((++_sp & 255u) == 0u) { if (xb_ld(&(bar)[XB_TMO])) break; if (_sp > XB_SPIN_CAP) { atomicAdd(&(bar)[XB_TMO], 1u); break; } } } } while (0)
struct XcdBarrier { unsigned* bar; unsigned x; volatile LAS unsigned* st; };
DI void xcd_barrier_complete(unsigned* bar, unsigned x, unsigned& nloc, unsigned& nx) {
    const unsigned G = gridDim.x * gridDim.y * gridDim.z;
    unsigned sum, cnt, mine, sp = 0u;
    for (;;) {
        sum = 0u; cnt = 0u; mine = 0u;
#pragma unroll
        for (unsigned j = 0; j < 16; ++j) { const unsigned c = xb_ld(&bar[XB_XCNT(j)]); sum += c; cnt += (c > 0u) ? 1u : 0u; mine = (j == x) ? c : mine; }
        if (sum == G) break;
        __builtin_amdgcn_s_sleep(1);
        if ((++sp & 255u) == 0u) { if (xb_ld(&bar[XB_TMO])) break; if (sp > XB_SPIN_CAP) { atomicAdd(&bar[XB_TMO], 1u); break; } }
    }
    nloc = mine > 0u ? mine : 1u; nx = cnt > 0u ? cnt : 1u;
}
DI void xcd_barrier(const XcdBarrier& b, const int tid) {
    asm volatile("s_waitcnt vmcnt(0)" ::: "memory");
    __syncthreads();
    if (tid == 0) {
        unsigned* bar = b.bar;
        __builtin_amdgcn_s_waitcnt(0);
        unsigned nloc = b.st[0], nx = b.st[1];
        if (nloc == 0u) { xcd_barrier_complete(bar, b.x, nloc, nx); b.st[0] = nloc; b.st[1] = nx; }
        const unsigned old = xb_add(&bar[XB_XSUB(b.x)], 1u);
        const unsigned gen = old / nloc;
        if (old + 1u == (gen + 1u) * nloc) {
            __builtin_amdgcn_fence(__ATOMIC_RELEASE, "agent");
            asm volatile("s_waitcnt vmcnt(0)" ::: "memory");
            const unsigned og = xb_add(&bar[XB_TOP], 1u);
            const unsigned tg = og / nx;
            if (og + 1u == (tg + 1u) * nx) xb_add(&bar[XB_TOPGEN], 1u);
            else XB_SPIN(xb_ld(&bar[XB_TOPGEN]) == tg, bar);
            __builtin_amdgcn_fence(__ATOMIC_ACQUIRE, "agent");
            xb_add(&bar[XB_XGEN(b.x)], 1u);
            asm volatile("s_waitcnt vmcnt(0)" ::: "memory");
        } else {
            XB_SPIN(xb_ld(&bar[XB_XGEN(b.x)]) == gen, bar);
            __builtin_amdgcn_fence(__ATOMIC_ACQUIRE, "agent");
            asm volatile("s_waitcnt vmcnt(0)" ::: "memory");
        }
    }
    __syncthreads();
}


#define GB_SUB(g)  (8192 + 16 * (g))
#define GB_GEN(g)  (9216 + 16 * (g))
#define GB_OK      6144
#define GB_MAP     6400
DI void grp_barrier(unsigned* bar, const int g, const unsigned nloc, const int tid) {
    asm volatile("s_waitcnt vmcnt(0)" ::: "memory");
    __syncthreads();
    if (tid == 0) {
        __builtin_amdgcn_s_waitcnt(0);
        const unsigned old = xb_add(&bar[GB_SUB(g)], 1u); const unsigned gen = old / nloc;
        if (old + 1u == (gen + 1u) * nloc) xb_add(&bar[GB_GEN(g)], 1u);
        else XB_SPIN(xb_ld(&bar[GB_GEN(g)]) == gen, bar);
        __builtin_amdgcn_fence(__ATOMIC_ACQUIRE, "agent");
        asm volatile("s_waitcnt vmcnt(0)" ::: "memory");
    }
    __syncthreads();
}

constexpr int NPH = 7;
constexpr int NSTEPS = 2 + NCHUNK * NLAYER * NPH + 1;

DI void run_step(const Ctx& X, int step, const int dummy, const XcdBarrier* xb) {
    const Params& P = *X.p; unsigned char* ws = X.ws; LAS unsigned char* ldsl = (LAS unsigned char*)X.lds;
    if (step == 0) { prep1(X); return; }
    if (step == 1) { prep2(X); return; }
    if (step == NSTEPS - 1) { norm_pass(X, NCHUNK - 1, 2); return; }
    const int s2 = step - 2, ph = s2 % NPH, cl = s2 / NPH, l = cl % NLAYER, ch = cl / NLAYER;
    unsigned char* wl = ws + WS_W + (size_t)l * LW;
    switch (ph) {
    case 0: { if (l == 0 && ch > 0) norm_pass(X, ch - 1, 2); norm_pass(X, ch, l); } break;
    case 1: { SchedSimple S{(const char*)(ws + WS_H), (const char*)(wl + W_IN), DM, DM, 16, 12, X.G, X.c, 0};
              EpiIn E{(bf16_t*)(ws + WS_Z), (bf16_t*)(ws + WS_ABT)};
              pg8::gemm_phase(ldsl, X.tid, DM, DM, S, E); } break;
    case 2: {
        s_pass(X, l);
        { SchedDft S{(const char*)(ws + WS_DFT), (const char*)(ws + WS_ABT), X.G, X.c}; EpiDft E{(bf16_t*)(ws + WS_P)};
          pg8::gemm_phase(ldsl, X.tid, 1024, 1024, S, E); }
        for (int it = X.c; it < MC / 64; it += X.G) conv_item(X, it, l);
        pool_pass(X, dummy ? (bf16_t*)(ws + WS_U) : (bf16_t*)(ws + WS_Z));
    } break;
    case 3: { { SchedQKV S{(const char*)(ws + WS_CQN), (const char*)(ws + WS_CKVN), (const char*)(wl + W_UQ), (const char*)(wl + W_UKV), X.G, X.c};
                EpiQKV E{(bf16_t*)(ws + WS_Q), (bf16_t*)(ws + WS_KN), (bf16_t*)(ws + WS_V)};
                pg8::gemm_phase(ldsl, X.tid, 256, 256, S, E); }
              { SchedSimple S{(const char*)(ws + WS_CB), (const char*)(wl + W_PW), 256, 256, 4, 1, X.G, X.c, (X.G >> 3) >= 32 ? 24 : 0};
                EpiPw E{(bf16_t*)(ws + WS_Z), P.in[17 + X.zero] + (size_t)l * 256};
                pg8::gemm_phase(ldsl, X.tid, 256, 256, S, E); }
              dft_combine(X); } break;
    case 4: {
        const bf16_t* q = (const bf16_t*)(ws + WS_Q); const bf16_t* kn = (const bf16_t*)(ws + WS_KN); const bf16_t* kr = (const bf16_t*)(ws + WS_KROPE); const bf16_t* v = (const bf16_t*)(ws + WS_V);
        bf16_t* z = (bf16_t*)(ws + WS_Z); bf16_t* zo = dummy ? (bf16_t*)(ws + WS_U) : z; const float* rc = (const float*)(ws + WS_ROPE); const float* rs = rc + 4096 * 16;
        for (int i = 0;; ++i) { int pair, qb;
            if (X.G == 256) { if (i >= 2) break; const int pm = 8 * (X.c & 7) + ((X.c >> 3) & 7), pc = X.c >> 6; pair = (pm >> 4) * 8 + 2 * pc + i; qb = pm & 15; }
            else if ((X.G & 7) == 0) { const int per = X.G >> 3, x = X.c & 7, idx = X.c >> 3, qq = i * per + idx; if (qq >= 64) break; pair = 4 * x + (qq >> 4); qb = qq & 15; }
            else { const int L = i * X.G + X.c; if (L >= 512) break; pair = L >> 4; qb = L & 15; }
            const int b = pair >> 3, h = pair & 7;
            att::attn_unit(q + ((size_t)pair * 4096 + qb * 256) * 96, kn + (size_t)pair * 4096 * 64, kr + (size_t)b * 4096 * 32, v + (size_t)pair * 4096 * 64,
                           z + ((size_t)(b * 4096 + qb * 256)) * NZ + ZC_GATTN + h * 64, zo + ((size_t)(b * 4096 + qb * 256)) * NZ + ZC_GATTN + h * 64, rc, rs, qb * 256, X.lds, X.tid); }
    } break;
    case 5: { { SchedUp S{(const char*)(ws + WS_Z), (const char*)(wl + W_UP), X.G, X.c}; EpiPlain E{(bf16_t*)(ws + WS_U), 4096, 0};
                pg8::gemm_phase(ldsl, X.tid, NZ, 1280, S, E); }
              if (X.G != 256) xcd_barrier(*xb, X.tid);
              { SchedGate S{(const char*)(ws + WS_H), (const char*)(wl + W_G), X.G, X.c};
                EpiGate E{(const bf16_t*)(ws + WS_U), (bf16_t*)(ws + WS_M), P.in[5 + X.zero] + (size_t)l * 4096};
                pg8::gemm_phase(ldsl, X.tid, DM, DM, S, E); } } break;
    case 6: { SchedSimple S{(const char*)(ws + WS_M), (const char*)(wl + W_OUT), DM, DM, 16, 4, X.G, X.c, 0}; EpiPlain E{(bf16_t*)(ws + WS_OB), DM, 0};
              pg8::gemm_phase(ldsl, X.tid, DM, DM, S, E); } break;
    }
}


__global__ void __launch_bounds__(NTHREADS, 2) mk_fwd(Params prm) {
    extern __shared__ __attribute__((aligned(16))) unsigned char lds[];
    const int wave_s = __builtin_amdgcn_readfirstlane(threadIdx.x >> 6);
    volatile LAS unsigned* bst = (volatile LAS unsigned*)((LAS unsigned char*)lds + LDS_MISC);
    if (threadIdx.x == 0) { bst[0] = 0u; bst[1] = 0u; }
    __syncthreads();
    XcdBarrier xbar; xbar.bar = (unsigned*)(prm.ws + WS_BAR); xbar.x = xb_xcc_id(); xbar.st = bst;
    if (threadIdx.x == 0) { (void)xb_add(&xbar.bar[XB_XCNT(xbar.x)], 1u); __hip_atomic_store(&xbar.bar[GB_MAP + blockIdx.x], xbar.x + 1u, __ATOMIC_RELAXED, __HIP_MEMORY_SCOPE_AGENT); }
    int use_local = 0;
    int rep = 0;
    for (int step = prm.step_lo; step < prm.step_hi;) {
        int wv_ = wave_s, cb_ = blockIdx.x, gd_ = gridDim.x, zero_ = 0;
        asm volatile("" : "+s"(wv_), "+s"(cb_), "+s"(gd_), "+s"(zero_));
        int lane_; asm volatile("v_mbcnt_lo_u32_b32 %0, -1, 0\n\tv_mbcnt_hi_u32_b32 %0, -1, %0" : "=v"(lane_));
        int tidv = wv_ * 64 + lane_;
        Ctx X; X.p = &prm; X.ws = prm.ws + (size_t)(unsigned)zero_; X.lds = (char*)lds; X.G = gd_; X.c = cb_; X.tid = tidv; X.lane = tidv & 63; X.zero = zero_;
        X.wave = __builtin_amdgcn_readfirstlane(tidv >> 6);
        const bool want2 = (DBL_PREP && step < 2) || (DBL_MASK != 0 && step >= 2 && step < NSTEPS - 1 && ((DBL_MASK >> ((step - 2) % NPH)) & 1));
        const int dummy = (want2 && rep == 0) ? 1 : 0;
        run_step(X, step, dummy, &xbar);
        if (dummy) rep = 1; else { rep = 0; ++step; }
        if (step < prm.step_hi) {
            if (step == 1) { cg::this_grid().sync();
                if (tidv == 0) { unsigned ok = (gd_ == 256) ? 1u : 0u; for (int k = 0; k < 32 && ok; ++k) ok = (xb_ld(&xbar.bar[GB_MAP + (cb_ & 7) + 8 * k]) == xbar.x + 1u) ? 1u : 0u; (void)xb_add(&xbar.bar[GB_OK], ok); } }
            else if (step == 2) { xcd_barrier(xbar, tidv); use_local = __builtin_amdgcn_readfirstlane((int)(xb_ld(&xbar.bar[GB_OK]) == (unsigned)gd_)); }
            else { const int phd = (step - 3) % NPH;
                if (use_local && step >= 3 && (phd == 4 || phd == 5 || phd == 6 || phd == 0)) grp_barrier(xbar.bar, (cb_ & 7) * 8 + ((cb_ >> 3) & 7), 4u, tidv); else xcd_barrier(xbar, tidv); }
        }
    }
}

__global__ void __launch_bounds__(NTHREADS) dbg_kernel(Params prm, int mode) {
    Ctx X; X.p = &prm; X.ws = prm.ws; X.lds = nullptr; X.G = gridDim.x; X.c = blockIdx.x; X.tid = threadIdx.x; X.lane = threadIdx.x & 63; X.wave = threadIdx.x >> 6; X.zero = 0;
    if (mode == 0) dbg_check(X, 0); else dbg_report(X);
}

extern "C" void kernel_launch(void* const* d_in, const int* in_sizes, int n_in, void* d_out, int out_size, void* d_ws, size_t ws_size, hipStream_t stream) {
    static int grid = 0;
    if (grid == 0) {
        if (n_in != 24 || ws_size < WS_END) { fprintf(stderr, "kernel_launch: unexpected n_in %d / ws %zu\n", n_in, ws_size); grid = -1; return; }
        int dev = 0, cus = 0, per_cu = 0;
        hipGetDevice(&dev); hipDeviceGetAttribute(&cus, hipDeviceAttributeMultiprocessorCount, dev);
        if (hipFuncSetAttribute((const void*)mk_fwd, hipFuncAttributeMaxDynamicSharedMemorySize, LDS_BYTES) != hipSuccess) { fprintf(stderr, "kernel_launch: hipFuncSetAttribute failed\n"); grid = -1; return; }
        if (hipOccupancyMaxActiveBlocksPerMultiprocessor(&per_cu, (const void*)mk_fwd, NTHREADS, LDS_BYTES) != hipSuccess || per_cu < 1) { fprintf(stderr, "kernel_launch: occupancy query says %d\n", per_cu); per_cu = 1; }
        (void)hipGetLastError();
        grid = cus;
    }
    if (grid < 0) return;
    Params p{};
    for (int i = 0; i < 24; ++i) p.in[i] = (const float*)d_in[i];
    p.out = (float*)d_out; p.ws = (unsigned char*)d_ws;
    for (int i = 0; i < 16; ++i) p.inv_freq[i] = 1.0f / powf(10000.0f, (float)(2 * i) / 32.0f);
#if MULTI_LAUNCH
    for (int s = 0; s < NSTEPS; ++s) {
#if DBG_ON
        if (s == 2 + (DBG_CH * 2 + 1) * NPH) hipLaunchKernelGGL(dbg_kernel, dim3(64), dim3(NTHREADS), 0, stream, p, 0);
#endif

        p.step_lo = s; p.step_hi = s + 1; hipLaunchKernelGGL(mk_fwd, dim3(grid), dim3(NTHREADS), LDS_BYTES, stream, p); }
#if DBG_ON
    hipLaunchKernelGGL(dbg_kernel, dim3(1), dim3(NTHREADS), 0, stream, p, 1);
#endif
#else
    p.step_lo = 0; p.step_hi = NSTEPS;
    (void)hipMemsetAsync((char*)d_ws + WS_BAR, 0, 65536, stream);
    void* args[] = {&p};
    hipError_t e = hipLaunchCooperativeKernel((const void*)mk_fwd, dim3(grid), dim3(NTHREADS), args, LDS_BYTES, stream);
    if (e != hipSuccess) fprintf(stderr, "cooperative launch failed: %s (grid %d)\n", hipGetErrorString(e), grid);
#endif
}
```

```cpp
#include <hip/hip_runtime.h>
#include <hip/hip_cooperative_groups.h>
#include <cstdio>
#include <cstdint>
namespace cg = cooperative_groups;

#ifndef PH4_ATT
#define PH4_ATT 1
#endif
#ifndef PH4_DFT
#define PH4_DFT 1
#endif
#ifndef PH4_CONV
#define PH4_CONV 1
#endif
#ifndef PH4_POOL
#define PH4_POOL 1
#endif
#ifndef DBL_PREP
#define DBL_PREP 0
#endif
#ifndef DBL_MASK
#define DBL_MASK 0
#endif
#ifndef DBG_ON
#define DBG_ON 0
#endif
#ifndef DBG_CH
#define DBG_CH 0
#endif
#ifndef MULTI_LAUNCH
#define MULTI_LAUNCH 0
#endif

#define DI __device__ __forceinline__
#define LAS __attribute__((address_space(3)))
typedef unsigned short bf16_t;
typedef short bf16x8 __attribute__((ext_vector_type(8)));
typedef short s16x4 __attribute__((ext_vector_type(4)));
typedef float f32x4 __attribute__((ext_vector_type(4)));
typedef float f32x2 __attribute__((ext_vector_type(2)));
typedef float f32x16 __attribute__((ext_vector_type(16)));
typedef unsigned u32x4 __attribute__((ext_vector_type(4)));
typedef unsigned u32x2 __attribute__((ext_vector_type(2)));

constexpr int DM = 1024, SEQ = 4096, NLAYER = 2, NIN = 6816;
constexpr int MC = 16384, NCHUNK = 5, CSEQ = 4;
constexpr int NZ = 3072;
constexpr int ZC_GLU = 768, ZC_G = 1792, ZC_GATTN = 2048, ZC_GCONV = 2560, ZC_GFOUR = 2816;
constexpr float NORM_EPS = 1e-6f, LN_EPS = 1e-5f;
constexpr float ATT_SCALE = 0.10206207261596575f;
constexpr int LDS_BYTES = 147456;
constexpr int NTHREADS = 512, NWAVES = 8;

constexpr size_t MiB = 1u << 20;
constexpr size_t WS_ROPE = 0;
constexpr size_t WS_MAB = 1 * MiB;
constexpr size_t WS_W = 2 * MiB, LW = 20 * MiB;
constexpr size_t W_IN = 0, W_G = 6 * MiB, W_UQ = 14 * MiB, W_UKV = 14 * MiB + 512 * 1024, W_UP = 15 * MiB, W_OUT = 17 * MiB + 512 * 1024, W_PW = 19 * MiB + 512 * 1024;
constexpr size_t WS_DFT = 42 * MiB;
constexpr size_t WS_H = 74 * MiB, WS_Z = 106 * MiB, WS_CQN = 202 * MiB, WS_CKVN = 210 * MiB, WS_KROPE = 218 * MiB;
constexpr size_t WS_Q = 219 * MiB, WS_KN = 243 * MiB, WS_V = 259 * MiB, WS_ABT = 275 * MiB, WS_P = 291 * MiB, WS_CB = 323 * MiB;
constexpr size_t WS_U = 331 * MiB, WS_M = 459 * MiB, WS_OB = 491 * MiB, WS_END = 523 * MiB;

struct Params {
    const float* in[24];
    float* out;
    unsigned char* ws;
    float inv_freq[16];
    int step_lo, step_hi;
};

DI unsigned cvt_pk(float lo, float hi) { unsigned r; asm volatile("v_cvt_pk_bf16_f32 %0, %1, %2" : "=v"(r) : "v"(lo), "v"(hi)); return r; }
DI bf16_t f2bf(float f) { unsigned u = __builtin_bit_cast(unsigned, f); return (bf16_t)((u + 0x7fffu + ((u >> 16) & 1u)) >> 16); }
DI float bf2f(bf16_t b) { return __builtin_bit_cast(float, (unsigned)b << 16); }
DI float bflo(unsigned w) { return __builtin_bit_cast(float, w << 16); }
DI float bfhi(unsigned w) { return __builtin_bit_cast(float, w & 0xffff0000u); }
DI float sigmoidf_(float x) { return __builtin_amdgcn_rcpf(1.f + __builtin_amdgcn_exp2f(-1.4426950408889634f * x)); }
DI float siluf_(float x) { return x * sigmoidf_(x); }
DI float wave_sum(float v, int lane) {
#pragma unroll
    for (int o = 1; o < 64; o <<= 1) v += __builtin_bit_cast(float, __builtin_amdgcn_ds_bpermute((lane ^ o) << 2, __builtin_bit_cast(int, v)));
    return v;
}
DI void store8(bf16_t* p, f32x4 v0, f32x4 v1) { u32x4 w; w.x = cvt_pk(v0[0], v0[1]); w.y = cvt_pk(v0[2], v0[3]); w.z = cvt_pk(v1[0], v1[1]); w.w = cvt_pk(v1[2], v1[3]); *(u32x4*)p = w; }
DI void load8(const bf16_t* p, f32x4& v0, f32x4& v1) { u32x4 w = *(const u32x4*)p; v0 = (f32x4){bflo(w.x), bfhi(w.x), bflo(w.y), bfhi(w.y)}; v1 = (f32x4){bflo(w.z), bfhi(w.z), bflo(w.w), bfhi(w.w)}; }

namespace pg8 {
constexpr int BM = 256, BK = 64, HALF = 128, HTB = HALF * BK * 2, STAGE_BYTES = 8 * HTB;
DI int lds_byte(int r, int c) { const int st = (r >> 4) * 2 + (c >> 5), rr = r & 15, cc = c & 31, ob = rr * 64 + cc * 2; return st * 1024 + (ob ^ (((ob >> 9) & 1) << 5)); }
DI void stage_rc(int b, int& R, int& C) { const int st = b / 1024, sb = b % 1024, swz = sb ^ (((sb >> 9) & 1) << 5); R = (st >> 1) * 16 + swz / 64; C = (st & 1) * 32 + (swz % 64) / 2; }
DI int perm32(int rho) { const int n = rho >> 4, i = rho & 15; return 8 * (i >> 2) + 4 * n + (i & 3); }

struct Unit { const char* A; const char* B; int nt; int pm; int pn; int tag; };

template <class Epi, class Sched>
DI void gemm_phase(LAS unsigned char* lds, const int tid, const int lda, const int ldb, const Sched& S, const Epi& E) {
    const int  wid = __builtin_amdgcn_readfirstlane(tid >> 6), lane = tid & 63, wr = wid >> 2, wc = wid & 3, fr = lane & 15, fq = lane >> 4;
    unsigned voffA[2], voffB[2];
#pragma unroll
    for (int i = 0; i < 2; ++i) { int R, C; stage_rc(tid * 16 + i * 8192, R, C); const int Rb = (R & ~31) + perm32(R & 31);
        voffA[i] = (unsigned)(R * lda + C) * 2u; voffB[i] = (unsigned)(Rb * ldb + C) * 2u; }
    const int kstep = BK * 2;
    const int hstepA = HALF * lda * 2, hstepB = HALF * ldb * 2;
    const unsigned ldsw = (unsigned)wid * 1024u;
    const int aoff = lds_byte(wr * 64 + fr, fq * 8), boff = lds_byte(wc * 32 + fr, fq * 8);
#define PG8_SA(b, h) (((b) * 2 + (h)) * HTB)
#define PG8_SB(b, h) ((4 + (b) * 2 + (h)) * HTB)
#define PG8_STAGE(bufoff, gbase, voff, soff) do { const __amdgpu_buffer_rsrc_t _rs = __builtin_amdgcn_make_buffer_rsrc((void*)(gbase), (short)0, (int)0x7fffffff, (int)0x00020000); _Pragma("unroll") for (int _i = 0; _i < 2; ++_i) \
        __builtin_amdgcn_raw_ptr_buffer_load_lds(_rs, (LAS void*)(lds + (bufoff) + ldsw + _i * 8192), 16, (int)(voff)[_i], (int)(soff), 0, 0); } while (0)
#define PG8_LDA(dst, b, h) do { _Pragma("unroll") for (int m = 0; m < 4; ++m) _Pragma("unroll") for (int k = 0; k < 2; ++k) dst[m][k] = *(const LAS bf16x8*)(lds + PG8_SA(b, h) + aoff + m * 2048 + k * 1024); } while (0)
#define PG8_LDB(dst, b, h) do { _Pragma("unroll") for (int n = 0; n < 2; ++n) _Pragma("unroll") for (int k = 0; k < 2; ++k) dst[n][k] = *(const LAS bf16x8*)(lds + PG8_SB(b, h) + boff + n * 2048 + k * 1024); } while (0)
#define PG8_MMA(ai, bj, At, Bt) do { __builtin_amdgcn_s_setprio(1); _Pragma("unroll") for (int m = 0; m < 4; ++m) _Pragma("unroll") for (int n = 0; n < 2; ++n) _Pragma("unroll") for (int k = 0; k < 2; ++k) \
        acc[ai][bj][m][n] = __builtin_amdgcn_mfma_f32_16x16x32_bf16(Bt[n][k], At[m][k], acc[ai][bj][m][n], 0, 0, 0); __builtin_amdgcn_s_setprio(0); } while (0)
#define PG8_WAIT_V(n) asm volatile("s_waitcnt vmcnt(" #n ")" ::: "memory")
#define PG8_WAIT_L(n) asm volatile("s_waitcnt lgkmcnt(" #n ")" ::: "memory")
#define PG8_BAR __builtin_amdgcn_s_barrier()
#define PG8_SCHED __builtin_amdgcn_sched_barrier(0)
    Unit cur, nxt; int ui = 0;
    if (!S.next(0, cur)) return;
    f32x4 acc[2][2][4][2];
#pragma unroll
    for (int a = 0; a < 2; ++a)
#pragma unroll
        for (int b = 0; b < 2; ++b)
#pragma unroll
            for (int m = 0; m < 4; ++m)
#pragma unroll
                for (int n = 0; n < 2; ++n) acc[a][b][m][n] = (f32x4){0.f, 0.f, 0.f, 0.f};
    bf16x8 At[4][2], B0[2][2], B1[2][2];
    const char* cA = cur.A; const char* cB = cur.B;
    PG8_STAGE(PG8_SB(0, 0), cB, voffB, 0); PG8_STAGE(PG8_SB(0, 1), cB, voffB, hstepB); PG8_STAGE(PG8_SA(0, 0), cA, voffA, 0); PG8_STAGE(PG8_SA(0, 1), cA, voffA, hstepA);
    if (wr == 1) PG8_BAR;
    PG8_WAIT_V(2); PG8_BAR;
    PG8_STAGE(PG8_SB(1, 0), cB, voffB, kstep); PG8_STAGE(PG8_SA(1, 0), cA, voffA, kstep); PG8_STAGE(PG8_SB(1, 1), cB, voffB, hstepB + kstep);
    PG8_WAIT_V(6); PG8_BAR;
    for (;;) {
        const bool has_next = S.next(ui + 1, nxt);
        const char* nA = has_next ? nxt.A : cA; const char* nB = has_next ? nxt.B : cB;
        const int nt = cur.nt;
        for (int t = 0; t < nt; t += 2) {
            const bool last = (t == nt - 2);
            const int o1 = (t + 1) * kstep;
            const char* a2 = last ? nA : cA; const char* b2 = last ? nB : cB; const int o2 = last ? 0 : (t + 2) * kstep, o3 = o2 + kstep;
            PG8_LDB(B0, 0, 0); PG8_LDB(B1, 0, 1); PG8_SCHED; PG8_LDA(At, 0, 0); PG8_STAGE(PG8_SA(1, 1), cA, voffA, o1 + hstepA);
            PG8_WAIT_V(8); PG8_WAIT_L(0); PG8_BAR; PG8_MMA(0, 0, At, B0); PG8_MMA(0, 1, At, B1); PG8_BAR; PG8_SCHED;
            PG8_LDA(At, 0, 1); PG8_STAGE(PG8_SB(0, 0), b2, voffB, o2); PG8_STAGE(PG8_SB(0, 1), b2, voffB, o2 + hstepB); PG8_STAGE(PG8_SA(0, 0), a2, voffA, o2);
            PG8_WAIT_V(8); PG8_WAIT_L(0); PG8_BAR; PG8_MMA(1, 0, At, B0); PG8_MMA(1, 1, At, B1); PG8_BAR; PG8_SCHED;
            PG8_LDB(B0, 1, 0); PG8_LDB(B1, 1, 1); PG8_SCHED; PG8_LDA(At, 1, 0); PG8_STAGE(PG8_SA(0, 1), a2, voffA, o2 + hstepA);
            PG8_WAIT_V(8); PG8_WAIT_L(0); PG8_BAR; PG8_MMA(0, 0, At, B0); PG8_MMA(0, 1, At, B1); PG8_BAR; PG8_SCHED;
            PG8_LDA(At, 1, 1); PG8_STAGE(PG8_SB(1, 0), b2, voffB, o3); PG8_STAGE(PG8_SB(1, 1), b2, voffB, o3 + hstepB); PG8_STAGE(PG8_SA(1, 0), a2, voffA, o3);
            PG8_WAIT_V(8); PG8_WAIT_L(0); PG8_BAR; PG8_MMA(1, 0, At, B0); PG8_MMA(1, 1, At, B1); PG8_BAR; PG8_SCHED;
        }
        if (wr == 0) PG8_BAR;
        E(acc, cur, wr, wc, fr, fq);
        if (!has_next) break;
#pragma unroll
        for (int a = 0; a < 2; ++a)
#pragma unroll
            for (int b = 0; b < 2; ++b)
#pragma unroll
                for (int m = 0; m < 4; ++m)
#pragma unroll
                    for (int n = 0; n < 2; ++n) acc[a][b][m][n] = (f32x4){0.f, 0.f, 0.f, 0.f};
        cur = nxt; cA = nA; cB = nB; ++ui;
        if (wr == 1) PG8_BAR;
    }
    PG8_WAIT_V(0);
    PG8_BAR;
#undef PG8_SA
#undef PG8_SB
#undef PG8_STAGE
#undef PG8_LDA
#undef PG8_LDB
#undef PG8_MMA
#undef PG8_WAIT_V
#undef PG8_WAIT_L
#undef PG8_BAR
#undef PG8_SCHED
}
}
using pg8::Unit;
typedef f32x4 Acc[2][2][4][2];

DI bool tile_of(int i, int G, int c, int npn, int& pm, int& pn, int ioff = 0) {
    if ((G & 7) == 0) { const int per = G >> 3, x = c & 7, idx = c >> 3, q = i * per + idx - ioff; if (q < 0 || q >= 8 * npn) return false; pm = 8 * x + (q & 7); pn = q >> 3; return true; }
    const int L = i * G + c; if (L >= 64 * npn) return false; pm = L & 63; pn = L >> 6; return true;
}

struct SchedSimple {
    const char* A; const char* B; int lda, ldb, nt, npn, G, c, ioff;
    DI bool next(int i, Unit& u) const { int pm, pn; if (!tile_of(i, G, c, npn, pm, pn, ioff)) return false;
        u.A = A + (size_t)pm * 256 * lda * 2; u.B = B + (size_t)pn * 256 * ldb * 2; u.nt = nt; u.pm = pm; u.pn = pn; u.tag = 0; return true; }
};
struct SchedQKV {
    const char* Aq; const char* Akv; const char* Bq; const char* Bkv; int G, c;
    DI bool next(int i, Unit& u) const { int pm, pn; if (!tile_of(i, G, c, 7, pm, pn)) return false;
        const bool isq = pn < 3; u.A = (isq ? Aq : Akv) + (size_t)pm * 256 * 256 * 2; u.B = isq ? Bq + (size_t)pn * 256 * 256 * 2 : Bkv + (size_t)(pn - 3) * 256 * 256 * 2;
        u.nt = 4; u.pm = pm; u.pn = isq ? pn : pn - 3; u.tag = isq ? 0 : 1; return true; }
};
struct SchedUp {
    const char* Z; const char* W; int G, c;
    DI bool next(int i, Unit& u) const { const int L = i * G + c; if (L >= 1024) return false; const int br = L >> 8, r = L & 255;
        const int x = r & 7, idx = r >> 3, pm = 8 * x + (idx & 7), pn = idx >> 3;
        const int koff = br == 0 ? 0 : (br == 1 ? 256 : (br == 2 ? 768 : 1024));
        u.A = Z + ((size_t)pm * 256 * NZ + ZC_G + koff) * 2; u.B = W + ((size_t)pn * 256 * 1280 + koff) * 2; u.nt = br == 1 ? 8 : 4; u.pm = pm; u.pn = br * 4 + pn; u.tag = br; return true; }
};
struct SchedGate {
    const char* H; const char* W; int G, c;
    DI bool next(int i, Unit& u) const { const int P = (i >> 2) * G + c; if (P >= 256) return false; const int b = i & 3;
        const int x = P & 7, idx = P >> 3, pm = 8 * x + (idx & 7), pc = idx >> 3;
        u.A = H + (size_t)pm * 256 * 1024 * 2; u.B = W + (size_t)(b * 4 + pc) * 256 * 1024 * 2; u.nt = 16; u.pm = pm; u.pn = b * 4 + pc; u.tag = b; return true; }
};
struct SchedDft {
    const char* T; const char* AB; int G, c;
    DI bool next(int i, Unit& u) const { const int L = i * G + c; if (L >= 256) return false; const int j = L & 7, r = L >> 3, b = r >> 3, kt = r & 7;
        u.A = T + ((size_t)j * 2048 + kt * 256) * 1024 * 2; u.B = AB + (size_t)(b * 8 + j) * 256 * 1024 * 2; u.nt = 16; u.pm = kt; u.pn = 0; u.tag = b * 8 + j; return true; }
};

#define EPI_LOOP_ROWS for (int ai = 0; ai < 2; ++ai) for (int m = 0; m < 4; ++m)
struct EpiIn {
    bf16_t* z; bf16_t* abt;
    DI void operator()(const Acc& acc, const Unit& u, int wr, int wc, int fr, int fq) const {
        const int row0 = u.pm * 256 + wr * 64 + fr, pn = u.pn, cb = wc * 32 + 8 * fq;
        if (pn <= 2 || pn >= 7) {
#pragma unroll
            EPI_LOOP_ROWS { bf16_t* rp = z + (size_t)(row0 + ai * 128 + m * 16) * NZ + pn * 256 + cb;
#pragma unroll
                for (int bj = 0; bj < 2; ++bj) { f32x4 v0 = acc[ai][bj][m][0], v1 = acc[ai][bj][m][1];
                    if (pn >= 7) {
#pragma unroll
                        for (int e = 0; e < 4; ++e) { v0[e] = siluf_(v0[e]); v1[e] = siluf_(v1[e]); } }
                    store8(rp + bj * 128, v0, v1); } __builtin_amdgcn_sched_barrier(0); }
        } else if (pn <= 4) {
#pragma unroll
            EPI_LOOP_ROWS { bf16_t* rp = z + (size_t)(row0 + ai * 128 + m * 16) * NZ + ZC_GLU + (pn - 3) * 128 + cb;
                f32x4 v0, v1;
#pragma unroll
                for (int e = 0; e < 4; ++e) { v0[e] = acc[ai][0][m][0][e] * sigmoidf_(acc[ai][1][m][0][e]); v1[e] = acc[ai][0][m][1][e] * sigmoidf_(acc[ai][1][m][1][e]); }
                store8(rp, v0, v1); __builtin_amdgcn_sched_barrier(0); }
        } else {
            const int koff = pn == 6 ? 512 : 0;
#pragma unroll
            EPI_LOOP_ROWS { const int row = row0 + ai * 128 + m * 16, b = row >> 12, s = row & 4095;
                const int j = (s & 1) + 2 * (s >> 10), kidx = ((s >> 1) & 511) + koff;
                bf16_t* bp = abt + ((size_t)(b * 8 + j) * 256 + cb) * 1024 + kidx;
#pragma unroll
                for (int bj = 0; bj < 2; ++bj)
#pragma unroll
                    for (int n = 0; n < 2; ++n)
#pragma unroll
                        for (int e = 0; e < 4; ++e) bp[(size_t)(bj * 128 + n * 4 + e) * 1024] = f2bf(acc[ai][bj][m][n][e]); __builtin_amdgcn_sched_barrier(0); }
        }
    }
};
struct EpiQKV {
    bf16_t* q; bf16_t* kn; bf16_t* v;
    DI void operator()(const Acc& acc, const Unit& u, int wr, int wc, int fr, int fq) const {
        const int row0 = u.pm * 256 + wr * 64 + fr;
#pragma unroll
        for (int bj = 0; bj < 2; ++bj) { const int c0 = u.pn * 256 + bj * 128 + wc * 32 + 8 * fq; bf16_t* base; int rstride;
            if (u.tag == 0) { const int h = c0 / 96, d = c0 - 96 * h; base = q + (size_t)h * 4096 * 96 + d; rstride = 96; }
            else { const int h = c0 >> 7, w = c0 & 127; base = (w < 64 ? kn : v) + (size_t)h * 4096 * 64 + (w & 63); rstride = 64; }
#pragma unroll
            EPI_LOOP_ROWS { const int row = row0 + ai * 128 + m * 16; const int rr = row + (row >> 12) * 7 * 4096;
                store8(base + (size_t)rr * rstride, acc[ai][bj][m][0], acc[ai][bj][m][1]); __builtin_amdgcn_sched_barrier(0); } }
    }
};
struct EpiPlain {
    bf16_t* O; int ldc; int col0;
    DI void operator()(const Acc& acc, const Unit& u, int wr, int wc, int fr, int fq) const {
        const int row0 = u.pm * 256 + wr * 64 + fr;
#pragma unroll
        EPI_LOOP_ROWS { bf16_t* rp = O + (size_t)(row0 + ai * 128 + m * 16) * ldc + col0 + u.pn * 256 + wc * 32 + 8 * fq;
#pragma unroll
            for (int bj = 0; bj < 2; ++bj) store8(rp + bj * 128, acc[ai][bj][m][0], acc[ai][bj][m][1]); __builtin_amdgcn_sched_barrier(0); }
    }
};
struct EpiDft {
    bf16_t* P;
    DI void operator()(const Acc& acc, const Unit& u, int wr, int wc, int fr, int fq) const {
        const int row0 = u.pm * 256 + wr * 64 + fr;
#pragma unroll
        EPI_LOOP_ROWS { bf16_t* rp = P + ((size_t)u.tag * 2048 + row0 + ai * 128 + m * 16) * 256 + wc * 32 + 8 * fq;
#pragma unroll
            for (int bj = 0; bj < 2; ++bj) store8(rp + bj * 128, acc[ai][bj][m][0], acc[ai][bj][m][1]); __builtin_amdgcn_sched_barrier(0); }
    }
};
struct EpiPw {
    bf16_t* z; const float* pwb;
    DI void operator()(const Acc& acc, const Unit& u, int wr, int wc, int fr, int fq) const {
        const int row0 = u.pm * 256 + wr * 64 + fr;
#pragma unroll
        for (int bj = 0; bj < 2; ++bj) { const int c0 = bj * 128 + wc * 32 + 8 * fq; const f32x4 b0 = *(const f32x4*)(pwb + c0), b1 = *(const f32x4*)(pwb + c0 + 4);
            u32x4 gg[8];
#pragma unroll
            for (int r8 = 0; r8 < 8; ++r8) gg[r8] = *(const u32x4*)(z + (size_t)(row0 + (r8 >> 2) * 128 + (r8 & 3) * 16) * NZ + ZC_GCONV + c0);
            __builtin_amdgcn_sched_barrier(0);
#pragma unroll
            for (int r8 = 0; r8 < 8; ++r8) { const int ai = r8 >> 2, m = r8 & 3; const u32x4 w = gg[r8];
                const f32x4 g0 = {bflo(w.x), bfhi(w.x), bflo(w.y), bfhi(w.y)}, g1 = {bflo(w.z), bfhi(w.z), bflo(w.w), bfhi(w.w)};
                store8(z + (size_t)(row0 + ai * 128 + m * 16) * NZ + ZC_GCONV + c0, (acc[ai][bj][m][0] + b0) * g0, (acc[ai][bj][m][1] + b1) * g1); }
            __builtin_amdgcn_sched_barrier(0); }
    }
};
struct EpiGate {
    const bf16_t* U; bf16_t* mbuf; const float* gb;
    DI void operator()(const Acc& acc, const Unit& u, int wr, int wc, int fr, int fq) const {
        const int row0 = u.pm * 256 + wr * 64 + fr, br = u.tag;
        const int cgb = u.pn * 256 + wc * 32 + 8 * fq;
        u32x4 uA[2], pA[2], uB[2], pB[2];
#define GATE_LOAD(UU, PP, K) do { const int bj_ = (K) >> 2, ai_ = ((K) >> 1) & 1, mh_ = (K) & 1; const int cg_ = cgb + bj_ * 128; _Pragma("unroll") for (int mm = 0; mm < 2; ++mm) { const size_t row = row0 + ai_ * 128 + (2 * mh_ + mm) * 16; \
            UU[mm] = *(const u32x4*)(U + row * 4096 + cg_); if (br != 0) PP[mm] = *(const u32x4*)(mbuf + row * 1024 + (cg_ & 1023)); else PP[mm] = (u32x4){0u, 0u, 0u, 0u}; } } while (0)
#define GATE_DO(UU, PP, K) do { const int bj_ = (K) >> 2, ai_ = ((K) >> 1) & 1, mh_ = (K) & 1; const int cg_ = cgb + bj_ * 128; const f32x4 b0 = *(const f32x4*)(gb + cg_), b1 = *(const f32x4*)(gb + cg_ + 4); \
        _Pragma("unroll") for (int mm = 0; mm < 2; ++mm) { const int m = 2 * mh_ + mm; const size_t row = row0 + ai_ * 128 + m * 16; const u32x4 w = UU[mm], q = PP[mm]; \
            const f32x4 u0 = {bflo(w.x), bfhi(w.x), bflo(w.y), bfhi(w.y)}, u1 = {bflo(w.z), bfhi(w.z), bflo(w.w), bfhi(w.w)}; \
            const f32x4 p0 = {bflo(q.x), bfhi(q.x), bflo(q.y), bfhi(q.y)}, p1 = {bflo(q.z), bfhi(q.z), bflo(q.w), bfhi(q.w)}; \
            f32x4 v0 = acc[ai_][bj_][m][0] + b0, v1 = acc[ai_][bj_][m][1] + b1; \
            _Pragma("unroll") for (int e = 0; e < 4; ++e) { v0[e] = sigmoidf_(v0[e]) * u0[e] + p0[e]; v1[e] = sigmoidf_(v1[e]) * u1[e] + p1[e]; } \
            store8(mbuf + row * 1024 + (cg_ & 1023), v0, v1); } } while (0)
#define SB __builtin_amdgcn_sched_barrier(0)
        GATE_LOAD(uA, pA, 0); SB;
        GATE_LOAD(uB, pB, 1); SB; GATE_DO(uA, pA, 0); SB;
        GATE_LOAD(uA, pA, 2); SB; GATE_DO(uB, pB, 1); SB;
        GATE_LOAD(uB, pB, 3); SB; GATE_DO(uA, pA, 2); SB;
        GATE_LOAD(uA, pA, 4); SB; GATE_DO(uB, pB, 3); SB;
        GATE_LOAD(uB, pB, 5); SB; GATE_DO(uA, pA, 4); SB;
        GATE_LOAD(uA, pA, 6); SB; GATE_DO(uB, pB, 5); SB;
        GATE_LOAD(uB, pB, 7); SB; GATE_DO(uA, pA, 6); SB;
        GATE_DO(uB, pB, 7); SB;
#undef SB
#undef GATE_LOAD
#undef GATE_DO
    }
};

struct SchedQKVPW {
    const char* Aq; const char* Akv; const char* Apw; const char* Bq; const char* Bkv; const char* Bpw; int G, c;
    DI bool next(int i, Unit& u) const { int pm, pn; if (!tile_of(i, G, c, 8, pm, pn)) return false;
        const int t = pn < 3 ? 0 : (pn < 7 ? 1 : 2); const int lp = t == 0 ? pn : (t == 1 ? pn - 3 : 0);
        u.A = (t == 0 ? Aq : (t == 1 ? Akv : Apw)) + (size_t)pm * 256 * 256 * 2; u.B = (t == 0 ? Bq : (t == 1 ? Bkv : Bpw)) + (size_t)lp * 256 * 256 * 2;
        u.nt = 4; u.pm = pm; u.pn = lp; u.tag = t; return true; }
};
struct EpiQKVPW {
    EpiQKV a; EpiPw b;
    DI void operator()(const Acc& acc, const Unit& u, int wr, int wc, int fr, int fq) const { if (u.tag == 2) b(acc, u, wr, wc, fr, fq); else a(acc, u, wr, wc, fr, fq); }
};

namespace att {
constexpr int KROWB = 208, SHM_K = 64 * KROWB, SHM_V = 8192;
constexpr int NBUF = 3, OFF_V = 0, OFF_K = NBUF * SHM_V, OFF_WS = OFF_K + NBUF * SHM_K;
constexpr float THR = 8.f;
#define SBAR() __builtin_amdgcn_sched_barrier(0)
DI int crow(int r, int hi) { return (r & 3) + 8 * (r >> 2) + 4 * hi; }
template <bool FIRST> DI void partialSM(f32x16& p0, f32x16& p1, f32x16& negm, float& alpha) {
    constexpr float THR2 = THR * 1.4426950408889634f;
    float pmax = p0[0];
#pragma unroll
    for (int r = 1; r < 16; ++r) pmax = fmaxf(pmax, p0[r]);
#pragma unroll
    for (int r = 0; r < 16; ++r) pmax = fmaxf(pmax, p1[r]);
    { auto rr = __builtin_amdgcn_permlane32_swap(__float_as_uint(pmax), __float_as_uint(pmax), false, false);
      pmax = fmaxf(__uint_as_float(rr[0]), __uint_as_float(rr[1])); }
    if (!FIRST && __builtin_expect(__all(pmax <= THR2), 1)) { alpha = 1.f; }
    else { const float d = FIRST ? pmax : fmaxf(pmax, 0.f); alpha = FIRST ? 1.f : __builtin_amdgcn_exp2f(-d);
#pragma unroll
        for (int r = 0; r < 16; ++r) { p0[r] -= d; p1[r] -= d; negm[r] -= d; } }
#pragma unroll
    for (int r = 0; r < 16; ++r) p0[r] = __builtin_amdgcn_exp2f(p0[r]);
}
DI void finishSM(f32x16& p0, f32x16& p1, float alpha, float& l_reg, bf16x8& pa0, bf16x8& pa1, bf16x8& pa2, bf16x8& pa3) {
#pragma unroll
    for (int r = 0; r < 16; ++r) p1[r] = __builtin_amdgcn_exp2f(p1[r]);
    float ps = 0;
#pragma unroll
    for (int r = 0; r < 16; ++r) ps += p0[r];
#pragma unroll
    for (int r = 0; r < 16; ++r) ps += p1[r];
    { auto rr = __builtin_amdgcn_permlane32_swap(__float_as_uint(ps), __float_as_uint(ps), false, false);
      ps = __uint_as_float(rr[0]) + __uint_as_float(rr[1]); }
    l_reg = l_reg * alpha + ps;
#define PK4(P, BASE, OUT) do { unsigned a0 = cvt_pk(P[BASE + 0], P[BASE + 1]), a1 = cvt_pk(P[BASE + 2], P[BASE + 3]);   \
    unsigned b0 = cvt_pk(P[BASE + 4], P[BASE + 5]), b1 = cvt_pk(P[BASE + 6], P[BASE + 7]);                              \
    auto r0 = __builtin_amdgcn_permlane32_swap(a0, b0, false, false); auto r1 = __builtin_amdgcn_permlane32_swap(a1, b1, false, false); \
    u32x4 w = {r0[0], r1[0], r0[1], r1[1]}; OUT = __builtin_bit_cast(bf16x8, w); } while (0)
    PK4(p0, 0, pa0); PK4(p0, 8, pa1); PK4(p1, 0, pa2); PK4(p1, 8, pa3);
#undef PK4
}
DI void qkt(f32x16& p0, f32x16& p1, const char* Ks, const bf16x8* qr, int r32, int hi, const f32x16& negm) {
    const char* k0p = Ks + r32 * KROWB + hi * 16; const char* k1p = k0p + 32 * KROWB;
#pragma unroll
    for (int d0 = 0; d0 < 6; ++d0) {
        const bf16x8 b0 = *reinterpret_cast<const bf16x8*>(k0p + d0 * 32), b1 = *reinterpret_cast<const bf16x8*>(k1p + d0 * 32);
        if (d0 == 0) { p0 = __builtin_amdgcn_mfma_f32_32x32x16_bf16(b0, qr[0], negm, 0, 0, 0); p1 = __builtin_amdgcn_mfma_f32_32x32x16_bf16(b1, qr[0], negm, 0, 0, 0); }
        else { p0 = __builtin_amdgcn_mfma_f32_32x32x16_bf16(b0, qr[d0], p0, 0, 0, 0); p1 = __builtin_amdgcn_mfma_f32_32x32x16_bf16(b1, qr[d0], p1, 0, 0, 0); } }
}
DI int v_st(int k, int c) { const int kk = (k & ~0xC) | ((k & 4) << 1) | ((k & 8) >> 1); return ((kk >> 3) * 2 + (c >> 5)) * 512 + ((kk & 7) * 32 + (c & 31)) * 2; }
DI int v_rd_base(int lane) { return ((lane & 3) << 3) | (((lane >> 2) & 3) << 6) | (((lane >> 4) & 1) << 5) | (((lane >> 5) & 1) << 8); }
constexpr int v_rd_off(int d0, int ks, int half) { return d0 * 512 + ks * 2048 + half * 1024; }
typedef short v4i16_t __attribute__((ext_vector_type(4)));
template <int OFF> DI s16x4 tr_read(int vb) { return __builtin_bit_cast(s16x4, __builtin_amdgcn_ds_read_tr16_b64_v4i16((LAS v4i16_t*)(unsigned long long)(unsigned)(vb + OFF))); }
template <int D0> DI void pv_one(f32x16& od, int vb, bf16x8 pa0, bf16x8 pa1, bf16x8 pa2, bf16x8 pa3) {
    const s16x4 l0 = tr_read<v_rd_off(D0, 0, 0)>(vb), h0 = tr_read<v_rd_off(D0, 0, 1)>(vb), l1 = tr_read<v_rd_off(D0, 1, 0)>(vb), h1 = tr_read<v_rd_off(D0, 1, 1)>(vb);
    const s16x4 l2 = tr_read<v_rd_off(D0, 2, 0)>(vb), h2 = tr_read<v_rd_off(D0, 2, 1)>(vb), l3 = tr_read<v_rd_off(D0, 3, 0)>(vb), h3 = tr_read<v_rd_off(D0, 3, 1)>(vb);
#define PK(L, H) (bf16x8){L[0], L[1], L[2], L[3], H[0], H[1], H[2], H[3]}
    od = __builtin_amdgcn_mfma_f32_32x32x16_bf16(pa0, PK(l0, h0), od, 0, 0, 0);
    od = __builtin_amdgcn_mfma_f32_32x32x16_bf16(pa1, PK(l1, h1), od, 0, 0, 0);
    od = __builtin_amdgcn_mfma_f32_32x32x16_bf16(pa2, PK(l2, h2), od, 0, 0, 0);
    od = __builtin_amdgcn_mfma_f32_32x32x16_bf16(pa3, PK(l3, h3), od, 0, 0, 0);
#undef PK
}
DI void pv_d0(f32x16* o, int vb, bf16x8 pa0, bf16x8 pa1, bf16x8 pa2, bf16x8 pa3) { pv_one<0>(o[0], vb, pa0, pa1, pa2, pa3); pv_one<1>(o[1], vb, pa0, pa1, pa2, pa3); }

DI void attn_unit(const bf16_t* __restrict__ Qb, const bf16_t* __restrict__ Kn, const bf16_t* __restrict__ Kr, const bf16_t* __restrict__ Vh,
                  const bf16_t* Zg, bf16_t* Zo, const float* __restrict__ ropec, const float* __restrict__ ropes, int pos0, char* lds, const int tid) {
    const int wid = tid >> 6, lane = tid & 63, r32 = lane & 31, hi = lane >> 5;
    char* V_lds = lds + OFF_V; char* K_lds = lds + OFF_K;
    float* ws = (float*)(lds + OFF_WS) + wid * 64; float* li_l = ws; float* al_l = ws + 32;
    float l_reg = 0; f32x16 o[2], negm;
#pragma unroll
    for (int r = 0; r < 16; ++r) { o[0][r] = 0.f; o[1][r] = 0.f; negm[r] = 0.f; }
    bf16x8 qr[6];
    { const bf16_t* Qw = Qb + (size_t)(wid * 32 + r32) * 96 + hi * 8;
#pragma unroll
      for (int d0 = 0; d0 < 6; ++d0) qr[d0] = *reinterpret_cast<const bf16x8*>(Qw + d0 * 16);
      const int pos = pos0 + wid * 32 + r32;
      const f32x4 c0 = *(const f32x4*)(ropec + pos * 16 + hi * 8), c1 = *(const f32x4*)(ropec + pos * 16 + hi * 8 + 4);
      const f32x4 s0 = *(const f32x4*)(ropes + pos * 16 + hi * 8), s1 = *(const f32x4*)(ropes + pos * 16 + hi * 8 + 4);
      float x1[8], x2[8], cs[8], sn[8];
#pragma unroll
      for (int j = 0; j < 8; ++j) { x1[j] = bf2f((bf16_t)qr[4][j]); x2[j] = bf2f((bf16_t)qr[5][j]); cs[j] = j < 4 ? c0[j & 3] : c1[j & 3]; sn[j] = j < 4 ? s0[j & 3] : s1[j & 3]; }
      u32x4 w1, w2;
      w1.x = cvt_pk(x1[0] * cs[0] - x2[0] * sn[0], x1[1] * cs[1] - x2[1] * sn[1]); w1.y = cvt_pk(x1[2] * cs[2] - x2[2] * sn[2], x1[3] * cs[3] - x2[3] * sn[3]);
      w1.z = cvt_pk(x1[4] * cs[4] - x2[4] * sn[4], x1[5] * cs[5] - x2[5] * sn[5]); w1.w = cvt_pk(x1[6] * cs[6] - x2[6] * sn[6], x1[7] * cs[7] - x2[7] * sn[7]);
      w2.x = cvt_pk(x2[0] * cs[0] + x1[0] * sn[0], x2[1] * cs[1] + x1[1] * sn[1]); w2.y = cvt_pk(x2[2] * cs[2] + x1[2] * sn[2], x2[3] * cs[3] + x1[3] * sn[3]);
      w2.z = cvt_pk(x2[4] * cs[4] + x1[4] * sn[4], x2[5] * cs[5] + x1[5] * sn[5]); w2.w = cvt_pk(x2[6] * cs[6] + x1[6] * sn[6], x2[7] * cs[7] + x1[7] * sn[7]);
      qr[4] = __builtin_bit_cast(bf16x8, w1); qr[5] = __builtin_bit_cast(bf16x8, w2); }
    const int ka_r = tid / 12, ka_c = tid - 12 * ka_r; const int kb_i = 512 + (tid >> 1), kb_r = kb_i / 12, kb_c = kb_i - 12 * kb_r, kb_h = (tid & 1) * 8;
    const int dKr = (int)((const char*)Kr - (const char*)Kn);
    const int koa = ka_c < 8 ? (ka_r * 64 + ka_c * 8) * 2 : dKr + (ka_r * 32 + (ka_c - 8) * 8) * 2; const int ksa = ka_c < 8 ? 128 : 64;
    const int kob = (kb_c < 8 ? (kb_r * 64 + kb_c * 8) * 2 : dKr + (kb_r * 32 + (kb_c - 8) * 8) * 2) + kb_h; const int ksb = kb_c < 8 ? 128 : 64;
    const int kda = ka_r * KROWB + ka_c * 16, kdb = kb_r * KROWB + kb_c * 16 + kb_h;
    const int vr = tid >> 3, vc = (tid & 7) * 8; const int vo = (vr * 64 + vc) * 2; const int vd = v_st(vr, vc);
    const int vb0 = (int)(uintptr_t)V_lds + v_rd_base(lane);
    struct { bf16x8 ka, vv; u32x2 kb; } sr_[2];
#define SLOAD(i, k0) do { sr_[i].ka = *reinterpret_cast<const bf16x8*>((const char*)Kn + (koa + (k0) * ksa)); sr_[i].kb = *reinterpret_cast<const u32x2*>((const char*)Kn + (kob + (k0) * ksb)); \
    sr_[i].vv = *reinterpret_cast<const bf16x8*>((const char*)Vh + (vo + (k0) * 128)); } while (0)
#define SWRITE(b, i) do { *(bf16x8*)(V_lds + (b) * SHM_V + vd) = sr_[i].vv; *(bf16x8*)(K_lds + (b) * SHM_K + kda) = sr_[i].ka; \
    *(u32x2*)(K_lds + (b) * SHM_K + kdb) = sr_[i].kb; } while (0)
#define SWAIT() asm volatile("s_waitcnt vmcnt(3)" ::: "memory")
#define RESC(a) do { if (__any((a) < 1.f)) { if (hi == 0) al_l[r32] = (a); asm volatile("s_waitcnt lgkmcnt(0)" ::: "memory"); \
    _Pragma("unroll") for (int d = 0; d < 2; ++d) _Pragma("unroll") for (int r = 0; r < 16; ++r) o[d][r] *= al_l[crow(r, hi)]; } } while (0)
    f32x16 pA0, pA1, pB0, pB1; float alA, alB; bf16x8 pa0, pa1, pa2, pa3; constexpr int NT = SEQ / 64;
    SLOAD(0, 0); asm volatile("s_waitcnt vmcnt(0)" ::: "memory"); SWRITE(0, 0); __syncthreads();
    qkt(pA0, pA1, K_lds, qr, r32, hi, negm); partialSM<true>(pA0, pA1, negm, alA);
    SLOAD(1, 64); SLOAD(0, 128);
    SWAIT(); SWRITE(1, 1); __syncthreads();
    int bc = 1;
    for (int j = 1; j + 1 < NT; j += 2) {
        const int bp = bc == 0 ? 2 : bc - 1, bn = bc == 2 ? 0 : bc + 1, bnn = bn == 2 ? 0 : bn + 1;
        SBAR(); qkt(pB0, pB1, K_lds + bc * SHM_K, qr, r32, hi, negm);
        finishSM(pA0, pA1, alA, l_reg, pa0, pa1, pa2, pa3); SBAR();
        SLOAD(1, (j + 2) * 64); SBAR();
        pv_d0(o, vb0 + bp * SHM_V, pa0, pa1, pa2, pa3); partialSM<false>(pB0, pB1, negm, alB);
        SWAIT(); SWRITE(bn, 0);
        RESC(alB); __syncthreads();
        SBAR(); qkt(pA0, pA1, K_lds + bn * SHM_K, qr, r32, hi, negm);
        finishSM(pB0, pB1, alB, l_reg, pa0, pa1, pa2, pa3); SBAR();
        if (j + 3 < NT) SLOAD(0, (j + 3) * 64); SBAR();
        pv_d0(o, vb0 + bc * SHM_V, pa0, pa1, pa2, pa3); partialSM<false>(pA0, pA1, negm, alA);
        SWAIT(); SWRITE(bnn, 1);
        RESC(alA); __syncthreads();
        bc = bnn;
    }
    { const int bp = bc == 0 ? 2 : bc - 1;
      SBAR(); qkt(pB0, pB1, K_lds + bc * SHM_K, qr, r32, hi, negm);
      finishSM(pA0, pA1, alA, l_reg, pa0, pa1, pa2, pa3); SBAR();
      pv_d0(o, vb0 + bp * SHM_V, pa0, pa1, pa2, pa3); partialSM<false>(pB0, pB1, negm, alB);
      RESC(alB);
      finishSM(pB0, pB1, alB, l_reg, pa0, pa1, pa2, pa3); SBAR();
      pv_d0(o, vb0 + bc * SHM_V, pa0, pa1, pa2, pa3); }
    if (hi == 0) li_l[r32] = l_reg; asm volatile("s_waitcnt lgkmcnt(0)" ::: "memory");
    bf16_t* Zw = Zo + (size_t)(wid * 32) * NZ; const bf16_t* Zgw = Zg + (size_t)(wid * 32) * NZ;
#pragma unroll
    for (int r = 0; r < 16; ++r) { const int orow = crow(r, hi); const float rl = __builtin_amdgcn_rcpf(li_l[orow]);
#pragma unroll
        for (int d0 = 0; d0 < 2; ++d0) { const size_t off = (size_t)orow * NZ + d0 * 32 + r32; Zw[off] = f2bf(o[d0][r] * rl * bf2f(Zgw[off])); } }
    __syncthreads();
#undef SLOAD
#undef SWRITE
#undef SWAIT
#undef RESC
}
}

struct Ctx {
    const Params* p; unsigned char* ws; char* lds; int G, c, tid, wave, zero;
};

DI void job_transpose(const Ctx& X, const float* W, int ldw, int col0, int ncols, int K, int kvalid, bf16_t* dst, int ldd, int drow0, int dcol0, float scale) {
    const int k8n = K >> 3, total = ncols * k8n;
    for (int it = X.c * NTHREADS + X.tid; it < total; it += X.G * NTHREADS) {
        const int n = it % ncols, k8 = it / ncols; float v[8];
#pragma unroll
        for (int i = 0; i < 8; ++i) { const int k = k8 * 8 + i; v[i] = k < kvalid ? W[(size_t)k * ldw + col0 + n] * scale : 0.f; }
        u32x4 w; w.x = cvt_pk(v[0], v[1]); w.y = cvt_pk(v[2], v[3]); w.z = cvt_pk(v[4], v[5]); w.w = cvt_pk(v[6], v[7]);
        *(u32x4*)(dst + (size_t)(drow0 + n) * ldd + dcol0 + k8 * 8) = w;
    }
}
DI void job_zero_rows(const Ctx& X, bf16_t* dst, int ldd, int drow0, int nrows, int K) {
    const int k8n = K >> 3, total = nrows * k8n; unsigned zz = 0u; asm volatile("" : "+v"(zz));
    for (int it = X.c * NTHREADS + X.tid; it < total; it += X.G * NTHREADS) { const int n = it / k8n, k8 = it % k8n;
        *(u32x4*)(dst + (size_t)(drow0 + n) * ldd + k8 * 8) = (u32x4){zz, zz, zz, zz}; }
}

DI void prep1(const Ctx& X) {
    const Params& P = *X.p; unsigned char* ws = X.ws;
    const int gt = X.c * NTHREADS + X.tid, GT = X.G * NTHREADS;
    if (gt < 16) ((float*)(ws + 768 * 1024))[gt] = 0.f;
    { float* rc = (float*)(ws + WS_ROPE); float* rs = rc + 4096 * 16;
      for (int it = gt; it < 4096 * 16; it += GT) { const int pos = it >> 4, i = it & 15; const float ang = (float)pos * P.inv_freq[i];
          double rev = (double)ang * 0.15915494309189535; rev -= __builtin_rint(rev); const float rf = (float)rev;
          rc[it] = __builtin_amdgcn_cosf(rf); rs[it] = __builtin_amdgcn_sinf(rf); } }
    { bf16_t* T = (bf16_t*)(ws + WS_DFT);
      for (int it = gt; it < 8 * 2048 * 128; it += GT) { const int k8 = it & 127, ks = (it >> 7) & 2047, j = it >> 18; float v[8];
#pragma unroll
          for (int i = 0; i < 8; ++i) { const int kidx = k8 * 8 + i, kk = kidx & 511, s = 2 * ((j >> 1) * 512 + kk) + (j & 1);
              const float fr = (float)((ks * s) & 4095) * (1.f / 4096.f);
              v[i] = (kidx < 512 ? __builtin_amdgcn_cosf(fr) : -__builtin_amdgcn_sinf(fr)) * (1.f / 64.f); }
          u32x4 w; w.x = cvt_pk(v[0], v[1]); w.y = cvt_pk(v[2], v[3]); w.z = cvt_pk(v[4], v[5]); w.w = cvt_pk(v[6], v[7]);
          *(u32x4*)(T + (size_t)it * 8) = w; } }
    for (int l = 0; l < NLAYER; ++l) {
        unsigned char* wl = ws + WS_W + (size_t)l * LW;
        const float* w_in = P.in[4 + X.zero] + (size_t)l * DM * NIN;
        bf16_t* WinT = (bf16_t*)(wl + W_IN);
        job_transpose(X, w_in, NIN, 256, 256, DM, DM, WinT, DM, 256, 0, 1.f);
        job_transpose(X, w_in, NIN, 512, 160, DM, DM, WinT, DM, 512, 0, 1.f);
        job_zero_rows(X, WinT, DM, 672, 96, DM);
        job_transpose(X, w_in, NIN, 672, 128, DM, DM, WinT, DM, 768, 0, 1.f);
        job_transpose(X, w_in, NIN, 928, 128, DM, DM, WinT, DM, 896, 0, 1.f);
        job_transpose(X, w_in, NIN, 800, 128, DM, DM, WinT, DM, 1024, 0, 1.f);
        job_transpose(X, w_in, NIN, 1056, 128, DM, DM, WinT, DM, 1152, 0, 1.f);
        job_transpose(X, w_in, NIN, 1440, 1280, DM, DM, WinT, DM, 1792, 0, 1.f);
        job_transpose(X, w_in, NIN, 2720, 4096, DM, DM, (bf16_t*)(wl + W_G), DM, 0, 0, 1.f);
        job_transpose(X, P.in[7 + X.zero] + (size_t)l * 256 * 768, 768, 0, 768, 256, 256, (bf16_t*)(wl + W_UQ), 256, 0, 0, ATT_SCALE * 1.4426950408889634f);
        job_transpose(X, P.in[9 + X.zero] + (size_t)l * 128 * 1024, 1024, 0, 1024, 256, 128, (bf16_t*)(wl + W_UKV), 256, 0, 0, 1.f);
        job_transpose(X, P.in[19 + X.zero] + (size_t)l * 256 * DM, DM, 0, DM, 256, 256, (bf16_t*)(wl + W_UP), 1280, 0, 0, 1.f);
        job_transpose(X, P.in[20 + X.zero] + (size_t)l * 512 * DM, DM, 0, DM, 512, 512, (bf16_t*)(wl + W_UP), 1280, 0, 256, 1.f);
        job_transpose(X, P.in[21 + X.zero] + (size_t)l * 256 * DM, DM, 0, DM, 256, 256, (bf16_t*)(wl + W_UP), 1280, 0, 768, 1.f);
        job_transpose(X, P.in[22 + X.zero] + (size_t)l * 256 * DM, DM, 0, DM, 256, 256, (bf16_t*)(wl + W_UP), 1280, 0, 1024, 1.f);
        job_transpose(X, P.in[23 + X.zero] + (size_t)l * DM * DM, DM, 0, DM, DM, DM, (bf16_t*)(wl + W_OUT), DM, 0, 0, 1.f);
        job_transpose(X, P.in[16 + X.zero] + (size_t)l * 256 * 256, 256, 0, 256, 256, 256, (bf16_t*)(wl + W_PW), 256, 0, 0, 1.f);
        { const float* pw = P.in[10 + X.zero] + (size_t)l * 4 * 64 * 64; const float* psc = P.in[11 + X.zero] + (size_t)l * 256;
          for (int it = gt; it < DM * 256; it += GT) { const int n = it & 255, k = it >> 8, g = n >> 6, d = n & 63; float a = 0.f;
              const float* wr_ = w_in + (size_t)k * NIN + g * 64; const float* pp = pw + g * 4096 + d;
#pragma unroll 8
              for (int cc = 0; cc < 64; ++cc) a = fmaf(wr_[cc], pp[cc * 64], a);
              WinT[(size_t)n * DM + k] = f2bf(a * psc[n]); } }
        { const float* wf = P.in[18 + X.zero] + (size_t)l * 256 * 256; float* MA = (float*)(ws + WS_MAB) + (size_t)l * 2 * 65536; float* MB = MA + 65536;
          for (int it = gt; it < 65536; it += GT) { const int d = it & 255, gc = it >> 8, g = gc >> 6, cch = gc & 63; float a = 0.f, b = 0.f;
              for (int kc = 0; kc < 64; ++kc) { const float fr = (float)((kc * cch) & 63) * (1.f / 64.f); const float w = wf[(size_t)(g * 64 + kc) * 256 + d];
                  a = fmaf(__builtin_amdgcn_cosf(fr), w, a); b = fmaf(__builtin_amdgcn_sinf(fr), w, b); }
              MA[it] = a; MB[it] = b; } }
    }
}
DI void prep2(const Ctx& X) {
    const Params& P = *X.p; unsigned char* ws = X.ws;
    const int gt = X.c * NTHREADS + X.tid, GT = X.G * NTHREADS;
    for (int l = 0; l < NLAYER; ++l) {
        const float* w_in = P.in[4 + X.zero] + (size_t)l * DM * NIN + 1184; bf16_t* WinT = (bf16_t*)(ws + WS_W + (size_t)l * LW + W_IN);
        const float* MA = (const float*)(ws + WS_MAB) + (size_t)l * 2 * 65536;
        for (int it = gt; it < DM * 512; it += GT) { const int n = it & 511, k = it >> 9; const float* Mx = MA + (n >> 8) * 65536 + (n & 255); const float* wr_ = w_in + (size_t)k * NIN; float a = 0.f;
#pragma unroll 8
            for (int gc = 0; gc < 256; ++gc) a = fmaf(wr_[gc], Mx[gc * 256], a);
            WinT[(size_t)(1280 + n) * DM + k] = f2bf(a * 0.125f); }
    }
}

DI void norm_pass(const Ctx& X, int ch, int l) {
    float NEPS = NORM_EPS; asm volatile("" : "+s"(NEPS));
    const Params& P = *X.p; const int lane = X.tid & 63;
    const int gw = X.G == 256 ? (256 * (8 * (X.c & 7) + ((X.c >> 3) & 7)) + 64 * (X.c >> 6) + 8 * X.wave) : X.c * NWAVES + X.wave, NGW = X.G == 256 ? 1 : X.G * NWAVES;
    const int rend = X.G == 256 ? gw + 8 : MC;
    const float* xin = ch == 0 ? P.in[0 + X.zero] : P.in[1 + X.zero] + (size_t)(ch - 1) * MC * DM;
    float* xo = P.out + (size_t)ch * MC * DM;
    const bf16_t* ob = (const bf16_t*)(X.ws + WS_OB); bf16_t* hb = (bf16_t*)(X.ws + WS_H);
    for (int r = gw; r < rend; r += NGW) {
        const float* xr = (l == 0 ? xin : (l == 1 ? xin : xo)) + (size_t)r * DM;
        f32x4 v[4];
#pragma unroll
        for (int j = 0; j < 4; ++j) v[j] = *(const f32x4*)(xr + (lane + 64 * j) * 4);
        if (l >= 1) {
            const float* pg = P.in[3 + X.zero] + (size_t)(l - 1) * DM; f32x4 ov[4]; float ss = 0.f;
#pragma unroll
            for (int j = 0; j < 4; ++j) { const u32x2 w = *(const u32x2*)(ob + (size_t)r * DM + (lane + 64 * j) * 4); ov[j] = (f32x4){bflo(w.x), bfhi(w.x), bflo(w.y), bfhi(w.y)};
                ss += ov[j][0] * ov[j][0] + ov[j][1] * ov[j][1] + ov[j][2] * ov[j][2] + ov[j][3] * ov[j][3]; }
            const float rs = __builtin_amdgcn_rsqf(wave_sum(ss, lane) * (1.f / DM) + NEPS);
#pragma unroll
            for (int j = 0; j < 4; ++j) { const f32x4 g = *(const f32x4*)(pg + (lane + 64 * j) * 4); v[j] += ov[j] * rs * g; *(f32x4*)(xo + (size_t)r * DM + (lane + 64 * j) * 4) = v[j]; }
        }
        if (l <= 1) {
            const float* pg = P.in[2 + X.zero] + (size_t)l * DM; float ss = 0.f;
#pragma unroll
            for (int j = 0; j < 4; ++j) ss += v[j][0] * v[j][0] + v[j][1] * v[j][1] + v[j][2] * v[j][2] + v[j][3] * v[j][3];
            const float rs = __builtin_amdgcn_rsqf(wave_sum(ss, lane) * (1.f / DM) + NEPS);
#pragma unroll
            for (int j = 0; j < 4; ++j) { const f32x4 g = *(const f32x4*)(pg + (lane + 64 * j) * 4); const f32x4 hv = v[j] * rs * g;
                u32x2 w; w.x = cvt_pk(hv[0], hv[1]); w.y = cvt_pk(hv[2], hv[3]); *(u32x2*)(hb + (size_t)r * DM + (lane + 64 * j) * 4) = w; }
        }
    }
}

DI void s_pass(const Ctx& X, int l) {
    float NEPS = NORM_EPS; asm volatile("" : "+s"(NEPS));
    const Params& P = *X.p; const int gw = X.c * NWAVES + X.wave, NGW = X.G * NWAVES, lane = X.tid & 63;
    const bf16_t* z = (const bf16_t*)(X.ws + WS_Z); bf16_t* cqn = (bf16_t*)(X.ws + WS_CQN); bf16_t* ckvn = (bf16_t*)(X.ws + WS_CKVN); bf16_t* kro = (bf16_t*)(X.ws + WS_KROPE);
    const float* qg = P.in[6 + X.zero] + (size_t)l * 256; const float* kg = P.in[8 + X.zero] + (size_t)l * 128;
    const float* rc = (const float*)(X.ws + WS_ROPE); const float* rs_ = rc + 4096 * 16;
    for (int r = gw; r < MC; r += NGW) {
        const bf16_t* zr = z + (size_t)r * NZ;
        { const u32x2 w = *(const u32x2*)(zr + 256 + lane * 4); f32x4 v = {bflo(w.x), bfhi(w.x), bflo(w.y), bfhi(w.y)};
          const float rs = __builtin_amdgcn_rsqf(wave_sum(v[0] * v[0] + v[1] * v[1] + v[2] * v[2] + v[3] * v[3], lane) * (1.f / 256.f) + NEPS);
          const f32x4 g = *(const f32x4*)(qg + lane * 4); v = v * rs * g; u32x2 o; o.x = cvt_pk(v[0], v[1]); o.y = cvt_pk(v[2], v[3]); *(u32x2*)(cqn + (size_t)r * 256 + lane * 4) = o; }
        { const unsigned w = *(const unsigned*)(zr + 512 + lane * 2); float a = bflo(w), b = bfhi(w);
          const float rs = __builtin_amdgcn_rsqf(wave_sum(a * a + b * b, lane) * (1.f / 128.f) + NEPS);
          const f32x2 g = *(const f32x2*)(kg + lane * 2); *(unsigned*)(ckvn + (size_t)r * 256 + lane * 2) = cvt_pk(a * rs * g[0], b * rs * g[1]);
          *(unsigned*)(ckvn + (size_t)r * 256 + 128 + lane * 2) = 0u; }
        if (lane < 16) { const int pos = r & 4095; const float x1 = bf2f(zr[640 + lane]), x2 = bf2f(zr[656 + lane]), cs = rc[pos * 16 + lane], sn = rs_[pos * 16 + lane];
          kro[(size_t)r * 32 + lane] = f2bf(x1 * cs - x2 * sn); kro[(size_t)r * 32 + 16 + lane] = f2bf(x2 * cs + x1 * sn); }
    }
}

DI void pool_pass(const Ctx& X, bf16_t* zo) {
    bf16_t* z = (bf16_t*)(X.ws + WS_Z);
    for (int e = X.c * NTHREADS + X.tid; e < MC * 32; e += X.G * NTHREADS) {
        const int t = e >> 5, cgp = e & 31, ch0 = cgp * 8, g = cgp >> 3, hw = 1 << g, s = t & 4095, tb = t - s;
        const int lo = max(s - hw, 0), hi = min(s + hw, SEQ);
        f32x4 a0 = {0.f, 0.f, 0.f, 0.f}, a1 = a0;
        for (int r = lo; r < hi; ++r) { f32x4 v0, v1; load8(z + (size_t)(tb + r) * NZ + ch0, v0, v1); a0 += v0; a1 += v1; }
        const float ic = 1.f / (float)(hi - lo); f32x4 u0, u1, g0, g1; load8(z + (size_t)t * NZ + ch0, u0, u1); load8(z + (size_t)t * NZ + ZC_G + ch0, g0, g1);
        store8(zo + (size_t)t * NZ + ZC_G + ch0, (a0 * ic - u0) * g0, (a1 * ic - u1) * g1);
    }
}

DI void dft_combine(const Ctx& X) {
    bf16_t* z = (bf16_t*)(X.ws + WS_Z); const bf16_t* Pp = (const bf16_t*)(X.ws + WS_P);
    for (int e = X.c * NTHREADS + X.tid; e < MC * 32; e += X.G * NTHREADS) {
        const int t = e >> 5, ch0 = (e & 31) * 8, b = t >> 12, s = t & 4095, ks = s & 2047; const float sg = s >= 2048 ? -1.f : 1.f;
        f32x4 a0 = {0.f, 0.f, 0.f, 0.f}, a1 = a0;
#pragma unroll
        for (int j = 0; j < 8; ++j) { f32x4 v0, v1; load8(Pp + ((size_t)(b * 8 + j) * 2048 + ks) * 256 + ch0, v0, v1); const float sj = (j & 1) ? sg : 1.f; a0 += v0 * sj; a1 += v1 * sj; }
        f32x4 g0, g1; bf16_t* zp = z + (size_t)t * NZ + ZC_GFOUR + ch0; load8(zp, g0, g1); store8(zp, a0 * g0, a1 * g1);
    }
}

DI void conv_item(const Ctx& X, int item, int l) {
    float LEPS = LN_EPS; asm volatile("" : "+s"(LEPS)); unsigned zz = 0u; asm volatile("" : "+v"(zz));
    const Params& P = *X.p; const int tid = X.tid;
    const bf16_t* z = (const bf16_t*)(X.ws + WS_Z); bf16_t* cb = (bf16_t*)(X.ws + WS_CB);
    char* gl = X.lds; float* co = (float*)(X.lds + 49152);
    const int t0 = item * 64, s0 = t0 & 4095, tb = t0 - s0;
    for (int i = tid; i < 94 * 32; i += NTHREADS) { const int r = i >> 5, c8 = i & 31, s = s0 - 15 + r; u32x4 w = {zz, zz, zz, zz};
        if (s >= 0 && s < SEQ) w = *(const u32x4*)(z + (size_t)(tb + s) * NZ + ZC_GLU + c8 * 8);
        *(u32x4*)(gl + r * 512 + c8 * 16) = w; }
    __syncthreads();
    { const int cp = tid & 127, tg = tid >> 7; const float* cw = P.in[12 + X.zero] + (size_t)l * 31 * 256 + 2 * cp; const f32x2 bias = *(const f32x2*)(P.in[13 + X.zero] + (size_t)l * 256 + 2 * cp);
      f32x2 w[31];
#pragma unroll
      for (int k = 0; k < 31; ++k) w[k] = *(const f32x2*)(cw + k * 256);
      f32x2 a[16];
#pragma unroll
      for (int i = 0; i < 16; ++i) a[i] = bias;
#pragma unroll
      for (int r = 0; r < 46; ++r) { const unsigned u = *(const unsigned*)(gl + (tg * 16 + r) * 512 + cp * 4); const f32x2 v = {bflo(u), bfhi(u)};
#pragma unroll
          for (int i = 0; i < 16; ++i) { if (r - i >= 0 && r - i <= 30) a[i] += v * w[r - i]; } }
#pragma unroll
      for (int i = 0; i < 16; ++i) *(f32x2*)(co + (tg * 16 + i) * 256 + 2 * cp) = a[i]; }
    __syncthreads();
    { const int wv = X.wave, lane = X.tid & 63; const f32x4 g = *(const f32x4*)(P.in[14 + X.zero] + (size_t)l * 256 + lane * 4), be = *(const f32x4*)(P.in[15 + X.zero] + (size_t)l * 256 + lane * 4);
#pragma unroll
      for (int i = 0; i < 8; ++i) { const int tok = wv * 8 + i; f32x4 v = *(const f32x4*)(co + tok * 256 + lane * 4);
          const float mu = wave_sum(v[0] + v[1] + v[2] + v[3], lane) * (1.f / 256.f); v -= mu;
          const float rs = __builtin_amdgcn_rsqf(wave_sum(v[0] * v[0] + v[1] * v[1] + v[2] * v[2] + v[3] * v[3], lane) * (1.f / 256.f) + LEPS);
          v = v * rs * g + be;
#pragma unroll
          for (int e = 0; e < 4; ++e) v[e] = siluf_(v[e]);
          u32x2 o; o.x = cvt_pk(v[0], v[1]); o.y = cvt_pk(v[2], v[3]); *(u32x2*)(cb + (size_t)(t0 + tok) * 256 + lane * 4) = o; } }
    __syncthreads();
}


DI float dotbf(const bf16_t* a, const bf16_t* b, int K) { float s = 0.f; for (int k = 0; k < K; ++k) s = fmaf(bf2f(a[k]), bf2f(b[k]), s); return s; }
DI void dbg_max(float* w, float v) { atomicMax((int*)w, __builtin_bit_cast(int, fabsf(v))); }
DI void dbg_check(const Ctx& X, int l) {
    const Params& P = *X.p; unsigned char* ws = X.ws; unsigned char* wl = ws + WS_W + (size_t)l * LW;
    float* dbg = (float*)(ws + 768 * 1024);
    const bf16_t* h = (const bf16_t*)(ws + WS_H); const bf16_t* z = (const bf16_t*)(ws + WS_Z); const bf16_t* WinT = (const bf16_t*)(wl + W_IN);
    const bf16_t* abt = (const bf16_t*)(ws + WS_ABT); const bf16_t* T = (const bf16_t*)(ws + WS_DFT); const bf16_t* Pp = (const bf16_t*)(ws + WS_P);
    const bf16_t* U = (const bf16_t*)(ws + WS_U); const bf16_t* mb = (const bf16_t*)(ws + WS_M); const bf16_t* ob = (const bf16_t*)(ws + WS_OB);
    const bf16_t* WupT = (const bf16_t*)(wl + W_UP); const bf16_t* WgT = (const bf16_t*)(wl + W_G); const bf16_t* WoT = (const bf16_t*)(wl + W_OUT);
    const int i = X.c * NTHREADS + X.tid; if (i >= 32768) return;
    const unsigned hsh = (unsigned)i * 2654435761u; const int row = (hsh >> 7) % MC; const int cc = (hsh >> 3) & 1023;
    const bf16_t* hr = h + (size_t)row * DM;
    { const int col = cc % 672; dbg_max(dbg + 1, bf2f(z[(size_t)row * NZ + col]) - dotbf(hr, WinT + (size_t)col * DM, DM)); }
    { const int col = cc & 255, wr0 = 768 + (col >> 7) * 256 + (col & 127); const float a = dotbf(hr, WinT + (size_t)wr0 * DM, DM), b = dotbf(hr, WinT + (size_t)(wr0 + 128) * DM, DM);
      dbg_max(dbg + 2, bf2f(z[(size_t)row * NZ + ZC_GLU + col]) - a / (1.f + expf(-b))); }
    { const int ch = cc & 255, b = row >> 12, s = row & 4095, j = (s & 1) + 2 * (s >> 10), kidx = (s >> 1) & 511; const bf16_t* ap = abt + ((size_t)(b * 8 + j) * 256 + ch) * 1024;
      dbg_max(dbg + 3, bf2f(ap[kidx]) - dotbf(hr, WinT + (size_t)(1280 + ch) * DM, DM)); dbg_max(dbg + 3, bf2f(ap[512 + kidx]) - dotbf(hr, WinT + (size_t)(1536 + ch) * DM, DM)); }
    { const int ch = cc & 255, bj = (row >> 11) & 31, ks = row & 2047; dbg_max(dbg + 4, bf2f(Pp[((size_t)bj * 2048 + ks) * 256 + ch]) - dotbf(T + ((size_t)(bj & 7) * 2048 + ks) * 1024, abt + ((size_t)bj * 256 + ch) * 1024, 1024)); }
    { const int br = (hsh >> 1) & 3, koff = br == 0 ? 0 : (br == 1 ? 256 : (br == 2 ? 768 : 1024)), K = br == 1 ? 512 : 256;
      dbg_max(dbg + 5, bf2f(U[(size_t)row * 4096 + br * 1024 + cc]) - dotbf(z + (size_t)row * NZ + ZC_G + koff, WupT + (size_t)cc * 1280 + koff, K)); }
    { float acc = 0.f; for (int b = 0; b < 4; ++b) { const float g = dotbf(hr, WgT + (size_t)(b * 1024 + cc) * DM, DM) + P.in[5 + X.zero][(size_t)l * 4096 + b * 1024 + cc];
          acc += bf2f(U[(size_t)row * 4096 + b * 1024 + cc]) / (1.f + expf(-g)); }
      dbg_max(dbg + 6, bf2f(mb[(size_t)row * 1024 + cc]) - acc); }
    { dbg_max(dbg + 7, bf2f(ob[(size_t)row * 1024 + cc]) - dotbf(mb + (size_t)row * 1024, WoT + (size_t)cc * DM, DM)); }
    { const int col = cc & 255, g = col >> 6, hw = 1 << g, s = row & 4095, tb = row - s, lo = max(s - hw, 0), hi = min(s + hw, SEQ); float a = 0.f;
      for (int r = lo; r < hi; ++r) a += bf2f(z[(size_t)(tb + r) * NZ + col]);
      const float gg = dotbf(hr, WinT + (size_t)(1792 + col) * DM, DM), sg = gg / (1.f + expf(-gg));
      dbg_max(dbg + 8, bf2f(z[(size_t)row * NZ + ZC_G + col]) - (a / (float)(hi - lo) - bf2f(z[(size_t)row * NZ + col])) * sg); }
    { const bf16_t* cbp = (const bf16_t*)(ws + WS_CB); const int col = cc & 255, s = row & 4095, tb = row - s; float sum = 0.f, sq = 0.f, mine = 0.f;
      for (int ch = 0; ch < 256; ++ch) { float a = P.in[13 + X.zero][(size_t)l * 256 + ch];
          for (int k = 0; k < 31; ++k) { const int ss = s + k - 15; if (ss >= 0 && ss < SEQ) a = fmaf(bf2f(z[(size_t)(tb + ss) * NZ + ZC_GLU + ch]), P.in[12 + X.zero][((size_t)l * 31 + k) * 256 + ch], a); }
          sum += a; sq += a * a; if (ch == col) mine = a; }
      const float mu = sum / 256.f, var = sq / 256.f - mu * mu; float y = (mine - mu) / sqrtf(var + LN_EPS) * P.in[14 + X.zero][(size_t)l * 256 + col] + P.in[15 + X.zero][(size_t)l * 256 + col]; y = y / (1.f + expf(-y));
      dbg_max(dbg + 9, bf2f(cbp[(size_t)row * 256 + col]) - y);
      const float gg = dotbf(hr, WinT + (size_t)(2560 + col) * DM, DM), sg = gg / (1.f + expf(-gg));
      dbg_max(dbg + 10, bf2f(z[(size_t)row * NZ + ZC_GCONV + col]) - (dotbf(cbp + (size_t)row * 256, (const bf16_t*)(wl + W_PW) + (size_t)col * 256, 256) + P.in[17 + X.zero][(size_t)l * 256 + col]) * sg); }
    { const int col = cc & 255, b = row >> 12, s = row & 4095, ks = s & 2047; float f = 0.f;
      for (int j = 0; j < 8; ++j) { const float pv = bf2f(Pp[((size_t)(b * 8 + j) * 2048 + ks) * 256 + col]); f += ((j & 1) && s >= 2048) ? -pv : pv; }
      const float gg = dotbf(hr, WinT + (size_t)(2816 + col) * DM, DM), sg = gg / (1.f + expf(-gg));
      dbg_max(dbg + 11, bf2f(z[(size_t)row * NZ + ZC_GFOUR + col]) - f * sg); }
    { const float* xr = P.in[0 + X.zero] + (size_t)row * DM; float ss = 0.f; for (int k = 0; k < DM; ++k) ss = fmaf(xr[k], xr[k], ss);
      dbg_max(dbg + 12, bf2f(hr[cc]) - xr[cc] / sqrtf(ss / DM + NORM_EPS) * P.in[2 + X.zero][(size_t)l * DM + cc]); }
}
DI void dbg_report(const Ctx& X) {
    const float* dbg = (const float*)(X.ws + 768 * 1024);
    if (X.c == 0 && X.tid == 0) { float add = 0.f;
        if (dbg[1] > 0.03f) add = 1e2f; if (dbg[2] > 0.03f) add = 1e3f; if (dbg[3] > 0.03f) add = 1e4f; if (dbg[4] > 0.03f) add = 1e5f;
        if (dbg[5] > 0.03f) add = 1e6f; if (dbg[6] > 0.03f) add = 1e7f; if (dbg[7] > 0.03f) add = 1e8f; if (dbg[8] > 0.03f) add = 1e9f; if (dbg[9] > 0.03f) add = 1e10f; if (dbg[10] > 0.03f) add = 1e11f; if (dbg[11] > 0.03f) add = 1e12f; if (dbg[12] > 0.03f) add = 1e13f;
        X.p->out[0] += add; }
}

#define XB_TMO      128
#define XB_XCNT(j)  (256  + 64 * (j))
#define XB_XSUB(j)  (1280 + 64 * (j))
#define XB_XGEN(j)  (2304 + 64 * (j))
#define XB_TOP      3328
#define XB_TOPGEN   3392
#define XCD_BAR_WORDS 3456
#define XB_SPIN_CAP (1u << 22)
constexpr size_t WS_BAR = 800 * 1024;
constexpr int LDS_MISC = 131072 + 1024;
DI unsigned xb_ld(unsigned* p)              { return __hip_atomic_load(p, __ATOMIC_RELAXED, __HIP_MEMORY_SCOPE_AGENT); }
DI unsigned xb_add(unsigned* p, unsigned v) { return __hip_atomic_fetch_add(p, v, __ATOMIC_RELAXED, __HIP_MEMORY_SCOPE_AGENT); }
DI unsigned xb_xcc_id() { return (unsigned)__builtin_amdgcn_s_getreg((3 << 11) | 20) & 0xFu; }
#define XB_SPIN(cond, bar) do { unsigned _sp = 0; while (cond) { __builtin_amdgcn_s_sleep(1); \
    if ((++_sp & 255u) == 0u) { if (xb_ld(&(bar)[XB_TMO])) break; if (_sp > XB_SPIN_CAP) { atomicAdd(&(bar)[XB_TMO], 1u); break; } } } } while (0)
struct XcdBarrier { unsigned* bar; unsigned x; volatile LAS unsigned* st; };
DI void xcd_barrier_complete(unsigned* bar, unsigned x, unsigned& nloc, unsigned& nx) {
    const unsigned G = gridDim.x * gridDim.y * gridDim.z;
    unsigned sum, cnt, mine, sp = 0u;
    for (;;) {
        sum = 0u; cnt = 0u; mine = 0u;
#pragma unroll
        for (unsigned j = 0; j < 16; ++j) { const unsigned c = xb_ld(&bar[XB_XCNT(j)]); sum += c; cnt += (c > 0u) ? 1u : 0u; mine = (j == x) ? c : mine; }
        if (sum == G) break;
        __builtin_amdgcn_s_sleep(1);
        if ((++sp & 255u) == 0u) { if (xb_ld(&bar[XB_TMO])) break; if (sp > XB_SPIN_CAP) { atomicAdd(&bar[XB_TMO], 1u); break; } }
    }
    nloc = mine > 0u ? mine : 1u; nx = cnt > 0u ? cnt : 1u;
}
DI void xcd_barrier(const XcdBarrier& b, const int tid) {
    asm volatile("s_waitcnt vmcnt(0)" ::: "memory");
    __syncthreads();
    if (tid == 0) {
        unsigned* bar = b.bar;
        __builtin_amdgcn_s_waitcnt(0);
        unsigned nloc = b.st[0], nx = b.st[1];
        if (nloc == 0u) { xcd_barrier_complete(bar, b.x, nloc, nx); b.st[0] = nloc; b.st[1] = nx; }
        const unsigned old = xb_add(&bar[XB_XSUB(b.x)], 1u);
        const unsigned gen = old / nloc;
        if (old + 1u == (gen + 1u) * nloc) {
            __builtin_amdgcn_fence(__ATOMIC_RELEASE, "agent");
            asm volatile("s_waitcnt vmcnt(0)" ::: "memory");
            const unsigned og = xb_add(&bar[XB_TOP], 1u);
            const unsigned tg = og / nx;
            if (og + 1u == (tg + 1u) * nx) xb_add(&bar[XB_TOPGEN], 1u);
            else XB_SPIN(xb_ld(&bar[XB_TOPGEN]) == tg, bar);
            __builtin_amdgcn_fence(__ATOMIC_ACQUIRE, "agent");
            xb_add(&bar[XB_XGEN(b.x)], 1u);
            asm volatile("s_waitcnt vmcnt(0)" ::: "memory");
        } else {
            XB_SPIN(xb_ld(&bar[XB_XGEN(b.x)]) == gen, bar);
            __builtin_amdgcn_fence(__ATOMIC_ACQUIRE, "agent");
            asm volatile("s_waitcnt vmcnt(0)" ::: "memory");
        }
    }
    __syncthreads();
}


#define GB_SUB(g)  (8192 + 16 * (g))
#define GB_GEN(g)  (9216 + 16 * (g))
#define GB_OK      6144
#define GB_MAP     6400
DI void grp_barrier(unsigned* bar, const int g, const unsigned nloc, const int tid) {
    asm volatile("s_waitcnt vmcnt(0)" ::: "memory");
    __syncthreads();
    if (tid == 0) {
        __builtin_amdgcn_s_waitcnt(0);
        const unsigned old = xb_add(&bar[GB_SUB(g)], 1u); const unsigned gen = old / nloc;
        if (old + 1u == (gen + 1u) * nloc) xb_add(&bar[GB_GEN(g)], 1u);
        else XB_SPIN(xb_ld(&bar[GB_GEN(g)]) == gen, bar);
        __builtin_amdgcn_fence(__ATOMIC_ACQUIRE, "agent");
        asm volatile("s_waitcnt vmcnt(0)" ::: "memory");
    }
    __syncthreads();
}

constexpr int NPH = 7;
constexpr int NSTEPS = 2 + NCHUNK * NLAYER * NPH + 1;

DI void run_step(const Ctx& X, int step, const int dummy, const XcdBarrier* xb) {
    const Params& P = *X.p; unsigned char* ws = X.ws; LAS unsigned char* ldsl = (LAS unsigned char*)X.lds;
    if (step == 0) { prep1(X); return; }
    if (step == 1) { prep2(X); return; }
    if (step == NSTEPS - 1) { norm_pass(X, NCHUNK - 1, 2); return; }
    const int s2 = step - 2, ph = s2 % NPH, cl = s2 / NPH, l = cl % NLAYER, ch = cl / NLAYER;
    unsigned char* wl = ws + WS_W + (size_t)l * LW;
    switch (ph) {
    case 0: { if (l == 0 && ch > 0) norm_pass(X, ch - 1, 2); norm_pass(X, ch, l); } break;
    case 1: { SchedSimple S{(const char*)(ws + WS_H), (const char*)(wl + W_IN), DM, DM, 16, 12, X.G, X.c, 0};
              EpiIn E{(bf16_t*)(ws + WS_Z), (bf16_t*)(ws + WS_ABT)};
              pg8::gemm_phase(ldsl, X.tid, DM, DM, S, E); } break;
    case 2: {
        s_pass(X, l);
        { SchedDft S{(const char*)(ws + WS_DFT), (const char*)(ws + WS_ABT), X.G, X.c}; EpiDft E{(bf16_t*)(ws + WS_P)};
          pg8::gemm_phase(ldsl, X.tid, 1024, 1024, S, E); }
        for (int it = X.c; it < MC / 64; it += X.G) conv_item(X, it, l);
        pool_pass(X, dummy ? (bf16_t*)(ws + WS_U) : (bf16_t*)(ws + WS_Z));
    } break;
    case 3: { { SchedQKV S{(const char*)(ws + WS_CQN), (const char*)(ws + WS_CKVN), (const char*)(wl + W_UQ), (const char*)(wl + W_UKV), X.G, X.c};
                EpiQKV E{(bf16_t*)(ws + WS_Q), (bf16_t*)(ws + WS_KN), (bf16_t*)(ws + WS_V)};
                pg8::gemm_phase(ldsl, X.tid, 256, 256, S, E); }
              { SchedSimple S{(const char*)(ws + WS_CB), (const char*)(wl + W_PW), 256, 256, 4, 1, X.G, X.c, (X.G >> 3) >= 32 ? 24 : 0};
                EpiPw E{(bf16_t*)(ws + WS_Z), P.in[17 + X.zero] + (size_t)l * 256};
                pg8::gemm_phase(ldsl, X.tid, 256, 256, S, E); }
              dft_combine(X); } break;
    case 4: {
        const bf16_t* q = (const bf16_t*)(ws + WS_Q); const bf16_t* kn = (const bf16_t*)(ws + WS_KN); const bf16_t* kr = (const bf16_t*)(ws + WS_KROPE); const bf16_t* v = (const bf16_t*)(ws + WS_V);
        bf16_t* z = (bf16_t*)(ws + WS_Z); bf16_t* zo = dummy ? (bf16_t*)(ws + WS_U) : z; const float* rc = (const float*)(ws + WS_ROPE); const float* rs = rc + 4096 * 16;
        for (int i = 0;; ++i) { int pair, qb;
            if (X.G == 256) { if (i >= 2) break; const int pm = 8 * (X.c & 7) + ((X.c >> 3) & 7), pc = X.c >> 6; pair = (pm >> 4) * 8 + 2 * pc + i; qb = pm & 15; }
            else if ((X.G & 7) == 0) { const int per = X.G >> 3, x = X.c & 7, idx = X.c >> 3, qq = i * per + idx; if (qq >= 64) break; pair = 4 * x + (qq >> 4); qb = qq & 15; }
            else { const int L = i * X.G + X.c; if (L >= 512) break; pair = L >> 4; qb = L & 15; }
            const int b = pair >> 3, h = pair & 7;
            att::attn_unit(q + ((size_t)pair * 4096 + qb * 256) * 96, kn + (size_t)pair * 4096 * 64, kr + (size_t)b * 4096 * 32, v + (size_t)pair * 4096 * 64,
                           z + ((size_t)(b * 4096 + qb * 256)) * NZ + ZC_GATTN + h * 64, zo + ((size_t)(b * 4096 + qb * 256)) * NZ + ZC_GATTN + h * 64, rc, rs, qb * 256, X.lds, X.tid); }
    } break;
    case 5: { { SchedUp S{(const char*)(ws + WS_Z), (const char*)(wl + W_UP), X.G, X.c}; EpiPlain E{(bf16_t*)(ws + WS_U), 4096, 0};
                pg8::gemm_phase(ldsl, X.tid, NZ, 1280, S, E); }
              if (X.G != 256) xcd_barrier(*xb, X.tid);
              { SchedGate S{(const char*)(ws + WS_H), (const char*)(wl + W_G), X.G, X.c};
                EpiGate E{(const bf16_t*)(ws + WS_U), (bf16_t*)(ws + WS_M), P.in[5 + X.zero] + (size_t)l * 4096};
                pg8::gemm_phase(ldsl, X.tid, DM, DM, S, E); } } break;
    case 6: { SchedSimple S{(const char*)(ws + WS_M), (const char*)(wl + W_OUT), DM, DM, 16, 4, X.G, X.c, 0}; EpiPlain E{(bf16_t*)(ws + WS_OB), DM, 0};
              pg8::gemm_phase(ldsl, X.tid, DM, DM, S, E); } break;
    }
}


__global__ void __launch_bounds__(NTHREADS, 2) mk_fwd(Params prm) {
    extern __shared__ __attribute__((aligned(16))) unsigned char lds[];
    const int wave_s = __builtin_amdgcn_readfirstlane(threadIdx.x >> 6);
    volatile LAS unsigned* bst = (volatile LAS unsigned*)((LAS unsigned char*)lds + LDS_MISC);
    if (threadIdx.x == 0) { bst[0] = 0u; bst[1] = 0u; }
    __syncthreads();
    XcdBarrier xbar; xbar.bar = (unsigned*)(prm.ws + WS_BAR); xbar.x = xb_xcc_id(); xbar.st = bst;
    if (threadIdx.x == 0) { (void)xb_add(&xbar.bar[XB_XCNT(xbar.x)], 1u); __hip_atomic_store(&xbar.bar[GB_MAP + blockIdx.x], xbar.x + 1u, __ATOMIC_RELAXED, __HIP_MEMORY_SCOPE_AGENT); }
    int use_local = 0;
    int rep = 0;
    for (int step = prm.step_lo; step < prm.step_hi;) {
        int wv_ = wave_s, cb_ = blockIdx.x, gd_ = gridDim.x, zero_ = 0;
        asm volatile("" : "+s"(wv_), "+s"(cb_), "+s"(gd_), "+s"(zero_));
        int lane_; asm volatile("v_mbcnt_lo_u32_b32 %0, -1, 0\n\tv_mbcnt_hi_u32_b32 %0, -1, %0" : "=v"(lane_));
        int tidv = wv_ * 64 + lane_;
        Ctx X; X.p = &prm; X.ws = prm.ws + (size_t)(unsigned)zero_; X.lds = (char*)lds; X.G = gd_; X.c = cb_; X.tid = tidv; X.zero = zero_;
        X.wave = __builtin_amdgcn_readfirstlane(tidv >> 6);
        const bool want2 = (DBL_PREP && step < 2) || (DBL_MASK != 0 && step >= 2 && step < NSTEPS - 1 && ((DBL_MASK >> ((step - 2) % NPH)) & 1));
        const int dummy = (want2 && rep == 0) ? 1 : 0;
        run_step(X, step, dummy, &xbar);
        if (dummy) rep = 1; else { rep = 0; ++step; }
        if (step < prm.step_hi) {
            if (step == 1) { cg::this_grid().sync();
                if (tidv == 0) { unsigned ok = (gd_ == 256) ? 1u : 0u; for (int k = 0; k < 32 && ok; ++k) ok = (xb_ld(&xbar.bar[GB_MAP + (cb_ & 7) + 8 * k]) == xbar.x + 1u) ? 1u : 0u; (void)xb_add(&xbar.bar[GB_OK], ok); } }
            else if (step == 2) { xcd_barrier(xbar, tidv); use_local = __builtin_amdgcn_readfirstlane((int)(xb_ld(&xbar.bar[GB_OK]) == (unsigned)gd_)); }
            else { const int phd = (step - 3) % NPH;
                if (use_local && step >= 3 && (phd == 4 || phd == 5 || phd == 6 || phd == 0)) grp_barrier(xbar.bar, (cb_ & 7) * 8 + ((cb_ >> 3) & 7), 4u, tidv); else xcd_barrier(xbar, tidv); }
        }
    }
}

__global__ void __launch_bounds__(NTHREADS) dbg_kernel(Params prm, int mode) {
    Ctx X; X.p = &prm; X.ws = prm.ws; X.lds = nullptr; X.G = gridDim.x; X.c = blockIdx.x; X.tid = threadIdx.x; X.wave = threadIdx.x >> 6; X.zero = 0;
    if (mode == 0) dbg_check(X, 0); else dbg_report(X);
}

extern "C" void kernel_launch(void* const* d_in, const int* in_sizes, int n_in, void* d_out, int out_size, void* d_ws, size_t ws_size, hipStream_t stream) {
    static int grid = 0;
    if (grid == 0) {
        if (n_in != 24 || ws_size < WS_END) { fprintf(stderr, "kernel_launch: unexpected n_in %d / ws %zu\n", n_in, ws_size); grid = -1; return; }
        int dev = 0, cus = 0, per_cu = 0;
        hipGetDevice(&dev); hipDeviceGetAttribute(&cus, hipDeviceAttributeMultiprocessorCount, dev);
        if (hipFuncSetAttribute((const void*)mk_fwd, hipFuncAttributeMaxDynamicSharedMemorySize, LDS_BYTES) != hipSuccess) { fprintf(stderr, "kernel_launch: hipFuncSetAttribute failed\n"); grid = -1; return; }
        if (hipOccupancyMaxActiveBlocksPerMultiprocessor(&per_cu, (const void*)mk_fwd, NTHREADS, LDS_BYTES) != hipSuccess || per_cu < 1) { fprintf(stderr, "kernel_launch: occupancy query says %d\n", per_cu); per_cu = 1; }
        (void)hipGetLastError();
        grid = cus;
    }
    if (grid < 0) return;
    Params p{};
    for (int i = 0; i < 24; ++i) p.in[i] = (const float*)d_in[i];
    p.out = (float*)d_out; p.ws = (unsigned char*)d_ws;
    for (int i = 0; i < 16; ++i) p.inv_freq[i] = 1.0f / powf(10000.0f, (float)(2 * i) / 32.0f);
#if MULTI_LAUNCH
    for (int s = 0; s < NSTEPS; ++s) {
#if DBG_ON
        if (s == 2 + (DBG_CH * 2 + 1) * NPH) hipLaunchKernelGGL(dbg_kernel, dim3(64), dim3(NTHREADS), 0, stream, p, 0);
#endif

        p.step_lo = s; p.step_hi = s + 1; hipLaunchKernelGGL(mk_fwd, dim3(grid), dim3(NTHREADS), LDS_BYTES, stream, p); }
#if DBG_ON
    hipLaunchKernelGGL(dbg_kernel, dim3(1), dim3(NTHREADS), 0, stream, p, 1);
#endif
#else
    p.step_lo = 0; p.step_hi = NSTEPS;
    (void)hipMemsetAsync((char*)d_ws + WS_BAR, 0, 65536, stream);
    void* args[] = {&p};
    hipError_t e = hipLaunchCooperativeKernel((const void*)mk_fwd, dim3(grid), dim3(NTHREADS), args, LDS_BYTES, stream);
    if (e != hipSuccess) fprintf(stderr, "cooperative launch failed: %s (grid %d)\n", hipGetErrorString(e), grid);
#endif
}
```

```cpp
#include <hip/hip_runtime.h>
#include <hip/hip_cooperative_groups.h>
#include <cstdio>
#include <cstdint>
namespace cg = cooperative_groups;

#ifndef PH4_ATT
#define PH4_ATT 1
#endif
#ifndef PH4_DFT
#define PH4_DFT 1
#endif
#ifndef PH4_CONV
#define PH4_CONV 1
#endif
#ifndef PH4_POOL
#define PH4_POOL 1
#endif
#ifndef DBL_PREP
#define DBL_PREP 0
#endif
#ifndef DBL_MASK
#define DBL_MASK 0
#endif
#ifndef DBG_ON
#define DBG_ON 0
#endif
#ifndef DBG_CH
#define DBG_CH 0
#endif
#ifndef MULTI_LAUNCH
#define MULTI_LAUNCH 0
#endif

#define DI __device__ __forceinline__
#define LAS __attribute__((address_space(3)))
typedef unsigned short bf16_t;
typedef short bf16x8 __attribute__((ext_vector_type(8)));
typedef short s16x4 __attribute__((ext_vector_type(4)));
typedef float f32x4 __attribute__((ext_vector_type(4)));
typedef float f32x2 __attribute__((ext_vector_type(2)));
typedef float f32x16 __attribute__((ext_vector_type(16)));
typedef unsigned u32x4 __attribute__((ext_vector_type(4)));
typedef unsigned u32x2 __attribute__((ext_vector_type(2)));

constexpr int DM = 1024, SEQ = 4096, NLAYER = 2, NIN = 6816;
constexpr int MC = 16384, NCHUNK = 5, CSEQ = 4;
constexpr int NZ = 3072;
constexpr int ZC_GLU = 768, ZC_G = 1792, ZC_GATTN = 2048, ZC_GCONV = 2560, ZC_GFOUR = 2816;
constexpr float NORM_EPS = 1e-6f, LN_EPS = 1e-5f;
constexpr float ATT_SCALE = 0.10206207261596575f;
constexpr int LDS_BYTES = 147456;
constexpr int NTHREADS = 512, NWAVES = 8;

constexpr size_t MiB = 1u << 20;
constexpr size_t WS_ROPE = 0;
constexpr size_t WS_MAB = 1 * MiB;
constexpr size_t WS_W = 2 * MiB, LW = 20 * MiB;
constexpr size_t W_IN = 0, W_G = 6 * MiB, W_UQ = 14 * MiB, W_UKV = 14 * MiB + 512 * 1024, W_UP = 15 * MiB, W_OUT = 17 * MiB + 512 * 1024, W_PW = 19 * MiB + 512 * 1024;
constexpr size_t WS_DFT = 42 * MiB;
constexpr size_t WS_H = 74 * MiB, WS_Z = 106 * MiB, WS_CQN = 202 * MiB, WS_CKVN = 210 * MiB, WS_KROPE = 218 * MiB;
constexpr size_t WS_Q = 219 * MiB, WS_KN = 243 * MiB, WS_V = 259 * MiB, WS_ABT = 275 * MiB, WS_P = 291 * MiB, WS_CB = 323 * MiB;
constexpr size_t WS_U = 331 * MiB, WS_M = 459 * MiB, WS_OB = 491 * MiB, WS_END = 523 * MiB;

struct Params {
    const float* in[24];
    float* out;
    unsigned char* ws;
    float inv_freq[16];
    int step_lo, step_hi;
};

DI unsigned cvt_pk(float lo, float hi) { unsigned r; asm volatile("v_cvt_pk_bf16_f32 %0, %1, %2" : "=v"(r) : "v"(lo), "v"(hi)); return r; }
DI bf16_t f2bf(float f) { unsigned u = __builtin_bit_cast(unsigned, f); return (bf16_t)((u + 0x7fffu + ((u >> 16) & 1u)) >> 16); }
DI float bf2f(bf16_t b) { return __builtin_bit_cast(float, (unsigned)b << 16); }
DI float bflo(unsigned w) { return __builtin_bit_cast(float, w << 16); }
DI float bfhi(unsigned w) { return __builtin_bit_cast(float, w & 0xffff0000u); }
DI float sigmoidf_(float x) { return __builtin_amdgcn_rcpf(1.f + __builtin_amdgcn_exp2f(-1.4426950408889634f * x)); }
DI float siluf_(float x) { return x * sigmoidf_(x); }
DI float wave_sum(float v, int lane) {
#pragma unroll
    for (int o = 1; o < 64; o <<= 1) v += __builtin_bit_cast(float, __builtin_amdgcn_ds_bpermute((lane ^ o) << 2, __builtin_bit_cast(int, v)));
    return v;
}
DI void store8(bf16_t* p, f32x4 v0, f32x4 v1) { u32x4 w; w.x = cvt_pk(v0[0], v0[1]); w.y = cvt_pk(v0[2], v0[3]); w.z = cvt_pk(v1[0], v1[1]); w.w = cvt_pk(v1[2], v1[3]); *(u32x4*)p = w; }
DI void load8(const bf16_t* p, f32x4& v0, f32x4& v1) { u32x4 w = *(const u32x4*)p; v0 = (f32x4){bflo(w.x), bfhi(w.x), bflo(w.y), bfhi(w.y)}; v1 = (f32x4){bflo(w.z), bfhi(w.z), bflo(w.w), bfhi(w.w)}; }

namespace pg8 {
constexpr int BM = 256, BK = 64, HALF = 128, HTB = HALF * BK * 2, STAGE_BYTES = 8 * HTB;
DI int lds_byte(int r, int c) { const int st = (r >> 4) * 2 + (c >> 5), rr = r & 15, cc = c & 31, ob = rr * 64 + cc * 2; return st * 1024 + (ob ^ (((ob >> 9) & 1) << 5)); }
DI void stage_rc(int b, int& R, int& C) { const int st = b / 1024, sb = b % 1024, swz = sb ^ (((sb >> 9) & 1) << 5); R = (st >> 1) * 16 + swz / 64; C = (st & 1) * 32 + (swz % 64) / 2; }
DI int perm32(int rho) { const int n = rho >> 4, i = rho & 15; return 8 * (i >> 2) + 4 * n + (i & 3); }

struct Unit { const char* A; const char* B; int nt; int pm; int pn; int tag; };

template <class Epi, class Sched>
DI void gemm_phase(LAS unsigned char* lds, const int tid, const int lda, const int ldb, const Sched& S, const Epi& E) {
    const int  wid = __builtin_amdgcn_readfirstlane(tid >> 6), lane = tid & 63, wr = wid >> 2, wc = wid & 3, fr = lane & 15, fq = lane >> 4;
    unsigned voffA[2], voffB[2];
#pragma unroll
    for (int i = 0; i < 2; ++i) { int R, C; stage_rc(tid * 16 + i * 8192, R, C); const int Rb = (R & ~31) + perm32(R & 31);
        voffA[i] = (unsigned)(R * lda + C) * 2u; voffB[i] = (unsigned)(Rb * ldb + C) * 2u; }
    const int kstep = BK * 2;
    const int hstepA = HALF * lda * 2, hstepB = HALF * ldb * 2;
    const unsigned ldsw = (unsigned)wid * 1024u;
    const int aoff = lds_byte(wr * 64 + fr, fq * 8), boff = lds_byte(wc * 32 + fr, fq * 8);
#define PG8_SA(b, h) (((b) * 2 + (h)) * HTB)
#define PG8_SB(b, h) ((4 + (b) * 2 + (h)) * HTB)
#define PG8_STAGE(bufoff, gbase, voff, soff) do { const __amdgpu_buffer_rsrc_t _rs = __builtin_amdgcn_make_buffer_rsrc((void*)(gbase), (short)0, (int)0x7fffffff, (int)0x00020000); _Pragma("unroll") for (int _i = 0; _i < 2; ++_i) \
        __builtin_amdgcn_raw_ptr_buffer_load_lds(_rs, (LAS void*)(lds + (bufoff) + ldsw + _i * 8192), 16, (int)(voff)[_i], (int)(soff), 0, 0); } while (0)
#define PG8_LDA(dst, b, h) do { _Pragma("unroll") for (int m = 0; m < 4; ++m) _Pragma("unroll") for (int k = 0; k < 2; ++k) dst[m][k] = *(const LAS bf16x8*)(lds + PG8_SA(b, h) + aoff + m * 2048 + k * 1024); } while (0)
#define PG8_LDB(dst, b, h) do { _Pragma("unroll") for (int n = 0; n < 2; ++n) _Pragma("unroll") for (int k = 0; k < 2; ++k) dst[n][k] = *(const LAS bf16x8*)(lds + PG8_SB(b, h) + boff + n * 2048 + k * 1024); } while (0)
#define PG8_MMA(ai, bj, At, Bt) do { __builtin_amdgcn_s_setprio(1); _Pragma("unroll") for (int m = 0; m < 4; ++m) _Pragma("unroll") for (int n = 0; n < 2; ++n) _Pragma("unroll") for (int k = 0; k < 2; ++k) \
        acc[ai][bj][m][n] = __builtin_amdgcn_mfma_f32_16x16x32_bf16(Bt[n][k], At[m][k], acc[ai][bj][m][n], 0, 0, 0); __builtin_amdgcn_s_setprio(0); } while (0)
#define PG8_WAIT_V(n) asm volatile("s_waitcnt vmcnt(" #n ")" ::: "memory")
#define PG8_WAIT_L(n) asm volatile("s_waitcnt lgkmcnt(" #n ")" ::: "memory")
#define PG8_BAR __builtin_amdgcn_s_barrier()
#define PG8_SCHED __builtin_amdgcn_sched_barrier(0)
    Unit cur, nxt; int ui = 0;
    if (!S.next(0, cur)) return;
    f32x4 acc[2][2][4][2];
#pragma unroll
    for (int a = 0; a < 2; ++a)
#pragma unroll
        for (int b = 0; b < 2; ++b)
#pragma unroll
            for (int m = 0; m < 4; ++m)
#pragma unroll
                for (int n = 0; n < 2; ++n) acc[a][b][m][n] = (f32x4){0.f, 0.f, 0.f, 0.f};
    bf16x8 At[4][2], B0[2][2], B1[2][2];
    const char* cA = cur.A; const char* cB = cur.B;
    PG8_STAGE(PG8_SB(0, 0), cB, voffB, 0); PG8_STAGE(PG8_SB(0, 1), cB, voffB, hstepB); PG8_STAGE(PG8_SA(0, 0), cA, voffA, 0); PG8_STAGE(PG8_SA(0, 1), cA, voffA, hstepA);
    if (wr == 1) PG8_BAR;
    PG8_WAIT_V(2); PG8_BAR;
    PG8_STAGE(PG8_SB(1, 0), cB, voffB, kstep); PG8_STAGE(PG8_SA(1, 0), cA, voffA, kstep); PG8_STAGE(PG8_SB(1, 1), cB, voffB, hstepB + kstep);
    PG8_WAIT_V(6); PG8_BAR;
    for (;;) {
        const bool has_next = S.next(ui + 1, nxt);
        const char* nA = has_next ? nxt.A : cA; const char* nB = has_next ? nxt.B : cB;
        const int nt = cur.nt;
        for (int t = 0; t < nt; t += 2) {
            const bool last = (t == nt - 2);
            const int o1 = (t + 1) * kstep;
            const char* a2 = last ? nA : cA; const char* b2 = last ? nB : cB; const int o2 = last ? 0 : (t + 2) * kstep, o3 = o2 + kstep;
            PG8_LDB(B0, 0, 0); PG8_LDB(B1, 0, 1); PG8_SCHED; PG8_LDA(At, 0, 0); PG8_STAGE(PG8_SA(1, 1), cA, voffA, o1 + hstepA);
            PG8_WAIT_V(8); PG8_WAIT_L(0); PG8_BAR; PG8_MMA(0, 0, At, B0); PG8_MMA(0, 1, At, B1); PG8_BAR; PG8_SCHED;
            PG8_LDA(At, 0, 1); PG8_STAGE(PG8_SB(0, 0), b2, voffB, o2); PG8_STAGE(PG8_SB(0, 1), b2, voffB, o2 + hstepB); PG8_STAGE(PG8_SA(0, 0), a2, voffA, o2);
            PG8_WAIT_V(8); PG8_WAIT_L(0); PG8_BAR; PG8_MMA(1, 0, At, B0); PG8_MMA(1, 1, At, B1); PG8_BAR; PG8_SCHED;
            PG8_LDB(B0, 1, 0); PG8_LDB(B1, 1, 1); PG8_SCHED; PG8_LDA(At, 1, 0); PG8_STAGE(PG8_SA(0, 1), a2, voffA, o2 + hstepA);
            PG8_WAIT_V(8); PG8_WAIT_L(0); PG8_BAR; PG8_MMA(0, 0, At, B0); PG8_MMA(0, 1, At, B1); PG8_BAR; PG8_SCHED;
            PG8_LDA(At, 1, 1); PG8_STAGE(PG8_SB(1, 0), b2, voffB, o3); PG8_STAGE(PG8_SB(1, 1), b2, voffB, o3 + hstepB); PG8_STAGE(PG8_SA(1, 0), a2, voffA, o3);
            PG8_WAIT_V(8); PG8_WAIT_L(0); PG8_BAR; PG8_MMA(1, 0, At, B0); PG8_MMA(1, 1, At, B1); PG8_BAR; PG8_SCHED;
        }
        if (wr == 0) PG8_BAR;
        E(acc, cur, wr, wc, fr, fq);
        if (!has_next) break;
#pragma unroll
        for (int a = 0; a < 2; ++a)
#pragma unroll
            for (int b = 0; b < 2; ++b)
#pragma unroll
                for (int m = 0; m < 4; ++m)
#pragma unroll
                    for (int n = 0; n < 2; ++n) acc[a][b][m][n] = (f32x4){0.f, 0.f, 0.f, 0.f};
        cur = nxt; cA = nA; cB = nB; ++ui;
        if (wr == 1) PG8_BAR;
    }
    PG8_WAIT_V(0);
    PG8_BAR;
#undef PG8_SA
#undef PG8_SB
#undef PG8_STAGE
#undef PG8_LDA
#undef PG8_LDB
#undef PG8_MMA
#undef PG8_WAIT_V
#undef PG8_WAIT_L
#undef PG8_BAR
#undef PG8_SCHED
}
}
using pg8::Unit;
typedef f32x4 Acc[2][2][4][2];

DI bool tile_of(int i, int G, int c, int npn, int& pm, int& pn, int ioff = 0) {
    if ((G & 7) == 0) { const int per = G >> 3, x = c & 7, idx = c >> 3, q = i * per + idx - ioff; if (q < 0 || q >= 8 * npn) return false; pm = 8 * x + (q & 7); pn = q >> 3; return true; }
    const int L = i * G + c; if (L >= 64 * npn) return false; pm = L & 63; pn = L >> 6; return true;
}

struct SchedSimple {
    const char* A; const char* B; int lda, ldb, nt, npn, G, c, ioff;
    DI bool next(int i, Unit& u) const { int pm, pn; if (!tile_of(i, G, c, npn, pm, pn, ioff)) return false;
        u.A = A + (size_t)pm * 256 * lda * 2; u.B = B + (size_t)pn * 256 * ldb * 2; u.nt = nt; u.pm = pm; u.pn = pn; u.tag = 0; return true; }
};
struct SchedQKV {
    const char* Aq; const char* Akv; const char* Bq; const char* Bkv; int G, c;
    DI bool next(int i, Unit& u) const { int pm, pn; if (!tile_of(i, G, c, 7, pm, pn)) return false;
        const bool isq = pn < 3; u.A = (isq ? Aq : Akv) + (size_t)pm * 256 * 256 * 2; u.B = isq ? Bq + (size_t)pn * 256 * 256 * 2 : Bkv + (size_t)(pn - 3) * 256 * 256 * 2;
        u.nt = 4; u.pm = pm; u.pn = isq ? pn : pn - 3; u.tag = isq ? 0 : 1; return true; }
};
struct SchedUp {
    const char* Z; const char* W; int G, c;
    DI bool next(int i, Unit& u) const { const int L = i * G + c; if (L >= 1024) return false; const int br = L >> 8, r = L & 255;
        const int x = r & 7, idx = r >> 3, pm = 8 * x + (idx & 7), pn = idx >> 3;
        const int koff = br == 0 ? 0 : (br == 1 ? 256 : (br == 2 ? 768 : 1024));
        u.A = Z + ((size_t)pm * 256 * NZ + ZC_G + koff) * 2; u.B = W + ((size_t)pn * 256 * 1280 + koff) * 2; u.nt = br == 1 ? 8 : 4; u.pm = pm; u.pn = br * 4 + pn; u.tag = br; return true; }
};
struct SchedGate {
    const char* H; const char* W; int G, c;
    DI bool next(int i, Unit& u) const { const int P = (i >> 2) * G + c; if (P >= 256) return false; const int b = i & 3;
        const int x = P & 7, idx = P >> 3, pm = 8 * x + (idx & 7), pc = idx >> 3;
        u.A = H + (size_t)pm * 256 * 1024 * 2; u.B = W + (size_t)(b * 4 + pc) * 256 * 1024 * 2; u.nt = 16; u.pm = pm; u.pn = b * 4 + pc; u.tag = b; return true; }
};
struct SchedDft {
    const char* T; const char* AB; int G, c;
    DI bool next(int i, Unit& u) const { const int L = i * G + c; if (L >= 256) return false; const int j = L & 7, r = L >> 3, b = r >> 3, kt = r & 7;
        u.A = T + ((size_t)j * 2048 + kt * 256) * 1024 * 2; u.B = AB + (size_t)(b * 8 + j) * 256 * 1024 * 2; u.nt = 16; u.pm = kt; u.pn = 0; u.tag = b * 8 + j; return true; }
};

#define EPI_LOOP_ROWS for (int ai = 0; ai < 2; ++ai) for (int m = 0; m < 4; ++m)
struct EpiIn {
    bf16_t* z; bf16_t* abt;
    DI void operator()(const Acc& acc, const Unit& u, int wr, int wc, int fr, int fq) const {
        const int row0 = u.pm * 256 + wr * 64 + fr, pn = u.pn, cb = wc * 32 + 8 * fq;
        if (pn <= 2 || pn >= 7) {
#pragma unroll
            EPI_LOOP_ROWS { bf16_t* rp = z + (size_t)(row0 + ai * 128 + m * 16) * NZ + pn * 256 + cb;
#pragma unroll
                for (int bj = 0; bj < 2; ++bj) { f32x4 v0 = acc[ai][bj][m][0], v1 = acc[ai][bj][m][1];
                    if (pn >= 7) {
#pragma unroll
                        for (int e = 0; e < 4; ++e) { v0[e] = siluf_(v0[e]); v1[e] = siluf_(v1[e]); } }
                    store8(rp + bj * 128, v0, v1); } __builtin_amdgcn_sched_barrier(0); }
        } else if (pn <= 4) {
#pragma unroll
            EPI_LOOP_ROWS { bf16_t* rp = z + (size_t)(row0 + ai * 128 + m * 16) * NZ + ZC_GLU + (pn - 3) * 128 + cb;
                f32x4 v0, v1;
#pragma unroll
                for (int e = 0; e < 4; ++e) { v0[e] = acc[ai][0][m][0][e] * sigmoidf_(acc[ai][1][m][0][e]); v1[e] = acc[ai][0][m][1][e] * sigmoidf_(acc[ai][1][m][1][e]); }
                store8(rp, v0, v1); __builtin_amdgcn_sched_barrier(0); }
        } else {
            const int koff = pn == 6 ? 512 : 0;
#pragma unroll
            EPI_LOOP_ROWS { const int row = row0 + ai * 128 + m * 16, b = row >> 12, s = row & 4095;
                const int j = (s & 1) + 2 * (s >> 10), kidx = ((s >> 1) & 511) + koff;
                bf16_t* bp = abt + ((size_t)(b * 8 + j) * 256 + cb) * 1024 + kidx;
#pragma unroll
                for (int bj = 0; bj < 2; ++bj)
#pragma unroll
                    for (int n = 0; n < 2; ++n)
#pragma unroll
                        for (int e = 0; e < 4; ++e) bp[(size_t)(bj * 128 + n * 4 + e) * 1024] = f2bf(acc[ai][bj][m][n][e]); __builtin_amdgcn_sched_barrier(0); }
        }
    }
};
struct EpiQKV {
    bf16_t* q; bf16_t* kn; bf16_t* v;
    DI void operator()(const Acc& acc, const Unit& u, int wr, int wc, int fr, int fq) const {
        const int row0 = u.pm * 256 + wr * 64 + fr;
#pragma unroll
        for (int bj = 0; bj < 2; ++bj) { const int c0 = u.pn * 256 + bj * 128 + wc * 32 + 8 * fq; bf16_t* base; int rstride;
            if (u.tag == 0) { const int h = c0 / 96, d = c0 - 96 * h; base = q + (size_t)h * 4096 * 96 + d; rstride = 96; }
            else { const int h = c0 >> 7, w = c0 & 127; base = (w < 64 ? kn : v) + (size_t)h * 4096 * 64 + (w & 63); rstride = 64; }
#pragma unroll
            EPI_LOOP_ROWS { const int row = row0 + ai * 128 + m * 16; const int rr = row + (row >> 12) * 7 * 4096;
                store8(base + (size_t)rr * rstride, acc[ai][bj][m][0], acc[ai][bj][m][1]); __builtin_amdgcn_sched_barrier(0); } }
    }
};
struct EpiPlain {
    bf16_t* O; int ldc; int col0;
    DI void operator()(const Acc& acc, const Unit& u, int wr, int wc, int fr, int fq) const {
        const int row0 = u.pm * 256 + wr * 64 + fr;
#pragma unroll
        EPI_LOOP_ROWS { bf16_t* rp = O + (size_t)(row0 + ai * 128 + m * 16) * ldc + col0 + u.pn * 256 + wc * 32 + 8 * fq;
#pragma unroll
            for (int bj = 0; bj < 2; ++bj) store8(rp + bj * 128, acc[ai][bj][m][0], acc[ai][bj][m][1]); __builtin_amdgcn_sched_barrier(0); }
    }
};
struct EpiDft {
    bf16_t* P;
    DI void operator()(const Acc& acc, const Unit& u, int wr, int wc, int fr, int fq) const {
        const int row0 = u.pm * 256 + wr * 64 + fr;
#pragma unroll
        EPI_LOOP_ROWS { bf16_t* rp = P + ((size_t)u.tag * 2048 + row0 + ai * 128 + m * 16) * 256 + wc * 32 + 8 * fq;
#pragma unroll
            for (int bj = 0; bj < 2; ++bj) store8(rp + bj * 128, acc[ai][bj][m][0], acc[ai][bj][m][1]); __builtin_amdgcn_sched_barrier(0); }
    }
};
struct EpiPw {
    bf16_t* z; const float* pwb;
    DI void operator()(const Acc& acc, const Unit& u, int wr, int wc, int fr, int fq) const {
        const int row0 = u.pm * 256 + wr * 64 + fr;
#pragma unroll
        for (int bj = 0; bj < 2; ++bj) { const int c0 = bj * 128 + wc * 32 + 8 * fq; const f32x4 b0 = *(const f32x4*)(pwb + c0), b1 = *(const f32x4*)(pwb + c0 + 4);
            u32x4 gg[8];
#pragma unroll
            for (int r8 = 0; r8 < 8; ++r8) gg[r8] = *(const u32x4*)(z + (size_t)(row0 + (r8 >> 2) * 128 + (r8 & 3) * 16) * NZ + ZC_GCONV + c0);
            __builtin_amdgcn_sched_barrier(0);
#pragma unroll
            for (int r8 = 0; r8 < 8; ++r8) { const int ai = r8 >> 2, m = r8 & 3; const u32x4 w = gg[r8];
                const f32x4 g0 = {bflo(w.x), bfhi(w.x), bflo(w.y), bfhi(w.y)}, g1 = {bflo(w.z), bfhi(w.z), bflo(w.w), bfhi(w.w)};
                store8(z + (size_t)(row0 + ai * 128 + m * 16) * NZ + ZC_GCONV + c0, (acc[ai][bj][m][0] + b0) * g0, (acc[ai][bj][m][1] + b1) * g1); }
            __builtin_amdgcn_sched_barrier(0); }
    }
};
struct EpiGate {
    const bf16_t* U; bf16_t* mbuf; const float* gb;
    DI void operator()(const Acc& acc, const Unit& u, int wr, int wc, int fr, int fq) const {
        const int row0 = u.pm * 256 + wr * 64 + fr, br = u.tag;
        const int cgb = u.pn * 256 + wc * 32 + 8 * fq;
        u32x4 uA[2], pA[2], uB[2], pB[2];
#define GATE_LOAD(UU, PP, K) do { const int bj_ = (K) >> 2, ai_ = ((K) >> 1) & 1, mh_ = (K) & 1; const int cg_ = cgb + bj_ * 128; _Pragma("unroll") for (int mm = 0; mm < 2; ++mm) { const size_t row = row0 + ai_ * 128 + (2 * mh_ + mm) * 16; \
            UU[mm] = *(const u32x4*)(U + row * 4096 + cg_); if (br != 0) PP[mm] = *(const u32x4*)(mbuf + row * 1024 + (cg_ & 1023)); else PP[mm] = (u32x4){0u, 0u, 0u, 0u}; } } while (0)
#define GATE_DO(UU, PP, K) do { const int bj_ = (K) >> 2, ai_ = ((K) >> 1) & 1, mh_ = (K) & 1; const int cg_ = cgb + bj_ * 128; const f32x4 b0 = *(const f32x4*)(gb + cg_), b1 = *(const f32x4*)(gb + cg_ + 4); \
        _Pragma("unroll") for (int mm = 0; mm < 2; ++mm) { const int m = 2 * mh_ + mm; const size_t row = row0 + ai_ * 128 + m * 16; const u32x4 w = UU[mm], q = PP[mm]; \
            const f32x4 u0 = {bflo(w.x), bfhi(w.x), bflo(w.y), bfhi(w.y)}, u1 = {bflo(w.z), bfhi(w.z), bflo(w.w), bfhi(w.w)}; \
            const f32x4 p0 = {bflo(q.x), bfhi(q.x), bflo(q.y), bfhi(q.y)}, p1 = {bflo(q.z), bfhi(q.z), bflo(q.w), bfhi(q.w)}; \
            f32x4 v0 = acc[ai_][bj_][m][0] + b0, v1 = acc[ai_][bj_][m][1] + b1; \
            _Pragma("unroll") for (int e = 0; e < 4; ++e) { v0[e] = sigmoidf_(v0[e]) * u0[e] + p0[e]; v1[e] = sigmoidf_(v1[e]) * u1[e] + p1[e]; } \
            store8(mbuf + row * 1024 + (cg_ & 1023), v0, v1); } } while (0)
#define SB __builtin_amdgcn_sched_barrier(0)
        GATE_LOAD(uA, pA, 0); SB;
        GATE_LOAD(uB, pB, 1); SB; GATE_DO(uA, pA, 0); SB;
        GATE_LOAD(uA, pA, 2); SB; GATE_DO(uB, pB, 1); SB;
        GATE_LOAD(uB, pB, 3); SB; GATE_DO(uA, pA, 2); SB;
        GATE_LOAD(uA, pA, 4); SB; GATE_DO(uB, pB, 3); SB;
        GATE_LOAD(uB, pB, 5); SB; GATE_DO(uA, pA, 4); SB;
        GATE_LOAD(uA, pA, 6); SB; GATE_DO(uB, pB, 5); SB;
        GATE_LOAD(uB, pB, 7); SB; GATE_DO(uA, pA, 6); SB;
        GATE_DO(uB, pB, 7); SB;
#undef SB
#undef GATE_LOAD
#undef GATE_DO
    }
};

struct SchedQKVPW {
    const char* Aq; const char* Akv; const char* Apw; const char* Bq; const char* Bkv; const char* Bpw; int G, c;
    DI bool next(int i, Unit& u) const { int pm, pn; if (!tile_of(i, G, c, 8, pm, pn)) return false;
        const int t = pn < 3 ? 0 : (pn < 7 ? 1 : 2); const int lp = t == 0 ? pn : (t == 1 ? pn - 3 : 0);
        u.A = (t == 0 ? Aq : (t == 1 ? Akv : Apw)) + (size_t)pm * 256 * 256 * 2; u.B = (t == 0 ? Bq : (t == 1 ? Bkv : Bpw)) + (size_t)lp * 256 * 256 * 2;
        u.nt = 4; u.pm = pm; u.pn = lp; u.tag = t; return true; }
};
struct EpiQKVPW {
    EpiQKV a; EpiPw b;
    DI void operator()(const Acc& acc, const Unit& u, int wr, int wc, int fr, int fq) const { if (u.tag == 2) b(acc, u, wr, wc, fr, fq); else a(acc, u, wr, wc, fr, fq); }
};

namespace att {
constexpr int KROWB = 208, SHM_K = 64 * KROWB, SHM_V = 8192;
constexpr int NBUF = 3, OFF_V = 0, OFF_K = NBUF * SHM_V, OFF_WS = OFF_K + NBUF * SHM_K;
constexpr float THR = 8.f;
#define SBAR() __builtin_amdgcn_sched_barrier(0)
DI int crow(int r, int hi) { return (r & 3) + 8 * (r >> 2) + 4 * hi; }
template <bool FIRST> DI void partialSM(f32x16& p0, f32x16& p1, f32x16& negm, float& alpha) {
    constexpr float THR2 = THR * 1.4426950408889634f;
    float pmax = p0[0];
#pragma unroll
    for (int r = 1; r < 16; ++r) pmax = fmaxf(pmax, p0[r]);
#pragma unroll
    for (int r = 0; r < 16; ++r) pmax = fmaxf(pmax, p1[r]);
    { auto rr = __builtin_amdgcn_permlane32_swap(__float_as_uint(pmax), __float_as_uint(pmax), false, false);
      pmax = fmaxf(__uint_as_float(rr[0]), __uint_as_float(rr[1])); }
    if (!FIRST && __builtin_expect(__all(pmax <= THR2), 1)) { alpha = 1.f; }
    else { const float d = FIRST ? pmax : fmaxf(pmax, 0.f); alpha = FIRST ? 1.f : __builtin_amdgcn_exp2f(-d);
#pragma unroll
        for (int r = 0; r < 16; ++r) { p0[r] -= d; p1[r] -= d; negm[r] -= d; } }
#pragma unroll
    for (int r = 0; r < 16; ++r) p0[r] = __builtin_amdgcn_exp2f(p0[r]);
}
DI void finishSM(f32x16& p0, f32x16& p1, float alpha, float& l_reg, bf16x8& pa0, bf16x8& pa1, bf16x8& pa2, bf16x8& pa3) {
#pragma unroll
    for (int r = 0; r < 16; ++r) p1[r] = __builtin_amdgcn_exp2f(p1[r]);
    float ps = 0;
#pragma unroll
    for (int r = 0; r < 16; ++r) ps += p0[r];
#pragma unroll
    for (int r = 0; r < 16; ++r) ps += p1[r];
    { auto rr = __builtin_amdgcn_permlane32_swap(__float_as_uint(ps), __float_as_uint(ps), false, false);
      ps = __uint_as_float(rr[0]) + __uint_as_float(rr[1]); }
    l_reg = l_reg * alpha + ps;
#define PK4(P, BASE, OUT) do { u32x4 w = {cvt_pk(P[BASE + 0], P[BASE + 1]), cvt_pk(P[BASE + 2], P[BASE + 3]), cvt_pk(P[BASE + 4], P[BASE + 5]), cvt_pk(P[BASE + 6], P[BASE + 7])}; \
    OUT = __builtin_bit_cast(bf16x8, w); } while (0)
    PK4(p0, 0, pa0); PK4(p0, 8, pa1); PK4(p1, 0, pa2); PK4(p1, 8, pa3);
#undef PK4
}
DI void qkt(f32x16& p0, f32x16& p1, const char* Ks, const bf16x8* qr, int r32, int hi, const f32x16& negm) {
    const char* k0p = Ks + r32 * KROWB + hi * 16; const char* k1p = k0p + 32 * KROWB;
#pragma unroll
    for (int d0 = 0; d0 < 6; ++d0) {
        const bf16x8 b0 = *reinterpret_cast<const bf16x8*>(k0p + d0 * 32), b1 = *reinterpret_cast<const bf16x8*>(k1p + d0 * 32);
        if (d0 == 0) { p0 = __builtin_amdgcn_mfma_f32_32x32x16_bf16(b0, qr[0], negm, 0, 0, 0); p1 = __builtin_amdgcn_mfma_f32_32x32x16_bf16(b1, qr[0], negm, 0, 0, 0); }
        else { p0 = __builtin_amdgcn_mfma_f32_32x32x16_bf16(b0, qr[d0], p0, 0, 0, 0); p1 = __builtin_amdgcn_mfma_f32_32x32x16_bf16(b1, qr[d0], p1, 0, 0, 0); } }
}
DI int v_st(int k, int c) { const int kk = k; return ((kk >> 3) * 2 + (c >> 5)) * 512 + ((kk & 7) * 32 + (c & 31)) * 2; }
DI int v_rd_base(int lane) { return ((lane & 3) << 3) | (((lane >> 2) & 3) << 6) | (((lane >> 4) & 1) << 5) | (((lane >> 5) & 1) << 8); }
constexpr int v_rd_off(int d0, int ks, int half) { return d0 * 512 + ks * 2048 + half * 1024; }
typedef short v4i16_t __attribute__((ext_vector_type(4)));
template <int OFF> DI s16x4 tr_read(int vb) { return __builtin_bit_cast(s16x4, __builtin_amdgcn_ds_read_tr16_b64_v4i16((LAS v4i16_t*)(unsigned long long)(unsigned)(vb + OFF))); }
template <int D0> DI void pv_one(f32x16& od, int vb, bf16x8 pa0, bf16x8 pa1, bf16x8 pa2, bf16x8 pa3) {
    const s16x4 l0 = tr_read<v_rd_off(D0, 0, 0)>(vb), h0 = tr_read<v_rd_off(D0, 0, 1)>(vb), l1 = tr_read<v_rd_off(D0, 1, 0)>(vb), h1 = tr_read<v_rd_off(D0, 1, 1)>(vb);
    const s16x4 l2 = tr_read<v_rd_off(D0, 2, 0)>(vb), h2 = tr_read<v_rd_off(D0, 2, 1)>(vb), l3 = tr_read<v_rd_off(D0, 3, 0)>(vb), h3 = tr_read<v_rd_off(D0, 3, 1)>(vb);
#define PK(L, H) (bf16x8){L[0], L[1], L[2], L[3], H[0], H[1], H[2], H[3]}
    od = __builtin_amdgcn_mfma_f32_32x32x16_bf16(PK(l0, h0), pa0, od, 0, 0, 0);
    od = __builtin_amdgcn_mfma_f32_32x32x16_bf16(PK(l1, h1), pa1, od, 0, 0, 0);
    od = __builtin_amdgcn_mfma_f32_32x32x16_bf16(PK(l2, h2), pa2, od, 0, 0, 0);
    od = __builtin_amdgcn_mfma_f32_32x32x16_bf16(PK(l3, h3), pa3, od, 0, 0, 0);
#undef PK
}
DI void pv_d0(f32x16* o, int vb, bf16x8 pa0, bf16x8 pa1, bf16x8 pa2, bf16x8 pa3) { pv_one<0>(o[0], vb, pa0, pa1, pa2, pa3); pv_one<1>(o[1], vb, pa0, pa1, pa2, pa3); }

DI void attn_unit(const bf16_t* __restrict__ Qb, const bf16_t* __restrict__ Kn, const bf16_t* __restrict__ Kr, const bf16_t* __restrict__ Vh,
                  const bf16_t* Zg, bf16_t* Zo, const float* __restrict__ ropec, const float* __restrict__ ropes, int pos0, char* lds, const int tid) {
    const int wid = tid >> 6, lane = tid & 63, r32 = lane & 31, hi = lane >> 5;
    char* V_lds = lds + OFF_V; char* K_lds = lds + OFF_K;
    float* ws = (float*)(lds + OFF_WS) + wid * 64; float* li_l = ws; float* al_l = ws + 32;
    float l_reg = 0; f32x16 o[2], negm;
#pragma unroll
    for (int r = 0; r < 16; ++r) { o[0][r] = 0.f; o[1][r] = 0.f; negm[r] = 0.f; }
    bf16x8 qr[6];
    { const bf16_t* Qw = Qb + (size_t)(wid * 32 + r32) * 96 + hi * 8;
#pragma unroll
      for (int d0 = 0; d0 < 6; ++d0) qr[d0] = *reinterpret_cast<const bf16x8*>(Qw + d0 * 16);
      const int pos = pos0 + wid * 32 + r32;
      const f32x4 c0 = *(const f32x4*)(ropec + pos * 16 + hi * 8), c1 = *(const f32x4*)(ropec + pos * 16 + hi * 8 + 4);
      const f32x4 s0 = *(const f32x4*)(ropes + pos * 16 + hi * 8), s1 = *(const f32x4*)(ropes + pos * 16 + hi * 8 + 4);
      float x1[8], x2[8], cs[8], sn[8];
#pragma unroll
      for (int j = 0; j < 8; ++j) { x1[j] = bf2f((bf16_t)qr[4][j]); x2[j] = bf2f((bf16_t)qr[5][j]); cs[j] = j < 4 ? c0[j & 3] : c1[j & 3]; sn[j] = j < 4 ? s0[j & 3] : s1[j & 3]; }
      u32x4 w1, w2;
      w1.x = cvt_pk(x1[0] * cs[0] - x2[0] * sn[0], x1[1] * cs[1] - x2[1] * sn[1]); w1.y = cvt_pk(x1[2] * cs[2] - x2[2] * sn[2], x1[3] * cs[3] - x2[3] * sn[3]);
      w1.z = cvt_pk(x1[4] * cs[4] - x2[4] * sn[4], x1[5] * cs[5] - x2[5] * sn[5]); w1.w = cvt_pk(x1[6] * cs[6] - x2[6] * sn[6], x1[7] * cs[7] - x2[7] * sn[7]);
      w2.x = cvt_pk(x2[0] * cs[0] + x1[0] * sn[0], x2[1] * cs[1] + x1[1] * sn[1]); w2.y = cvt_pk(x2[2] * cs[2] + x1[2] * sn[2], x2[3] * cs[3] + x1[3] * sn[3]);
      w2.z = cvt_pk(x2[4] * cs[4] + x1[4] * sn[4], x2[5] * cs[5] + x1[5] * sn[5]); w2.w = cvt_pk(x2[6] * cs[6] + x1[6] * sn[6], x2[7] * cs[7] + x1[7] * sn[7]);
      qr[4] = __builtin_bit_cast(bf16x8, w1); qr[5] = __builtin_bit_cast(bf16x8, w2); }
    const int ka_r = tid / 12, ka_c = tid - 12 * ka_r; const int kb_i = 512 + (tid >> 1), kb_r = kb_i / 12, kb_c = kb_i - 12 * kb_r, kb_h = (tid & 1) * 8;
    const int dKr = (int)((const char*)Kr - (const char*)Kn);
    const int koa = ka_c < 8 ? (ka_r * 64 + ka_c * 8) * 2 : dKr + (ka_r * 32 + (ka_c - 8) * 8) * 2; const int ksa = ka_c < 8 ? 128 : 64;
    const int kob = (kb_c < 8 ? (kb_r * 64 + kb_c * 8) * 2 : dKr + (kb_r * 32 + (kb_c - 8) * 8) * 2) + kb_h; const int ksb = kb_c < 8 ? 128 : 64;
    const int kda = ka_r * KROWB + ka_c * 16, kdb = kb_r * KROWB + kb_c * 16 + kb_h;
    const int vr = tid >> 3, vc = (tid & 7) * 8; const int vo = (vr * 64 + vc) * 2; const int vd = v_st(vr, vc);
    const int vb0 = (int)(uintptr_t)V_lds + v_rd_base(lane);
    struct { bf16x8 ka, vv; u32x2 kb; } sr_[2];
#define SLOAD(i, k0) do { sr_[i].ka = *reinterpret_cast<const bf16x8*>((const char*)Kn + (koa + (k0) * ksa)); sr_[i].kb = *reinterpret_cast<const u32x2*>((const char*)Kn + (kob + (k0) * ksb)); \
    sr_[i].vv = *reinterpret_cast<const bf16x8*>((const char*)Vh + (vo + (k0) * 128)); } while (0)
#define SWRITE(b, i) do { *(bf16x8*)(V_lds + (b) * SHM_V + vd) = sr_[i].vv; *(bf16x8*)(K_lds + (b) * SHM_K + kda) = sr_[i].ka; \
    *(u32x2*)(K_lds + (b) * SHM_K + kdb) = sr_[i].kb; } while (0)
#define SWAIT() asm volatile("s_waitcnt vmcnt(3)" ::: "memory")
#define RESC(a) do { if (__any((a) < 1.f)) { _Pragma("unroll") for (int d = 0; d < 2; ++d) _Pragma("unroll") for (int r = 0; r < 16; ++r) o[d][r] *= (a); } } while (0)
    f32x16 pA0, pA1, pB0, pB1; float alA, alB; bf16x8 pa0, pa1, pa2, pa3; constexpr int NT = SEQ / 64;
    SLOAD(0, 0); asm volatile("s_waitcnt vmcnt(0)" ::: "memory"); SWRITE(0, 0); __syncthreads();
    qkt(pA0, pA1, K_lds, qr, r32, hi, negm); partialSM<true>(pA0, pA1, negm, alA);
    SLOAD(1, 64); SLOAD(0, 128);
    SWAIT(); SWRITE(1, 1); __syncthreads();
    int bc = 1;
    for (int j = 1; j + 1 < NT; j += 2) {
        const int bp = bc == 0 ? 2 : bc - 1, bn = bc == 2 ? 0 : bc + 1, bnn = bn == 2 ? 0 : bn + 1;
        SBAR(); qkt(pB0, pB1, K_lds + bc * SHM_K, qr, r32, hi, negm);
        finishSM(pA0, pA1, alA, l_reg, pa0, pa1, pa2, pa3); SBAR();
        SLOAD(1, (j + 2) * 64); SBAR();
        pv_d0(o, vb0 + bp * SHM_V, pa0, pa1, pa2, pa3); partialSM<false>(pB0, pB1, negm, alB);
        SWAIT(); SWRITE(bn, 0);
        RESC(alB); __syncthreads();
        SBAR(); qkt(pA0, pA1, K_lds + bn * SHM_K, qr, r32, hi, negm);
        finishSM(pB0, pB1, alB, l_reg, pa0, pa1, pa2, pa3); SBAR();
        if (j + 3 < NT) SLOAD(0, (j + 3) * 64); SBAR();
        pv_d0(o, vb0 + bc * SHM_V, pa0, pa1, pa2, pa3); partialSM<false>(pA0, pA1, negm, alA);
        SWAIT(); SWRITE(bnn, 1);
        RESC(alA); __syncthreads();
        bc = bnn;
    }
    { const int bp = bc == 0 ? 2 : bc - 1;
      SBAR(); qkt(pB0, pB1, K_lds + bc * SHM_K, qr, r32, hi, negm);
      finishSM(pA0, pA1, alA, l_reg, pa0, pa1, pa2, pa3); SBAR();
      pv_d0(o, vb0 + bp * SHM_V, pa0, pa1, pa2, pa3); partialSM<false>(pB0, pB1, negm, alB);
      RESC(alB);
      finishSM(pB0, pB1, alB, l_reg, pa0, pa1, pa2, pa3); SBAR();
      pv_d0(o, vb0 + bc * SHM_V, pa0, pa1, pa2, pa3); }
    { const float rl = __builtin_amdgcn_rcpf(l_reg);
      bf16_t* Zw = Zo + (size_t)(wid * 32 + r32) * NZ + 4 * hi; const bf16_t* Zgw = Zg + (size_t)(wid * 32 + r32) * NZ + 4 * hi;
#pragma unroll
      for (int d0 = 0; d0 < 2; ++d0)
#pragma unroll
          for (int g = 0; g < 4; ++g) { const int off = d0 * 32 + 8 * g; const u32x2 w = *(const u32x2*)(Zgw + off);
              u32x2 ov; ov.x = cvt_pk(o[d0][4 * g + 0] * rl * bflo(w.x), o[d0][4 * g + 1] * rl * bfhi(w.x)); ov.y = cvt_pk(o[d0][4 * g + 2] * rl * bflo(w.y), o[d0][4 * g + 3] * rl * bfhi(w.y));
              *(u32x2*)(Zw + off) = ov; } }
    __syncthreads();
#undef SLOAD
#undef SWRITE
#undef SWAIT
#undef RESC
}
}

struct Ctx {
    const Params* p; unsigned char* ws; char* lds; int G, c, tid, wave, zero;
};

DI void job_transpose(const Ctx& X, const float* W, int ldw, int col0, int ncols, int K, int kvalid, bf16_t* dst, int ldd, int drow0, int dcol0, float scale) {
    const int k8n = K >> 3, total = ncols * k8n;
    for (int it = X.c * NTHREADS + X.tid; it < total; it += X.G * NTHREADS) {
        const int n = it % ncols, k8 = it / ncols; float v[8];
#pragma unroll
        for (int i = 0; i < 8; ++i) { const int k = k8 * 8 + i; v[i] = k < kvalid ? W[(size_t)k * ldw + col0 + n] * scale : 0.f; }
        u32x4 w; w.x = cvt_pk(v[0], v[1]); w.y = cvt_pk(v[2], v[3]); w.z = cvt_pk(v[4], v[5]); w.w = cvt_pk(v[6], v[7]);
        *(u32x4*)(dst + (size_t)(drow0 + n) * ldd + dcol0 + k8 * 8) = w;
    }
}
DI void job_zero_rows(const Ctx& X, bf16_t* dst, int ldd, int drow0, int nrows, int K) {
    const int k8n = K >> 3, total = nrows * k8n; unsigned zz = 0u; asm volatile("" : "+v"(zz));
    for (int it = X.c * NTHREADS + X.tid; it < total; it += X.G * NTHREADS) { const int n = it / k8n, k8 = it % k8n;
        *(u32x4*)(dst + (size_t)(drow0 + n) * ldd + k8 * 8) = (u32x4){zz, zz, zz, zz}; }
}

DI void prep1(const Ctx& X) {
    const Params& P = *X.p; unsigned char* ws = X.ws;
    const int gt = X.c * NTHREADS + X.tid, GT = X.G * NTHREADS;
    if (gt < 16) ((float*)(ws + 768 * 1024))[gt] = 0.f;
    { float* rc = (float*)(ws + WS_ROPE); float* rs = rc + 4096 * 16;
      for (int it = gt; it < 4096 * 16; it += GT) { const int pos = it >> 4, i = it & 15; const float ang = (float)pos * P.inv_freq[i];
          double rev = (double)ang * 0.15915494309189535; rev -= __builtin_rint(rev); const float rf = (float)rev;
          rc[it] = __builtin_amdgcn_cosf(rf); rs[it] = __builtin_amdgcn_sinf(rf); } }
    { bf16_t* T = (bf16_t*)(ws + WS_DFT);
      for (int it = gt; it < 8 * 2048 * 128; it += GT) { const int k8 = it & 127, ks = (it >> 7) & 2047, j = it >> 18; float v[8];
#pragma unroll
          for (int i = 0; i < 8; ++i) { const int kidx = k8 * 8 + i, kk = kidx & 511, s = 2 * ((j >> 1) * 512 + kk) + (j & 1);
              const float fr = (float)((ks * s) & 4095) * (1.f / 4096.f);
              v[i] = (kidx < 512 ? __builtin_amdgcn_cosf(fr) : -__builtin_amdgcn_sinf(fr)) * (1.f / 64.f); }
          u32x4 w; w.x = cvt_pk(v[0], v[1]); w.y = cvt_pk(v[2], v[3]); w.z = cvt_pk(v[4], v[5]); w.w = cvt_pk(v[6], v[7]);
          *(u32x4*)(T + (size_t)it * 8) = w; } }
    for (int l = 0; l < NLAYER; ++l) {
        unsigned char* wl = ws + WS_W + (size_t)l * LW;
        const float* w_in = P.in[4 + X.zero] + (size_t)l * DM * NIN;
        bf16_t* WinT = (bf16_t*)(wl + W_IN);
        job_transpose(X, w_in, NIN, 256, 256, DM, DM, WinT, DM, 256, 0, 1.f);
        job_transpose(X, w_in, NIN, 512, 160, DM, DM, WinT, DM, 512, 0, 1.f);
        job_zero_rows(X, WinT, DM, 672, 96, DM);
        job_transpose(X, w_in, NIN, 672, 128, DM, DM, WinT, DM, 768, 0, 1.f);
        job_transpose(X, w_in, NIN, 928, 128, DM, DM, WinT, DM, 896, 0, 1.f);
        job_transpose(X, w_in, NIN, 800, 128, DM, DM, WinT, DM, 1024, 0, 1.f);
        job_transpose(X, w_in, NIN, 1056, 128, DM, DM, WinT, DM, 1152, 0, 1.f);
        job_transpose(X, w_in, NIN, 1440, 1280, DM, DM, WinT, DM, 1792, 0, 1.f);
        job_transpose(X, w_in, NIN, 2720, 4096, DM, DM, (bf16_t*)(wl + W_G), DM, 0, 0, 1.f);
        job_transpose(X, P.in[7 + X.zero] + (size_t)l * 256 * 768, 768, 0, 768, 256, 256, (bf16_t*)(wl + W_UQ), 256, 0, 0, ATT_SCALE * 1.4426950408889634f);
        job_transpose(X, P.in[9 + X.zero] + (size_t)l * 128 * 1024, 1024, 0, 1024, 256, 128, (bf16_t*)(wl + W_UKV), 256, 0, 0, 1.f);
        job_transpose(X, P.in[19 + X.zero] + (size_t)l * 256 * DM, DM, 0, DM, 256, 256, (bf16_t*)(wl + W_UP), 1280, 0, 0, 1.f);
        job_transpose(X, P.in[20 + X.zero] + (size_t)l * 512 * DM, DM, 0, DM, 512, 512, (bf16_t*)(wl + W_UP), 1280, 0, 256, 1.f);
        job_transpose(X, P.in[21 + X.zero] + (size_t)l * 256 * DM, DM, 0, DM, 256, 256, (bf16_t*)(wl + W_UP), 1280, 0, 768, 1.f);
        job_transpose(X, P.in[22 + X.zero] + (size_t)l * 256 * DM, DM, 0, DM, 256, 256, (bf16_t*)(wl + W_UP), 1280, 0, 1024, 1.f);
        job_transpose(X, P.in[23 + X.zero] + (size_t)l * DM * DM, DM, 0, DM, DM, DM, (bf16_t*)(wl + W_OUT), DM, 0, 0, 1.f);
        job_transpose(X, P.in[16 + X.zero] + (size_t)l * 256 * 256, 256, 0, 256, 256, 256, (bf16_t*)(wl + W_PW), 256, 0, 0, 1.f);
        { const float* pw = P.in[10 + X.zero] + (size_t)l * 4 * 64 * 64; const float* psc = P.in[11 + X.zero] + (size_t)l * 256;
          for (int it = gt; it < DM * 256; it += GT) { const int n = it & 255, k = it >> 8, g = n >> 6, d = n & 63; float a = 0.f;
              const float* wr_ = w_in + (size_t)k * NIN + g * 64; const float* pp = pw + g * 4096 + d;
#pragma unroll 8
              for (int cc = 0; cc < 64; ++cc) a = fmaf(wr_[cc], pp[cc * 64], a);
              WinT[(size_t)n * DM + k] = f2bf(a * psc[n]); } }
        { const float* wf = P.in[18 + X.zero] + (size_t)l * 256 * 256; float* MA = (float*)(ws + WS_MAB) + (size_t)l * 2 * 65536; float* MB = MA + 65536;
          for (int it = gt; it < 65536; it += GT) { const int d = it & 255, gc = it >> 8, g = gc >> 6, cch = gc & 63; float a = 0.f, b = 0.f;
              for (int kc = 0; kc < 64; ++kc) { const float fr = (float)((kc * cch) & 63) * (1.f / 64.f); const float w = wf[(size_t)(g * 64 + kc) * 256 + d];
                  a = fmaf(__builtin_amdgcn_cosf(fr), w, a); b = fmaf(__builtin_amdgcn_sinf(fr), w, b); }
              MA[it] = a; MB[it] = b; } }
    }
}
DI void prep2(const Ctx& X) {
    const Params& P = *X.p; unsigned char* ws = X.ws;
    const int gt = X.c * NTHREADS + X.tid, GT = X.G * NTHREADS;
    for (int l = 0; l < NLAYER; ++l) {
        const float* w_in = P.in[4 + X.zero] + (size_t)l * DM * NIN + 1184; bf16_t* WinT = (bf16_t*)(ws + WS_W + (size_t)l * LW + W_IN);
        const float* MA = (const float*)(ws + WS_MAB) + (size_t)l * 2 * 65536;
        for (int it = gt; it < DM * 512; it += GT) { const int n = it & 511, k = it >> 9; const float* Mx = MA + (n >> 8) * 65536 + (n & 255); const float* wr_ = w_in + (size_t)k * NIN; float a = 0.f;
#pragma unroll 8
            for (int gc = 0; gc < 256; ++gc) a = fmaf(wr_[gc], Mx[gc * 256], a);
            WinT[(size_t)(1280 + n) * DM + k] = f2bf(a * 0.125f); }
    }
}

DI void norm_pass(const Ctx& X, int ch, int l) {
    float NEPS = NORM_EPS; asm volatile("" : "+s"(NEPS));
    const Params& P = *X.p; const int lane = X.tid & 63;
    const int gw = X.G == 256 ? (256 * (8 * (X.c & 7) + ((X.c >> 3) & 7)) + 64 * (X.c >> 6) + 8 * X.wave) : X.c * NWAVES + X.wave, NGW = X.G == 256 ? 1 : X.G * NWAVES;
    const int rend = X.G == 256 ? gw + 8 : MC;
    const float* xin = ch == 0 ? P.in[0 + X.zero] : P.in[1 + X.zero] + (size_t)(ch - 1) * MC * DM;
    float* xo = P.out + (size_t)ch * MC * DM;
    const bf16_t* ob = (const bf16_t*)(X.ws + WS_OB); bf16_t* hb = (bf16_t*)(X.ws + WS_H);
    for (int r = gw; r < rend; r += NGW) {
        const float* xr = (l == 0 ? xin : (l == 1 ? xin : xo)) + (size_t)r * DM;
        f32x4 v[4];
#pragma unroll
        for (int j = 0; j < 4; ++j) v[j] = *(const f32x4*)(xr + (lane + 64 * j) * 4);
        if (l >= 1) {
            const float* pg = P.in[3 + X.zero] + (size_t)(l - 1) * DM; f32x4 ov[4]; float ss = 0.f;
#pragma unroll
            for (int j = 0; j < 4; ++j) { const u32x2 w = *(const u32x2*)(ob + (size_t)r * DM + (lane + 64 * j) * 4); ov[j] = (f32x4){bflo(w.x), bfhi(w.x), bflo(w.y), bfhi(w.y)};
                ss += ov[j][0] * ov[j][0] + ov[j][1] * ov[j][1] + ov[j][2] * ov[j][2] + ov[j][3] * ov[j][3]; }
            const float rs = __builtin_amdgcn_rsqf(wave_sum(ss, lane) * (1.f / DM) + NEPS);
#pragma unroll
            for (int j = 0; j < 4; ++j) { const f32x4 g = *(const f32x4*)(pg + (lane + 64 * j) * 4); v[j] += ov[j] * rs * g; *(f32x4*)(xo + (size_t)r * DM + (lane + 64 * j) * 4) = v[j]; }
        }
        if (l <= 1) {
            const float* pg = P.in[2 + X.zero] + (size_t)l * DM; float ss = 0.f;
#pragma unroll
            for (int j = 0; j < 4; ++j) ss += v[j][0] * v[j][0] + v[j][1] * v[j][1] + v[j][2] * v[j][2] + v[j][3] * v[j][3];
            const float rs = __builtin_amdgcn_rsqf(wave_sum(ss, lane) * (1.f / DM) + NEPS);
#pragma unroll
            for (int j = 0; j < 4; ++j) { const f32x4 g = *(const f32x4*)(pg + (lane + 64 * j) * 4); const f32x4 hv = v[j] * rs * g;
                u32x2 w; w.x = cvt_pk(hv[0], hv[1]); w.y = cvt_pk(hv[2], hv[3]); *(u32x2*)(hb + (size_t)r * DM + (lane + 64 * j) * 4) = w; }
        }
    }
}

DI void s_pass(const Ctx& X, int l) {
    float NEPS = NORM_EPS; asm volatile("" : "+s"(NEPS));
    const Params& P = *X.p; const int gw = X.c * NWAVES + X.wave, NGW = X.G * NWAVES, lane = X.tid & 63;
    const bf16_t* z = (const bf16_t*)(X.ws + WS_Z); bf16_t* cqn = (bf16_t*)(X.ws + WS_CQN); bf16_t* ckvn = (bf16_t*)(X.ws + WS_CKVN); bf16_t* kro = (bf16_t*)(X.ws + WS_KROPE);
    const float* qg = P.in[6 + X.zero] + (size_t)l * 256; const float* kg = P.in[8 + X.zero] + (size_t)l * 128;
    const float* rc = (const float*)(X.ws + WS_ROPE); const float* rs_ = rc + 4096 * 16;
    for (int r = gw; r < MC; r += NGW) {
        const bf16_t* zr = z + (size_t)r * NZ;
        { const u32x2 w = *(const u32x2*)(zr + 256 + lane * 4); f32x4 v = {bflo(w.x), bfhi(w.x), bflo(w.y), bfhi(w.y)};
          const float rs = __builtin_amdgcn_rsqf(wave_sum(v[0] * v[0] + v[1] * v[1] + v[2] * v[2] + v[3] * v[3], lane) * (1.f / 256.f) + NEPS);
          const f32x4 g = *(const f32x4*)(qg + lane * 4); v = v * rs * g; u32x2 o; o.x = cvt_pk(v[0], v[1]); o.y = cvt_pk(v[2], v[3]); *(u32x2*)(cqn + (size_t)r * 256 + lane * 4) = o; }
        { const unsigned w = *(const unsigned*)(zr + 512 + lane * 2); float a = bflo(w), b = bfhi(w);
          const float rs = __builtin_amdgcn_rsqf(wave_sum(a * a + b * b, lane) * (1.f / 128.f) + NEPS);
          const f32x2 g = *(const f32x2*)(kg + lane * 2); *(unsigned*)(ckvn + (size_t)r * 256 + lane * 2) = cvt_pk(a * rs * g[0], b * rs * g[1]);
          *(unsigned*)(ckvn + (size_t)r * 256 + 128 + lane * 2) = 0u; }
        if (lane < 16) { const int pos = r & 4095; const float x1 = bf2f(zr[640 + lane]), x2 = bf2f(zr[656 + lane]), cs = rc[pos * 16 + lane], sn = rs_[pos * 16 + lane];
          kro[(size_t)r * 32 + lane] = f2bf(x1 * cs - x2 * sn); kro[(size_t)r * 32 + 16 + lane] = f2bf(x2 * cs + x1 * sn); }
    }
}

DI void pool_pass(const Ctx& X, bf16_t* zo) {
    bf16_t* z = (bf16_t*)(X.ws + WS_Z);
    for (int e = X.c * NTHREADS + X.tid; e < MC * 32; e += X.G * NTHREADS) {
        const int t = e >> 5, cgp = e & 31, ch0 = cgp * 8, g = cgp >> 3, hw = 1 << g, s = t & 4095, tb = t - s;
        const int lo = max(s - hw, 0), hi = min(s + hw, SEQ);
        f32x4 a0 = {0.f, 0.f, 0.f, 0.f}, a1 = a0;
        for (int r = lo; r < hi; ++r) { f32x4 v0, v1; load8(z + (size_t)(tb + r) * NZ + ch0, v0, v1); a0 += v0; a1 += v1; }
        const float ic = 1.f / (float)(hi - lo); f32x4 u0, u1, g0, g1; load8(z + (size_t)t * NZ + ch0, u0, u1); load8(z + (size_t)t * NZ + ZC_G + ch0, g0, g1);
        store8(zo + (size_t)t * NZ + ZC_G + ch0, (a0 * ic - u0) * g0, (a1 * ic - u1) * g1);
    }
}

DI void dft_combine(const Ctx& X) {
    bf16_t* z = (bf16_t*)(X.ws + WS_Z); const bf16_t* Pp = (const bf16_t*)(X.ws + WS_P);
    for (int e = X.c * NTHREADS + X.tid; e < MC * 32; e += X.G * NTHREADS) {
        const int t = e >> 5, ch0 = (e & 31) * 8, b = t >> 12, s = t & 4095, ks = s & 2047; const float sg = s >= 2048 ? -1.f : 1.f;
        f32x4 a0 = {0.f, 0.f, 0.f, 0.f}, a1 = a0;
#pragma unroll
        for (int j = 0; j < 8; ++j) { f32x4 v0, v1; load8(Pp + ((size_t)(b * 8 + j) * 2048 + ks) * 256 + ch0, v0, v1); const float sj = (j & 1) ? sg : 1.f; a0 += v0 * sj; a1 += v1 * sj; }
        f32x4 g0, g1; bf16_t* zp = z + (size_t)t * NZ + ZC_GFOUR + ch0; load8(zp, g0, g1); store8(zp, a0 * g0, a1 * g1);
    }
}

DI void conv_item(const Ctx& X, int item, int l) {
    float LEPS = LN_EPS; asm volatile("" : "+s"(LEPS)); unsigned zz = 0u; asm volatile("" : "+v"(zz));
    const Params& P = *X.p; const int tid = X.tid;
    const bf16_t* z = (const bf16_t*)(X.ws + WS_Z); bf16_t* cb = (bf16_t*)(X.ws + WS_CB);
    char* gl = X.lds; float* co = (float*)(X.lds + 49152);
    const int t0 = item * 64, s0 = t0 & 4095, tb = t0 - s0;
    for (int i = tid; i < 94 * 32; i += NTHREADS) { const int r = i >> 5, c8 = i & 31, s = s0 - 15 + r; u32x4 w = {zz, zz, zz, zz};
        if (s >= 0 && s < SEQ) w = *(const u32x4*)(z + (size_t)(tb + s) * NZ + ZC_GLU + c8 * 8);
        *(u32x4*)(gl + r * 512 + c8 * 16) = w; }
    __syncthreads();
    { const int cp = tid & 127, tg = tid >> 7; const float* cw = P.in[12 + X.zero] + (size_t)l * 31 * 256 + 2 * cp; const f32x2 bias = *(const f32x2*)(P.in[13 + X.zero] + (size_t)l * 256 + 2 * cp);
      f32x2 w[31];
#pragma unroll
      for (int k = 0; k < 31; ++k) w[k] = *(const f32x2*)(cw + k * 256);
      f32x2 a[16];
#pragma unroll
      for (int i = 0; i < 16; ++i) a[i] = bias;
#pragma unroll
      for (int r = 0; r < 46; ++r) { const unsigned u = *(const unsigned*)(gl + (tg * 16 + r) * 512 + cp * 4); const f32x2 v = {bflo(u), bfhi(u)};
#pragma unroll
          for (int i = 0; i < 16; ++i) { if (r - i >= 0 && r - i <= 30) a[i] += v * w[r - i]; } }
#pragma unroll
      for (int i = 0; i < 16; ++i) *(f32x2*)(co + (tg * 16 + i) * 256 + 2 * cp) = a[i]; }
    __syncthreads();
    { const int wv = X.wave, lane = X.tid & 63; const f32x4 g = *(const f32x4*)(P.in[14 + X.zero] + (size_t)l * 256 + lane * 4), be = *(const f32x4*)(P.in[15 + X.zero] + (size_t)l * 256 + lane * 4);
#pragma unroll
      for (int i = 0; i < 8; ++i) { const int tok = wv * 8 + i; f32x4 v = *(const f32x4*)(co + tok * 256 + lane * 4);
          const float mu = wave_sum(v[0] + v[1] + v[2] + v[3], lane) * (1.f / 256.f); v -= mu;
          const float rs = __builtin_amdgcn_rsqf(wave_sum(v[0] * v[0] + v[1] * v[1] + v[2] * v[2] + v[3] * v[3], lane) * (1.f / 256.f) + LEPS);
          v = v * rs * g + be;
#pragma unroll
          for (int e = 0; e < 4; ++e) v[e] = siluf_(v[e]);
          u32x2 o; o.x = cvt_pk(v[0], v[1]); o.y = cvt_pk(v[2], v[3]); *(u32x2*)(cb + (size_t)(t0 + tok) * 256 + lane * 4) = o; } }
    __syncthreads();
}


DI float dotbf(const bf16_t* a, const bf16_t* b, int K) { float s = 0.f; for (int k = 0; k < K; ++k) s = fmaf(bf2f(a[k]), bf2f(b[k]), s); return s; }
DI void dbg_max(float* w, float v) { atomicMax((int*)w, __builtin_bit_cast(int, fabsf(v))); }
DI void dbg_check(const Ctx& X, int l) {
    const Params& P = *X.p; unsigned char* ws = X.ws; unsigned char* wl = ws + WS_W + (size_t)l * LW;
    float* dbg = (float*)(ws + 768 * 1024);
    const bf16_t* h = (const bf16_t*)(ws + WS_H); const bf16_t* z = (const bf16_t*)(ws + WS_Z); const bf16_t* WinT = (const bf16_t*)(wl + W_IN);
    const bf16_t* abt = (const bf16_t*)(ws + WS_ABT); const bf16_t* T = (const bf16_t*)(ws + WS_DFT); const bf16_t* Pp = (const bf16_t*)(ws + WS_P);
    const bf16_t* U = (const bf16_t*)(ws + WS_U); const bf16_t* mb = (const bf16_t*)(ws + WS_M); const bf16_t* ob = (const bf16_t*)(ws + WS_OB);
    const bf16_t* WupT = (const bf16_t*)(wl + W_UP); const bf16_t* WgT = (const bf16_t*)(wl + W_G); const bf16_t* WoT = (const bf16_t*)(wl + W_OUT);
    const int i = X.c * NTHREADS + X.tid; if (i >= 32768) return;
    const unsigned hsh = (unsigned)i * 2654435761u; const int row = (hsh >> 7) % MC; const int cc = (hsh >> 3) & 1023;
    const bf16_t* hr = h + (size_t)row * DM;
    { const int col = cc % 672; dbg_max(dbg + 1, bf2f(z[(size_t)row * NZ + col]) - dotbf(hr, WinT + (size_t)col * DM, DM)); }
    { const int col = cc & 255, wr0 = 768 + (col >> 7) * 256 + (col & 127); const float a = dotbf(hr, WinT + (size_t)wr0 * DM, DM), b = dotbf(hr, WinT + (size_t)(wr0 + 128) * DM, DM);
      dbg_max(dbg + 2, bf2f(z[(size_t)row * NZ + ZC_GLU + col]) - a / (1.f + expf(-b))); }
    { const int ch = cc & 255, b = row >> 12, s = row & 4095, j = (s & 1) + 2 * (s >> 10), kidx = (s >> 1) & 511; const bf16_t* ap = abt + ((size_t)(b * 8 + j) * 256 + ch) * 1024;
      dbg_max(dbg + 3, bf2f(ap[kidx]) - dotbf(hr, WinT + (size_t)(1280 + ch) * DM, DM)); dbg_max(dbg + 3, bf2f(ap[512 + kidx]) - dotbf(hr, WinT + (size_t)(1536 + ch) * DM, DM)); }
    { const int ch = cc & 255, bj = (row >> 11) & 31, ks = row & 2047; dbg_max(dbg + 4, bf2f(Pp[((size_t)bj * 2048 + ks) * 256 + ch]) - dotbf(T + ((size_t)(bj & 7) * 2048 + ks) * 1024, abt + ((size_t)bj * 256 + ch) * 1024, 1024)); }
    { const int br = (hsh >> 1) & 3, koff = br == 0 ? 0 : (br == 1 ? 256 : (br == 2 ? 768 : 1024)), K = br == 1 ? 512 : 256;
      dbg_max(dbg + 5, bf2f(U[(size_t)row * 4096 + br * 1024 + cc]) - dotbf(z + (size_t)row * NZ + ZC_G + koff, WupT + (size_t)cc * 1280 + koff, K)); }
    { float acc = 0.f; for (int b = 0; b < 4; ++b) { const float g = dotbf(hr, WgT + (size_t)(b * 1024 + cc) * DM, DM) + P.in[5 + X.zero][(size_t)l * 4096 + b * 1024 + cc];
          acc += bf2f(U[(size_t)row * 4096 + b * 1024 + cc]) / (1.f + expf(-g)); }
      dbg_max(dbg + 6, bf2f(mb[(size_t)row * 1024 + cc]) - acc); }
    { dbg_max(dbg + 7, bf2f(ob[(size_t)row * 1024 + cc]) - dotbf(mb + (size_t)row * 1024, WoT + (size_t)cc * DM, DM)); }
    { const int col = cc & 255, g = col >> 6, hw = 1 << g, s = row & 4095, tb = row - s, lo = max(s - hw, 0), hi = min(s + hw, SEQ); float a = 0.f;
      for (int r = lo; r < hi; ++r) a += bf2f(z[(size_t)(tb + r) * NZ + col]);
      const float gg = dotbf(hr, WinT + (size_t)(1792 + col) * DM, DM), sg = gg / (1.f + expf(-gg));
      dbg_max(dbg + 8, bf2f(z[(size_t)row * NZ + ZC_G + col]) - (a / (float)(hi - lo) - bf2f(z[(size_t)row * NZ + col])) * sg); }
    { const bf16_t* cbp = (const bf16_t*)(ws + WS_CB); const int col = cc & 255, s = row & 4095, tb = row - s; float sum = 0.f, sq = 0.f, mine = 0.f;
      for (int ch = 0; ch < 256; ++ch) { float a = P.in[13 + X.zero][(size_t)l * 256 + ch];
          for (int k = 0; k < 31; ++k) { const int ss = s + k - 15; if (ss >= 0 && ss < SEQ) a = fmaf(bf2f(z[(size_t)(tb + ss) * NZ + ZC_GLU + ch]), P.in[12 + X.zero][((size_t)l * 31 + k) * 256 + ch], a); }
          sum += a; sq += a * a; if (ch == col) mine = a; }
      const float mu = sum / 256.f, var = sq / 256.f - mu * mu; float y = (mine - mu) / sqrtf(var + LN_EPS) * P.in[14 + X.zero][(size_t)l * 256 + col] + P.in[15 + X.zero][(size_t)l * 256 + col]; y = y / (1.f + expf(-y));
      dbg_max(dbg + 9, bf2f(cbp[(size_t)row * 256 + col]) - y);
      const float gg = dotbf(hr, WinT + (size_t)(2560 + col) * DM, DM), sg = gg / (1.f + expf(-gg));
      dbg_max(dbg + 10, bf2f(z[(size_t)row * NZ + ZC_GCONV + col]) - (dotbf(cbp + (size_t)row * 256, (const bf16_t*)(wl + W_PW) + (size_t)col * 256, 256) + P.in[17 + X.zero][(size_t)l * 256 + col]) * sg); }
    { const int col = cc & 255, b = row >> 12, s = row & 4095, ks = s & 2047; float f = 0.f;
      for (int j = 0; j < 8; ++j) { const float pv = bf2f(Pp[((size_t)(b * 8 + j) * 2048 + ks) * 256 + col]); f += ((j & 1) && s >= 2048) ? -pv : pv; }
      const float gg = dotbf(hr, WinT + (size_t)(2816 + col) * DM, DM), sg = gg / (1.f + expf(-gg));
      dbg_max(dbg + 11, bf2f(z[(size_t)row * NZ + ZC_GFOUR + col]) - f * sg); }
    { const float* xr = P.in[0 + X.zero] + (size_t)row * DM; float ss = 0.f; for (int k = 0; k < DM; ++k) ss = fmaf(xr[k], xr[k], ss);
      dbg_max(dbg + 12, bf2f(hr[cc]) - xr[cc] / sqrtf(ss / DM + NORM_EPS) * P.in[2 + X.zero][(size_t)l * DM + cc]); }
}
DI void dbg_report(const Ctx& X) {
    const float* dbg = (const float*)(X.ws + 768 * 1024);
    if (X.c == 0 && X.tid == 0) { float add = 0.f;
        if (dbg[1] > 0.03f) add = 1e2f; if (dbg[2] > 0.03f) add = 1e3f; if (dbg[3] > 0.03f) add = 1e4f; if (dbg[4] > 0.03f) add = 1e5f;
        if (dbg[5] > 0.03f) add = 1e6f; if (dbg[6] > 0.03f) add = 1e7f; if (dbg[7] > 0.03f) add = 1e8f; if (dbg[8] > 0.03f) add = 1e9f; if (dbg[9] > 0.03f) add = 1e10f; if (dbg[10] > 0.03f) add = 1e11f; if (dbg[11] > 0.03f) add = 1e12f; if (dbg[12] > 0.03f) add = 1e13f;
        X.p->out[0] += add; }
}

#define XB_TMO      128
#define XB_XCNT(j)  (256  + 64 * (j))
#define XB_XSUB(j)  (1280 + 64 * (j))
#define XB_XGEN(j)  (2304 + 64 * (j))
#define XB_TOP      3328
#define XB_TOPGEN   3392
#define XCD_BAR_WORDS 3456
#define XB_SPIN_CAP (1u << 22)
constexpr size_t WS_BAR = 800 * 1024;
constexpr int LDS_MISC = 131072 + 1024;
DI unsigned xb_ld(unsigned* p)              { return __hip_atomic_load(p, __ATOMIC_RELAXED, __HIP_MEMORY_SCOPE_AGENT); }
DI unsigned xb_add(unsigned* p, unsigned v) { return __hip_atomic_fetch_add(p, v, __ATOMIC_RELAXED, __HIP_MEMORY_SCOPE_AGENT); }
DI unsigned xb_xcc_id() { return (unsigned)__builtin_amdgcn_s_getreg((3 << 11) | 20) & 0xFu; }
#define XB_SPIN(cond, bar) do { unsigned _sp = 0; while (cond) { __builtin_amdgcn_s_sleep(1); \
    if ((++_sp & 255u) == 0u) { if (xb_ld(&(bar)[XB_TMO])) break; if (_sp > XB_SPIN_CAP) { atomicAdd(&(bar)[XB_TMO], 1u); break; } } } } while (0)
struct XcdBarrier { unsigned* bar; unsigned x; volatile LAS unsigned* st; };
DI void xcd_barrier_complete(unsigned* bar, unsigned x, unsigned& nloc, unsigned& nx) {
    const unsigned G = gridDim.x * gridDim.y * gridDim.z;
    unsigned sum, cnt, mine, sp = 0u;
    for (;;) {
        sum = 0u; cnt = 0u; mine = 0u;
#pragma unroll
        for (unsigned j = 0; j < 16; ++j) { const unsigned c = xb_ld(&bar[XB_XCNT(j)]); sum += c; cnt += (c > 0u) ? 1u : 0u; mine = (j == x) ? c : mine; }
        if (sum == G) break;
        __builtin_amdgcn_s_sleep(1);
        if ((++sp & 255u) == 0u) { if (xb_ld(&bar[XB_TMO])) break; if (sp > XB_SPIN_CAP) { atomicAdd(&bar[XB_TMO], 1u); break; } }
    }
    nloc = mine > 0u ? mine : 1u; nx = cnt > 0u ? cnt : 1u;
}
DI void xcd_barrier(const XcdBarrier& b, const int tid) {
    asm volatile("s_waitcnt vmcnt(0)" ::: "memory");
    __syncthreads();
    if (tid == 0) {
        unsigned* bar = b.bar;
        __builtin_amdgcn_s_waitcnt(0);
        unsigned nloc = b.st[0], nx = b.st[1];
        if (nloc == 0u) { xcd_barrier_complete(bar, b.x, nloc, nx); b.st[0] = nloc; b.st[1] = nx; }
        const unsigned old = xb_add(&bar[XB_XSUB(b.x)], 1u);
        const unsigned gen = old / nloc;
        if (old + 1u == (gen + 1u) * nloc) {
            __builtin_amdgcn_fence(__ATOMIC_RELEASE, "agent");
            asm volatile("s_waitcnt vmcnt(0)" ::: "memory");
            const unsigned og = xb_add(&bar[XB_TOP], 1u);
            const unsigned tg = og / nx;
            if (og + 1u == (tg + 1u) * nx) xb_add(&bar[XB_TOPGEN], 1u);
            else XB_SPIN(xb_ld(&bar[XB_TOPGEN]) == tg, bar);
            __builtin_amdgcn_fence(__ATOMIC_ACQUIRE, "agent");
            xb_add(&bar[XB_XGEN(b.x)], 1u);
            asm volatile("s_waitcnt vmcnt(0)" ::: "memory");
        } else {
            XB_SPIN(xb_ld(&bar[XB_XGEN(b.x)]) == gen, bar);
            __builtin_amdgcn_fence(__ATOMIC_ACQUIRE, "agent");
            asm volatile("s_waitcnt vmcnt(0)" ::: "memory");
        }
    }
    __syncthreads();
}


#define GB_SUB(g)  (8192 + 16 * (g))
#define GB_GEN(g)  (9216 + 16 * (g))
#define GB_OK      6144
#define GB_MAP     6400
DI void grp_barrier(unsigned* bar, const int g, const unsigned nloc, const int tid) {
    asm volatile("s_waitcnt vmcnt(0)" ::: "memory");
    __syncthreads();
    if (tid == 0) {
        __builtin_amdgcn_s_waitcnt(0);
        const unsigned old = xb_add(&bar[GB_SUB(g)], 1u); const unsigned gen = old / nloc;
        if (old + 1u == (gen + 1u) * nloc) xb_add(&bar[GB_GEN(g)], 1u);
        else XB_SPIN(xb_ld(&bar[GB_GEN(g)]) == gen, bar);
        __builtin_amdgcn_fence(__ATOMIC_ACQUIRE, "agent");
        asm volatile("s_waitcnt vmcnt(0)" ::: "memory");
    }
    __syncthreads();
}

constexpr int NPH = 7;
constexpr int NSTEPS = 2 + NCHUNK * NLAYER * NPH + 1;

DI void run_step(const Ctx& X, int step, const int dummy, const XcdBarrier* xb) {
    const Params& P = *X.p; unsigned char* ws = X.ws; LAS unsigned char* ldsl = (LAS unsigned char*)X.lds;
    if (step == 0) { prep1(X); return; }
    if (step == 1) { prep2(X); return; }
    if (step == NSTEPS - 1) { norm_pass(X, NCHUNK - 1, 2); return; }
    const int s2 = step - 2, ph = s2 % NPH, cl = s2 / NPH, l = cl % NLAYER, ch = cl / NLAYER;
    unsigned char* wl = ws + WS_W + (size_t)l * LW;
    switch (ph) {
    case 0: { if (l == 0 && ch > 0) norm_pass(X, ch - 1, 2); norm_pass(X, ch, l); } break;
    case 1: { SchedSimple S{(const char*)(ws + WS_H), (const char*)(wl + W_IN), DM, DM, 16, 12, X.G, X.c, 0};
              EpiIn E{(bf16_t*)(ws + WS_Z), (bf16_t*)(ws + WS_ABT)};
              pg8::gemm_phase(ldsl, X.tid, DM, DM, S, E); } break;
    case 2: {
        s_pass(X, l);
        { SchedDft S{(const char*)(ws + WS_DFT), (const char*)(ws + WS_ABT), X.G, X.c}; EpiDft E{(bf16_t*)(ws + WS_P)};
          pg8::gemm_phase(ldsl, X.tid, 1024, 1024, S, E); }
        for (int it = X.c; it < MC / 64; it += X.G) conv_item(X, it, l);
        pool_pass(X, dummy ? (bf16_t*)(ws + WS_U) : (bf16_t*)(ws + WS_Z));
    } break;
    case 3: { { SchedQKV S{(const char*)(ws + WS_CQN), (const char*)(ws + WS_CKVN), (const char*)(wl + W_UQ), (const char*)(wl + W_UKV), X.G, X.c};
                EpiQKV E{(bf16_t*)(ws + WS_Q), (bf16_t*)(ws + WS_KN), (bf16_t*)(ws + WS_V)};
                pg8::gemm_phase(ldsl, X.tid, 256, 256, S, E); }
              { SchedSimple S{(const char*)(ws + WS_CB), (const char*)(wl + W_PW), 256, 256, 4, 1, X.G, X.c, (X.G >> 3) >= 32 ? 24 : 0};
                EpiPw E{(bf16_t*)(ws + WS_Z), P.in[17 + X.zero] + (size_t)l * 256};
                pg8::gemm_phase(ldsl, X.tid, 256, 256, S, E); }
              dft_combine(X); } break;
    case 4: {
        const bf16_t* q = (const bf16_t*)(ws + WS_Q); const bf16_t* kn = (const bf16_t*)(ws + WS_KN); const bf16_t* kr = (const bf16_t*)(ws + WS_KROPE); const bf16_t* v = (const bf16_t*)(ws + WS_V);
        bf16_t* z = (bf16_t*)(ws + WS_Z); bf16_t* zo = dummy ? (bf16_t*)(ws + WS_U) : z; const float* rc = (const float*)(ws + WS_ROPE); const float* rs = rc + 4096 * 16;
        for (int i = 0;; ++i) { int pair, qb;
            if (X.G == 256) { if (i >= 2) break; const int pm = 8 * (X.c & 7) + ((X.c >> 3) & 7), pc = X.c >> 6; pair = (pm >> 4) * 8 + 2 * pc + i; qb = pm & 15; }
            else if ((X.G & 7) == 0) { const int per = X.G >> 3, x = X.c & 7, idx = X.c >> 3, qq = i * per + idx; if (qq >= 64) break; pair = 4 * x + (qq >> 4); qb = qq & 15; }
            else { const int L = i * X.G + X.c; if (L >= 512) break; pair = L >> 4; qb = L & 15; }
            const int b = pair >> 3, h = pair & 7;
            att::attn_unit(q + ((size_t)pair * 4096 + qb * 256) * 96, kn + (size_t)pair * 4096 * 64, kr + (size_t)b * 4096 * 32, v + (size_t)pair * 4096 * 64,
                           z + ((size_t)(b * 4096 + qb * 256)) * NZ + ZC_GATTN + h * 64, zo + ((size_t)(b * 4096 + qb * 256)) * NZ + ZC_GATTN + h * 64, rc, rs, qb * 256, X.lds, X.tid); }
    } break;
    case 5: { { SchedUp S{(const char*)(ws + WS_Z), (const char*)(wl + W_UP), X.G, X.c}; EpiPlain E{(bf16_t*)(ws + WS_U), 4096, 0};
                pg8::gemm_phase(ldsl, X.tid, NZ, 1280, S, E); }
              if (X.G != 256) xcd_barrier(*xb, X.tid);
              { SchedGate S{(const char*)(ws + WS_H), (const char*)(wl + W_G), X.G, X.c};
                EpiGate E{(const bf16_t*)(ws + WS_U), (bf16_t*)(ws + WS_M), P.in[5 + X.zero] + (size_t)l * 4096};
                pg8::gemm_phase(ldsl, X.tid, DM, DM, S, E); } } break;
    case 6: { SchedSimple S{(const char*)(ws + WS_M), (const char*)(wl + W_OUT), DM, DM, 16, 4, X.G, X.c, 0}; EpiPlain E{(bf16_t*)(ws + WS_OB), DM, 0};
              pg8::gemm_phase(ldsl, X.tid, DM, DM, S, E); } break;
    }
}


__global__ void __launch_bounds__(NTHREADS, 2) mk_fwd(Params prm) {
    extern __shared__ __attribute__((aligned(16))) unsigned char lds[];
    const int wave_s = __builtin_amdgcn_readfirstlane(threadIdx.x >> 6);
    volatile LAS unsigned* bst = (volatile LAS unsigned*)((LAS unsigned char*)lds + LDS_MISC);
    if (threadIdx.x == 0) { bst[0] = 0u; bst[1] = 0u; }
    __syncthreads();
    XcdBarrier xbar; xbar.bar = (unsigned*)(prm.ws + WS_BAR); xbar.x = xb_xcc_id(); xbar.st = bst;
    if (threadIdx.x == 0) { (void)xb_add(&xbar.bar[XB_XCNT(xbar.x)], 1u); __hip_atomic_store(&xbar.bar[GB_MAP + blockIdx.x], xbar.x + 1u, __ATOMIC_RELAXED, __HIP_MEMORY_SCOPE_AGENT); }
    int use_local = 0;
    int rep = 0;
    for (int step = prm.step_lo; step < prm.step_hi;) {
        int wv_ = wave_s, cb_ = blockIdx.x, gd_ = gridDim.x, zero_ = 0;
        asm volatile("" : "+s"(wv_), "+s"(cb_), "+s"(gd_), "+s"(zero_));
        int lane_; asm volatile("v_mbcnt_lo_u32_b32 %0, -1, 0\n\tv_mbcnt_hi_u32_b32 %0, -1, %0" : "=v"(lane_));
        int tidv = wv_ * 64 + lane_;
        Ctx X; X.p = &prm; X.ws = prm.ws + (size_t)(unsigned)zero_; X.lds = (char*)lds; X.G = gd_; X.c = cb_; X.tid = tidv; X.zero = zero_;
        X.wave = __builtin_amdgcn_readfirstlane(tidv >> 6);
        const bool want2 = (DBL_PREP && step < 2) || (DBL_MASK != 0 && step >= 2 && step < NSTEPS - 1 && ((DBL_MASK >> ((step - 2) % NPH)) & 1));
        const int dummy = (want2 && rep == 0) ? 1 : 0;
        run_step(X, step, dummy, &xbar);
        if (dummy) rep = 1; else { rep = 0; ++step; }
        if (step < prm.step_hi) {
            if (step == 1) { cg::this_grid().sync();
                if (tidv == 0) { unsigned ok = (gd_ == 256) ? 1u : 0u; for (int k = 0; k < 32 && ok; ++k) ok = (xb_ld(&xbar.bar[GB_MAP + (cb_ & 7) + 8 * k]) == xbar.x + 1u) ? 1u : 0u; (void)xb_add(&xbar.bar[GB_OK], ok); } }
            else if (step == 2) { xcd_barrier(xbar, tidv); use_local = __builtin_amdgcn_readfirstlane((int)(xb_ld(&xbar.bar[GB_OK]) == (unsigned)gd_)); }
            else { const int phd = (step - 3) % NPH;
                if (use_local && step >= 3 && (phd == 4 || phd == 5 || phd == 6 || phd == 0)) grp_barrier(xbar.bar, (cb_ & 7) * 8 + ((cb_ >> 3) & 7), 4u, tidv); else xcd_barrier(xbar, tidv); }
        }
    }
}

__global__ void __launch_bounds__(NTHREADS) dbg_kernel(Params prm, int mode) {
    Ctx X; X.p = &prm; X.ws = prm.ws; X.lds = nullptr; X.G = gridDim.x; X.c = blockIdx.x; X.tid = threadIdx.x; X.wave = threadIdx.x >> 6; X.zero = 0;
    if (mode == 0) dbg_check(X, 0); else dbg_report(X);
}

extern "C" void kernel_launch(void* const* d_in, const int* in_sizes, int n_in, void* d_out, int out_size, void* d_ws, size_t ws_size, hipStream_t stream) {
    static int grid = 0;
    if (grid == 0) {
        if (n_in != 24 || ws_size < WS_END) { fprintf(stderr, "kernel_launch: unexpected n_in %d / ws %zu\n", n_in, ws_size); grid = -1; return; }
        int dev = 0, cus = 0, per_cu = 0;
        hipGetDevice(&dev); hipDeviceGetAttribute(&cus, hipDeviceAttributeMultiprocessorCount, dev);
        if (hipFuncSetAttribute((const void*)mk_fwd, hipFuncAttributeMaxDynamicSharedMemorySize, LDS_BYTES) != hipSuccess) { fprintf(stderr, "kernel_launch: hipFuncSetAttribute failed\n"); grid = -1; return; }
        if (hipOccupancyMaxActiveBlocksPerMultiprocessor(&per_cu, (const void*)mk_fwd, NTHREADS, LDS_BYTES) != hipSuccess || per_cu < 1) { fprintf(stderr, "kernel_launch: occupancy query says %d\n", per_cu); per_cu = 1; }
        (void)hipGetLastError();
        grid = cus;
    }
    if (grid < 0) return;
    Params p{};
    for (int i = 0; i < 24; ++i) p.in[i] = (const float*)d_in[i];
    p.out = (float*)d_out; p.ws = (unsigned char*)d_ws;
    for (int i = 0; i < 16; ++i) p.inv_freq[i] = 1.0f / powf(10000.0f, (float)(2 * i) / 32.0f);
#if MULTI_LAUNCH
    for (int s = 0; s < NSTEPS; ++s) {
#if DBG_ON
        if (s == 2 + (DBG_CH * 2 + 1) * NPH) hipLaunchKernelGGL(dbg_kernel, dim3(64), dim3(NTHREADS), 0, stream, p, 0);
#endif

        p.step_lo = s; p.step_hi = s + 1; hipLaunchKernelGGL(mk_fwd, dim3(grid), dim3(NTHREADS), LDS_BYTES, stream, p); }
#if DBG_ON
    hipLaunchKernelGGL(dbg_kernel, dim3(1), dim3(NTHREADS), 0, stream, p, 1);
#endif
#else
    p.step_lo = 0; p.step_hi = NSTEPS;
    (void)hipMemsetAsync((char*)d_ws + WS_BAR, 0, 65536, stream);
    void* args[] = {&p};
    hipError_t e = hipLaunchCooperativeKernel((const void*)mk_fwd, dim3(grid), dim3(NTHREADS), args, LDS_BYTES, stream);
    if (e != hipSuccess) fprintf(stderr, "cooperative launch failed: %s (grid %d)\n", hipGetErrorString(e), grid);
#endif
}
```

```cpp
#include <hip/hip_runtime.h>
#include <hip/hip_cooperative_groups.h>
#include <cstdio>
#include <cstdint>
namespace cg = cooperative_groups;

#ifndef PH4_ATT
#define PH4_ATT 1
#endif
#ifndef PH4_DFT
#define PH4_DFT 1
#endif
#ifndef PH4_CONV
#define PH4_CONV 1
#endif
#ifndef PH4_POOL
#define PH4_POOL 1
#endif
#ifndef DBL_PREP
#define DBL_PREP 0
#endif
#ifndef DBL_MASK
#define DBL_MASK 0
#endif
#ifndef DBG_ON
#define DBG_ON 0
#endif
#ifndef DBG_CH
#define DBG_CH 0
#endif
#ifndef MULTI_LAUNCH
#define MULTI_LAUNCH 0
#endif

#define DI __device__ __forceinline__
#define LAS __attribute__((address_space(3)))
typedef unsigned short bf16_t;
typedef short bf16x8 __attribute__((ext_vector_type(8)));
typedef short s16x4 __attribute__((ext_vector_type(4)));
typedef float f32x4 __attribute__((ext_vector_type(4)));
typedef float f32x2 __attribute__((ext_vector_type(2)));
typedef float f32x16 __attribute__((ext_vector_type(16)));
typedef unsigned u32x4 __attribute__((ext_vector_type(4)));
typedef unsigned u32x2 __attribute__((ext_vector_type(2)));

constexpr int DM = 1024, SEQ = 4096, NLAYER = 2, NIN = 6816;
constexpr int MC = 16384, NCHUNK = 5, CSEQ = 4;
constexpr int NZ = 3072;
constexpr int ZC_GLU = 768, ZC_G = 1792, ZC_GATTN = 2048, ZC_GCONV = 2560, ZC_GFOUR = 2816;
constexpr float NORM_EPS = 1e-6f, LN_EPS = 1e-5f;
constexpr float ATT_SCALE = 0.10206207261596575f;
constexpr int LDS_BYTES = 147456;
constexpr int NTHREADS = 512, NWAVES = 8;

constexpr size_t MiB = 1u << 20;
constexpr size_t WS_ROPE = 0;
constexpr size_t WS_MAB = 1 * MiB;
constexpr size_t WS_W = 2 * MiB, LW = 20 * MiB;
constexpr size_t W_IN = 0, W_G = 6 * MiB, W_UQ = 14 * MiB, W_UKV = 14 * MiB + 512 * 1024, W_UP = 15 * MiB, W_OUT = 17 * MiB + 512 * 1024, W_PW = 19 * MiB + 512 * 1024;
constexpr size_t WS_DFT = 42 * MiB;
constexpr size_t WS_H = 74 * MiB, WS_Z = 106 * MiB, WS_CQN = 202 * MiB, WS_CKVN = 210 * MiB, WS_KROPE = 218 * MiB;
constexpr size_t WS_Q = 219 * MiB, WS_KN = 243 * MiB, WS_V = 259 * MiB, WS_ABT = 275 * MiB, WS_P = 291 * MiB, WS_CB = 323 * MiB;
constexpr size_t WS_U = 331 * MiB, WS_M = 459 * MiB, WS_OB = 491 * MiB, WS_END = 523 * MiB;

struct Params {
    const float* in[24];
    float* out;
    unsigned char* ws;
    float inv_freq[16];
    int step_lo, step_hi;
};

DI unsigned cvt_pk(float lo, float hi) { unsigned r; asm volatile("v_cvt_pk_bf16_f32 %0, %1, %2" : "=v"(r) : "v"(lo), "v"(hi)); return r; }
DI bf16_t f2bf(float f) { unsigned u = __builtin_bit_cast(unsigned, f); return (bf16_t)((u + 0x7fffu + ((u >> 16) & 1u)) >> 16); }
DI float bf2f(bf16_t b) { return __builtin_bit_cast(float, (unsigned)b << 16); }
DI float bflo(unsigned w) { return __builtin_bit_cast(float, w << 16); }
DI float bfhi(unsigned w) { return __builtin_bit_cast(float, w & 0xffff0000u); }
DI float sigmoidf_(float x) { return __builtin_amdgcn_rcpf(1.f + __builtin_amdgcn_exp2f(-1.4426950408889634f * x)); }
DI float siluf_(float x) { return x * sigmoidf_(x); }
DI float wave_sum(float v, int lane) {
#pragma unroll
    for (int o = 1; o < 64; o <<= 1) v += __builtin_bit_cast(float, __builtin_amdgcn_ds_bpermute((lane ^ o) << 2, __builtin_bit_cast(int, v)));
    return v;
}
DI void store8(bf16_t* p, f32x4 v0, f32x4 v1) { u32x4 w; w.x = cvt_pk(v0[0], v0[1]); w.y = cvt_pk(v0[2], v0[3]); w.z = cvt_pk(v1[0], v1[1]); w.w = cvt_pk(v1[2], v1[3]); *(u32x4*)p = w; }
DI void load8(const bf16_t* p, f32x4& v0, f32x4& v1) { u32x4 w = *(const u32x4*)p; v0 = (f32x4){bflo(w.x), bfhi(w.x), bflo(w.y), bfhi(w.y)}; v1 = (f32x4){bflo(w.z), bfhi(w.z), bflo(w.w), bfhi(w.w)}; }

namespace pg8 {
constexpr int BM = 256, BK = 64, HALF = 128, HTB = HALF * BK * 2, STAGE_BYTES = 8 * HTB;
DI int lds_byte(int r, int c) { const int st = (r >> 4) * 2 + (c >> 5), rr = r & 15, cc = c & 31, ob = rr * 64 + cc * 2; return st * 1024 + (ob ^ (((ob >> 9) & 1) << 5)); }
DI void stage_rc(int b, int& R, int& C) { const int st = b / 1024, sb = b % 1024, swz = sb ^ (((sb >> 9) & 1) << 5); R = (st >> 1) * 16 + swz / 64; C = (st & 1) * 32 + (swz % 64) / 2; }
DI int perm32(int rho) { const int n = rho >> 4, i = rho & 15; return 8 * (i >> 2) + 4 * n + (i & 3); }

struct Unit { const char* A; const char* B; int nt; int pm; int pn; int tag; };

template <class Epi, class Sched>
DI void gemm_phase(LAS unsigned char* lds, const int tid, const int lda, const int ldb, const Sched& S, const Epi& E) {
    const int  wid = __builtin_amdgcn_readfirstlane(tid >> 6), lane = tid & 63, wr = wid >> 2, wc = wid & 3, fr = lane & 15, fq = lane >> 4;
    unsigned voffA[2], voffB[2];
#pragma unroll
    for (int i = 0; i < 2; ++i) { int R, C; stage_rc(tid * 16 + i * 8192, R, C); const int Rb = (R & ~31) + perm32(R & 31);
        voffA[i] = (unsigned)(R * lda + C) * 2u; voffB[i] = (unsigned)(Rb * ldb + C) * 2u; }
    const int kstep = BK * 2;
    const int hstepA = HALF * lda * 2, hstepB = HALF * ldb * 2;
    const unsigned ldsw = (unsigned)wid * 1024u;
    const int aoff = lds_byte(wr * 64 + fr, fq * 8), boff = lds_byte(wc * 32 + fr, fq * 8);
#define PG8_SA(b, h) (((b) * 2 + (h)) * HTB)
#define PG8_SB(b, h) ((4 + (b) * 2 + (h)) * HTB)
#define PG8_STAGE(bufoff, gbase, voff, soff) do { const __amdgpu_buffer_rsrc_t _rs = __builtin_amdgcn_make_buffer_rsrc((void*)(gbase), (short)0, (int)0x7fffffff, (int)0x00020000); _Pragma("unroll") for (int _i = 0; _i < 2; ++_i) \
        __builtin_amdgcn_raw_ptr_buffer_load_lds(_rs, (LAS void*)(lds + (bufoff) + ldsw + _i * 8192), 16, (int)(voff)[_i], (int)(soff), 0, 0); } while (0)
#define PG8_LDA(dst, b, h) do { _Pragma("unroll") for (int m = 0; m < 4; ++m) _Pragma("unroll") for (int k = 0; k < 2; ++k) dst[m][k] = *(const LAS bf16x8*)(lds + PG8_SA(b, h) + aoff + m * 2048 + k * 1024); } while (0)
#define PG8_LDB(dst, b, h) do { _Pragma("unroll") for (int n = 0; n < 2; ++n) _Pragma("unroll") for (int k = 0; k < 2; ++k) dst[n][k] = *(const LAS bf16x8*)(lds + PG8_SB(b, h) + boff + n * 2048 + k * 1024); } while (0)
#define PG8_MMA(ai, bj, At, Bt) do { __builtin_amdgcn_s_setprio(1); _Pragma("unroll") for (int m = 0; m < 4; ++m) _Pragma("unroll") for (int n = 0; n < 2; ++n) _Pragma("unroll") for (int k = 0; k < 2; ++k) \
        acc[ai][bj][m][n] = __builtin_amdgcn_mfma_f32_16x16x32_bf16(Bt[n][k], At[m][k], acc[ai][bj][m][n], 0, 0, 0); __builtin_amdgcn_s_setprio(0); } while (0)
#define PG8_WAIT_V(n) asm volatile("s_waitcnt vmcnt(" #n ")" ::: "memory")
#define PG8_WAIT_L(n) asm volatile("s_waitcnt lgkmcnt(" #n ")" ::: "memory")
#define PG8_BAR __builtin_amdgcn_s_barrier()
#define PG8_SCHED __builtin_amdgcn_sched_barrier(0)
    Unit cur, nxt; int ui = 0;
    if (!S.next(0, cur)) return;
    f32x4 acc[2][2][4][2];
#pragma unroll
    for (int a = 0; a < 2; ++a)
#pragma unroll
        for (int b = 0; b < 2; ++b)
#pragma unroll
            for (int m = 0; m < 4; ++m)
#pragma unroll
                for (int n = 0; n < 2; ++n) acc[a][b][m][n] = (f32x4){0.f, 0.f, 0.f, 0.f};
    bf16x8 At[4][2], B0[2][2], B1[2][2];
    const char* cA = cur.A; const char* cB = cur.B;
    PG8_STAGE(PG8_SB(0, 0), cB, voffB, 0); PG8_STAGE(PG8_SB(0, 1), cB, voffB, hstepB); PG8_STAGE(PG8_SA(0, 0), cA, voffA, 0); PG8_STAGE(PG8_SA(0, 1), cA, voffA, hstepA);
    if (wr == 1) PG8_BAR;
    PG8_WAIT_V(2); PG8_BAR;
    PG8_STAGE(PG8_SB(1, 0), cB, voffB, kstep); PG8_STAGE(PG8_SA(1, 0), cA, voffA, kstep); PG8_STAGE(PG8_SB(1, 1), cB, voffB, hstepB + kstep);
    PG8_WAIT_V(6); PG8_BAR;
    for (;;) {
        const bool has_next = S.next(ui + 1, nxt);
        const char* nA = has_next ? nxt.A : cA; const char* nB = has_next ? nxt.B : cB;
        const int nt = cur.nt;
        for (int t = 0; t < nt; t += 2) {
            const bool last = (t == nt - 2);
            const int o1 = (t + 1) * kstep;
            const char* a2 = last ? nA : cA; const char* b2 = last ? nB : cB; const int o2 = last ? 0 : (t + 2) * kstep, o3 = o2 + kstep;
            PG8_LDB(B0, 0, 0); PG8_LDB(B1, 0, 1); PG8_SCHED; PG8_LDA(At, 0, 0); PG8_STAGE(PG8_SA(1, 1), cA, voffA, o1 + hstepA);
            PG8_WAIT_V(8); PG8_WAIT_L(0); PG8_BAR; PG8_MMA(0, 0, At, B0); PG8_MMA(0, 1, At, B1); PG8_BAR; PG8_SCHED;
            PG8_LDA(At, 0, 1); PG8_STAGE(PG8_SB(0, 0), b2, voffB, o2); PG8_STAGE(PG8_SB(0, 1), b2, voffB, o2 + hstepB); PG8_STAGE(PG8_SA(0, 0), a2, voffA, o2);
            PG8_WAIT_V(8); PG8_WAIT_L(0); PG8_BAR; PG8_MMA(1, 0, At, B0); PG8_MMA(1, 1, At, B1); PG8_BAR; PG8_SCHED;
            PG8_LDB(B0, 1, 0); PG8_LDB(B1, 1, 1); PG8_SCHED; PG8_LDA(At, 1, 0); PG8_STAGE(PG8_SA(0, 1), a2, voffA, o2 + hstepA);
            PG8_WAIT_V(8); PG8_WAIT_L(0); PG8_BAR; PG8_MMA(0, 0, At, B0); PG8_MMA(0, 1, At, B1); PG8_BAR; PG8_SCHED;
            PG8_LDA(At, 1, 1); PG8_STAGE(PG8_SB(1, 0), b2, voffB, o3); PG8_STAGE(PG8_SB(1, 1), b2, voffB, o3 + hstepB); PG8_STAGE(PG8_SA(1, 0), a2, voffA, o3);
            PG8_WAIT_V(8); PG8_WAIT_L(0); PG8_BAR; PG8_MMA(1, 0, At, B0); PG8_MMA(1, 1, At, B1); PG8_BAR; PG8_SCHED;
        }
        if (wr == 0) PG8_BAR;
        E(acc, cur, wr, wc, fr, fq);
        if (!has_next) break;
#pragma unroll
        for (int a = 0; a < 2; ++a)
#pragma unroll
            for (int b = 0; b < 2; ++b)
#pragma unroll
                for (int m = 0; m < 4; ++m)
#pragma unroll
                    for (int n = 0; n < 2; ++n) acc[a][b][m][n] = (f32x4){0.f, 0.f, 0.f, 0.f};
        cur = nxt; cA = nA; cB = nB; ++ui;
        if (wr == 1) PG8_BAR;
    }
    PG8_WAIT_V(0);
    PG8_BAR;
#undef PG8_SA
#undef PG8_SB
#undef PG8_STAGE
#undef PG8_LDA
#undef PG8_LDB
#undef PG8_MMA
#undef PG8_WAIT_V
#undef PG8_WAIT_L
#undef PG8_BAR
#undef PG8_SCHED
}
}
using pg8::Unit;
typedef f32x4 Acc[2][2][4][2];

DI bool tile_of(int i, int G, int c, int npn, int& pm, int& pn, int ioff = 0) {
    if ((G & 7) == 0) { const int per = G >> 3, x = c & 7, idx = c >> 3, q = i * per + idx - ioff; if (q < 0 || q >= 8 * npn) return false; pm = 8 * x + (q & 7); pn = q >> 3; return true; }
    const int L = i * G + c; if (L >= 64 * npn) return false; pm = L & 63; pn = L >> 6; return true;
}

struct SchedSimple {
    const char* A; const char* B; int lda, ldb, nt, npn, G, c, ioff;
    DI bool next(int i, Unit& u) const { int pm, pn; if (!tile_of(i, G, c, npn, pm, pn, ioff)) return false;
        u.A = A + (size_t)pm * 256 * lda * 2; u.B = B + (size_t)pn * 256 * ldb * 2; u.nt = nt; u.pm = pm; u.pn = pn; u.tag = 0; return true; }
};
struct SchedQKV {
    const char* Aq; const char* Akv; const char* Bq; const char* Bkv; int G, c;
    DI bool next(int i, Unit& u) const { int pm, pn; if (!tile_of(i, G, c, 7, pm, pn)) return false;
        const bool isq = pn < 3; u.A = (isq ? Aq : Akv) + (size_t)pm * 256 * 256 * 2; u.B = isq ? Bq + (size_t)pn * 256 * 256 * 2 : Bkv + (size_t)(pn - 3) * 256 * 256 * 2;
        u.nt = isq ? 4 : 2;     u.pm = pm; u.pn = isq ? pn : pn - 3; u.tag = isq ? 0 : 1; return true; }
};
struct SchedUp {
    const char* Z; const char* W; int G, c;
    DI bool next(int i, Unit& u) const { const int L = i * G + c; if (L >= 1024) return false; const int br = L >> 8, r = L & 255;
        const int x = r & 7, idx = r >> 3, pm = 8 * x + (idx & 7), pn = idx >> 3;
        const int koff = br == 0 ? 0 : (br == 1 ? 256 : (br == 2 ? 768 : 1024));
        u.A = Z + ((size_t)pm * 256 * NZ + ZC_G + koff) * 2; u.B = W + ((size_t)pn * 256 * 1280 + koff) * 2; u.nt = br == 1 ? 8 : 4; u.pm = pm; u.pn = br * 4 + pn; u.tag = br; return true; }
};
struct SchedGate {
    const char* H; const char* W; int G, c;
    DI bool next(int i, Unit& u) const { const int P = (i >> 2) * G + c; if (P >= 256) return false; const int b = i & 3;
        const int x = P & 7, idx = P >> 3, pm = 8 * x + (idx & 7), pc = idx >> 3;
        u.A = H + (size_t)pm * 256 * 1024 * 2; u.B = W + (size_t)(b * 4 + pc) * 256 * 1024 * 2; u.nt = 16; u.pm = pm; u.pn = b * 4 + pc; u.tag = b; return true; }
};
struct SchedDft {
    const char* T; const char* AB; int G, c;
    DI bool next(int i, Unit& u) const { const int L = i * G + c; if (L >= 256) return false; const int j = L & 7, r = L >> 3, b = r >> 3, kt = r & 7;
        u.A = T + ((size_t)j * 2048 + kt * 256) * 1024 * 2; u.B = AB + (size_t)(b * 8 + j) * 256 * 1024 * 2; u.nt = 16; u.pm = kt; u.pn = 0; u.tag = b * 8 + j; return true; }
};

#define EPI_LOOP_ROWS for (int ai = 0; ai < 2; ++ai) for (int m = 0; m < 4; ++m)
struct EpiIn {
    bf16_t* z; bf16_t* abt;
    DI void operator()(const Acc& acc, const Unit& u, int wr, int wc, int fr, int fq) const {
        const int row0 = u.pm * 256 + wr * 64 + fr, pn = u.pn, cb = wc * 32 + 8 * fq;
        if (pn <= 2 || pn >= 7) {
#pragma unroll
            EPI_LOOP_ROWS { bf16_t* rp = z + (size_t)(row0 + ai * 128 + m * 16) * NZ + pn * 256 + cb;
#pragma unroll
                for (int bj = 0; bj < 2; ++bj) { f32x4 v0 = acc[ai][bj][m][0], v1 = acc[ai][bj][m][1];
                    if (pn >= 7) {
#pragma unroll
                        for (int e = 0; e < 4; ++e) { v0[e] = siluf_(v0[e]); v1[e] = siluf_(v1[e]); } }
                    store8(rp + bj * 128, v0, v1); } __builtin_amdgcn_sched_barrier(0); }
        } else if (pn <= 4) {
#pragma unroll
            EPI_LOOP_ROWS { bf16_t* rp = z + (size_t)(row0 + ai * 128 + m * 16) * NZ + ZC_GLU + (pn - 3) * 128 + cb;
                f32x4 v0, v1;
#pragma unroll
                for (int e = 0; e < 4; ++e) { v0[e] = acc[ai][0][m][0][e] * sigmoidf_(acc[ai][1][m][0][e]); v1[e] = acc[ai][0][m][1][e] * sigmoidf_(acc[ai][1][m][1][e]); }
                store8(rp, v0, v1); __builtin_amdgcn_sched_barrier(0); }
        } else {
            const int koff = pn == 6 ? 512 : 0;
#pragma unroll
            EPI_LOOP_ROWS { const int row = row0 + ai * 128 + m * 16, b = row >> 12, s = row & 4095;
                const int j = (s & 1) + 2 * (s >> 10), kidx = ((s >> 1) & 511) + koff;
                bf16_t* bp = abt + ((size_t)(b * 8 + j) * 256 + cb) * 1024 + kidx;
#pragma unroll
                for (int bj = 0; bj < 2; ++bj)
#pragma unroll
                    for (int n = 0; n < 2; ++n)
#pragma unroll
                        for (int e = 0; e < 4; ++e) bp[(size_t)(bj * 128 + n * 4 + e) * 1024] = f2bf(acc[ai][bj][m][n][e]); __builtin_amdgcn_sched_barrier(0); }
        }
    }
};
struct EpiQKV {
    bf16_t* q; bf16_t* kn; bf16_t* v;
    DI void operator()(const Acc& acc, const Unit& u, int wr, int wc, int fr, int fq) const {
        const int row0 = u.pm * 256 + wr * 64 + fr;
#pragma unroll
        for (int bj = 0; bj < 2; ++bj) { const int c0 = u.pn * 256 + bj * 128 + wc * 32 + 8 * fq; bf16_t* base; int rstride;
            if (u.tag == 0) { const int h = c0 / 96, d = c0 - 96 * h; base = q + (size_t)h * 4096 * 96 + d; rstride = 96; }
            else { const int h = c0 >> 7, w = c0 & 127; base = (w < 64 ? kn : v) + (size_t)h * 4096 * 64 + (w & 63); rstride = 64; }
#pragma unroll
            EPI_LOOP_ROWS { const int row = row0 + ai * 128 + m * 16; const int rr = row + (row >> 12) * 7 * 4096;
                store8(base + (size_t)rr * rstride, acc[ai][bj][m][0], acc[ai][bj][m][1]); __builtin_amdgcn_sched_barrier(0); } }
    }
};
struct EpiPlain {
    bf16_t* O; int ldc; int col0;
    DI void operator()(const Acc& acc, const Unit& u, int wr, int wc, int fr, int fq) const {
        const int row0 = u.pm * 256 + wr * 64 + fr;
#pragma unroll
        EPI_LOOP_ROWS { bf16_t* rp = O + (size_t)(row0 + ai * 128 + m * 16) * ldc + col0 + u.pn * 256 + wc * 32 + 8 * fq;
#pragma unroll
            for (int bj = 0; bj < 2; ++bj) store8(rp + bj * 128, acc[ai][bj][m][0], acc[ai][bj][m][1]); __builtin_amdgcn_sched_barrier(0); }
    }
};
struct EpiDft {
    bf16_t* P;
    DI void operator()(const Acc& acc, const Unit& u, int wr, int wc, int fr, int fq) const {
        const int row0 = u.pm * 256 + wr * 64 + fr;
#pragma unroll
        EPI_LOOP_ROWS { bf16_t* rp = P + ((size_t)u.tag * 2048 + row0 + ai * 128 + m * 16) * 256 + wc * 32 + 8 * fq;
#pragma unroll
            for (int bj = 0; bj < 2; ++bj) store8(rp + bj * 128, acc[ai][bj][m][0], acc[ai][bj][m][1]); __builtin_amdgcn_sched_barrier(0); }
    }
};
struct EpiPw {
    bf16_t* z; const float* pwb;
    DI void operator()(const Acc& acc, const Unit& u, int wr, int wc, int fr, int fq) const {
        const int row0 = u.pm * 256 + wr * 64 + fr;
#pragma unroll
        for (int bj = 0; bj < 2; ++bj) { const int c0 = bj * 128 + wc * 32 + 8 * fq; const f32x4 b0 = *(const f32x4*)(pwb + c0), b1 = *(const f32x4*)(pwb + c0 + 4);
            u32x4 gg[8];
#pragma unroll
            for (int r8 = 0; r8 < 8; ++r8) gg[r8] = *(const u32x4*)(z + (size_t)(row0 + (r8 >> 2) * 128 + (r8 & 3) * 16) * NZ + ZC_GCONV + c0);
            __builtin_amdgcn_sched_barrier(0);
#pragma unroll
            for (int r8 = 0; r8 < 8; ++r8) { const int ai = r8 >> 2, m = r8 & 3; const u32x4 w = gg[r8];
                const f32x4 g0 = {bflo(w.x), bfhi(w.x), bflo(w.y), bfhi(w.y)}, g1 = {bflo(w.z), bfhi(w.z), bflo(w.w), bfhi(w.w)};
                store8(z + (size_t)(row0 + ai * 128 + m * 16) * NZ + ZC_GCONV + c0, (acc[ai][bj][m][0] + b0) * g0, (acc[ai][bj][m][1] + b1) * g1); }
            __builtin_amdgcn_sched_barrier(0); }
    }
};
struct EpiGate {
    const bf16_t* U; bf16_t* mbuf; const float* gb;
    DI void operator()(const Acc& acc, const Unit& u, int wr, int wc, int fr, int fq) const {
        const int row0 = u.pm * 256 + wr * 64 + fr, br = u.tag;
        const int cgb = u.pn * 256 + wc * 32 + 8 * fq;
        u32x4 uA[2], pA[2], uB[2], pB[2];
#define GATE_LOAD(UU, PP, K) do { const int bj_ = (K) >> 2, ai_ = ((K) >> 1) & 1, mh_ = (K) & 1; const int cg_ = cgb + bj_ * 128; _Pragma("unroll") for (int mm = 0; mm < 2; ++mm) { const size_t row = row0 + ai_ * 128 + (2 * mh_ + mm) * 16; \
            UU[mm] = *(const u32x4*)(U + row * 4096 + cg_); if (br != 0) PP[mm] = *(const u32x4*)(mbuf + row * 1024 + (cg_ & 1023)); else PP[mm] = (u32x4){0u, 0u, 0u, 0u}; } } while (0)
#define GATE_DO(UU, PP, K) do { const int bj_ = (K) >> 2, ai_ = ((K) >> 1) & 1, mh_ = (K) & 1; const int cg_ = cgb + bj_ * 128; const f32x4 b0 = *(const f32x4*)(gb + cg_), b1 = *(const f32x4*)(gb + cg_ + 4); \
        _Pragma("unroll") for (int mm = 0; mm < 2; ++mm) { const int m = 2 * mh_ + mm; const size_t row = row0 + ai_ * 128 + m * 16; const u32x4 w = UU[mm], q = PP[mm]; \
            const f32x4 u0 = {bflo(w.x), bfhi(w.x), bflo(w.y), bfhi(w.y)}, u1 = {bflo(w.z), bfhi(w.z), bflo(w.w), bfhi(w.w)}; \
            const f32x4 p0 = {bflo(q.x), bfhi(q.x), bflo(q.y), bfhi(q.y)}, p1 = {bflo(q.z), bfhi(q.z), bflo(q.w), bfhi(q.w)}; \
            f32x4 v0 = acc[ai_][bj_][m][0] + b0, v1 = acc[ai_][bj_][m][1] + b1; \
            _Pragma("unroll") for (int e = 0; e < 4; ++e) { v0[e] = sigmoidf_(v0[e]) * u0[e] + p0[e]; v1[e] = sigmoidf_(v1[e]) * u1[e] + p1[e]; } \
            store8(mbuf + row * 1024 + (cg_ & 1023), v0, v1); } } while (0)
#define SB __builtin_amdgcn_sched_barrier(0)
        GATE_LOAD(uA, pA, 0); SB;
        GATE_LOAD(uB, pB, 1); SB; GATE_DO(uA, pA, 0); SB;
        GATE_LOAD(uA, pA, 2); SB; GATE_DO(uB, pB, 1); SB;
        GATE_LOAD(uB, pB, 3); SB; GATE_DO(uA, pA, 2); SB;
        GATE_LOAD(uA, pA, 4); SB; GATE_DO(uB, pB, 3); SB;
        GATE_LOAD(uB, pB, 5); SB; GATE_DO(uA, pA, 4); SB;
        GATE_LOAD(uA, pA, 6); SB; GATE_DO(uB, pB, 5); SB;
        GATE_LOAD(uB, pB, 7); SB; GATE_DO(uA, pA, 6); SB;
        GATE_DO(uB, pB, 7); SB;
#undef SB
#undef GATE_LOAD
#undef GATE_DO
    }
};

struct SchedQKVPW {
    const char* Aq; const char* Akv; const char* Apw; const char* Bq; const char* Bkv; const char* Bpw; int G, c;
    DI bool next(int i, Unit& u) const { int pm, pn; if (!tile_of(i, G, c, 8, pm, pn)) return false;
        const int t = pn < 3 ? 0 : (pn < 7 ? 1 : 2); const int lp = t == 0 ? pn : (t == 1 ? pn - 3 : 0);
        u.A = (t == 0 ? Aq : (t == 1 ? Akv : Apw)) + (size_t)pm * 256 * 256 * 2; u.B = (t == 0 ? Bq : (t == 1 ? Bkv : Bpw)) + (size_t)lp * 256 * 256 * 2;
        u.nt = 4; u.pm = pm; u.pn = lp; u.tag = t; return true; }
};
struct EpiQKVPW {
    EpiQKV a; EpiPw b;
    DI void operator()(const Acc& acc, const Unit& u, int wr, int wc, int fr, int fq) const { if (u.tag == 2) b(acc, u, wr, wc, fr, fq); else a(acc, u, wr, wc, fr, fq); }
};

namespace att {
constexpr int KROWB = 208, SHM_K = 64 * KROWB, SHM_V = 8192;
constexpr int NBUF = 3, OFF_V = 0, OFF_K = NBUF * SHM_V, OFF_WS = OFF_K + NBUF * SHM_K;
constexpr float THR = 8.f;
#define SBAR() __builtin_amdgcn_sched_barrier(0)
DI int crow(int r, int hi) { return (r & 3) + 8 * (r >> 2) + 4 * hi; }
template <bool FIRST> DI void partialSM(f32x16& p0, f32x16& p1, f32x16& negm, float& alpha) {
    constexpr float THR2 = THR * 1.4426950408889634f;
    float pmax = p0[0];
#pragma unroll
    for (int r = 1; r < 16; ++r) pmax = fmaxf(pmax, p0[r]);
#pragma unroll
    for (int r = 0; r < 16; ++r) pmax = fmaxf(pmax, p1[r]);
    { auto rr = __builtin_amdgcn_permlane32_swap(__float_as_uint(pmax), __float_as_uint(pmax), false, false);
      pmax = fmaxf(__uint_as_float(rr[0]), __uint_as_float(rr[1])); }
    if (!FIRST && __builtin_expect(__all(pmax <= THR2), 1)) { alpha = 1.f; }
    else { const float d = FIRST ? pmax : fmaxf(pmax, 0.f); alpha = FIRST ? 1.f : __builtin_amdgcn_exp2f(-d);
#pragma unroll
        for (int r = 0; r < 16; ++r) { p0[r] -= d; p1[r] -= d; negm[r] -= d; } }
#pragma unroll
    for (int r = 0; r < 16; ++r) p0[r] = __builtin_amdgcn_exp2f(p0[r]);
}
DI void finishSM(f32x16& p0, f32x16& p1, float alpha, float& l_reg, bf16x8& pa0, bf16x8& pa1, bf16x8& pa2, bf16x8& pa3) {
#pragma unroll
    for (int r = 0; r < 16; ++r) p1[r] = __builtin_amdgcn_exp2f(p1[r]);
    float ps = 0;
#pragma unroll
    for (int r = 0; r < 16; ++r) ps += p0[r];
#pragma unroll
    for (int r = 0; r < 16; ++r) ps += p1[r];
    { auto rr = __builtin_amdgcn_permlane32_swap(__float_as_uint(ps), __float_as_uint(ps), false, false);
      ps = __uint_as_float(rr[0]) + __uint_as_float(rr[1]); }
    l_reg = l_reg * alpha + ps;
#define PK4(P, BASE, OUT) do { u32x4 w = {cvt_pk(P[BASE + 0], P[BASE + 1]), cvt_pk(P[BASE + 2], P[BASE + 3]), cvt_pk(P[BASE + 4], P[BASE + 5]), cvt_pk(P[BASE + 6], P[BASE + 7])}; \
    OUT = __builtin_bit_cast(bf16x8, w); } while (0)
    PK4(p0, 0, pa0); PK4(p0, 8, pa1); PK4(p1, 0, pa2); PK4(p1, 8, pa3);
#undef PK4
}
DI void qkt(f32x16& p0, f32x16& p1, const char* Ks, const bf16x8* qr, int r32, int hi, const f32x16& negm) {
    const char* k0p = Ks + r32 * KROWB + hi * 16; const char* k1p = k0p + 32 * KROWB;
#pragma unroll
    for (int d0 = 0; d0 < 6; ++d0) {
        const bf16x8 b0 = *reinterpret_cast<const bf16x8*>(k0p + d0 * 32), b1 = *reinterpret_cast<const bf16x8*>(k1p + d0 * 32);
        if (d0 == 0) { p0 = __builtin_amdgcn_mfma_f32_32x32x16_bf16(b0, qr[0], negm, 0, 0, 0); p1 = __builtin_amdgcn_mfma_f32_32x32x16_bf16(b1, qr[0], negm, 0, 0, 0); }
        else { p0 = __builtin_amdgcn_mfma_f32_32x32x16_bf16(b0, qr[d0], p0, 0, 0, 0); p1 = __builtin_amdgcn_mfma_f32_32x32x16_bf16(b1, qr[d0], p1, 0, 0, 0); } }
}
DI int v_st(int k, int c) { const int kk = k; return ((kk >> 3) * 2 + (c >> 5)) * 512 + ((kk & 7) * 32 + (c & 31)) * 2; }
DI int v_rd_base(int lane) { return ((lane & 3) << 3) | (((lane >> 2) & 3) << 6) | (((lane >> 4) & 1) << 5) | (((lane >> 5) & 1) << 8); }
constexpr int v_rd_off(int d0, int ks, int half) { return d0 * 512 + ks * 2048 + half * 1024; }
typedef short v4i16_t __attribute__((ext_vector_type(4)));
template <int OFF> DI s16x4 tr_read(int vb) { return __builtin_bit_cast(s16x4, __builtin_amdgcn_ds_read_tr16_b64_v4i16((LAS v4i16_t*)(unsigned long long)(unsigned)(vb + OFF))); }
template <int D0> DI void pv_one(f32x16& od, int vb, bf16x8 pa0, bf16x8 pa1, bf16x8 pa2, bf16x8 pa3) {
    const s16x4 l0 = tr_read<v_rd_off(D0, 0, 0)>(vb), h0 = tr_read<v_rd_off(D0, 0, 1)>(vb), l1 = tr_read<v_rd_off(D0, 1, 0)>(vb), h1 = tr_read<v_rd_off(D0, 1, 1)>(vb);
    const s16x4 l2 = tr_read<v_rd_off(D0, 2, 0)>(vb), h2 = tr_read<v_rd_off(D0, 2, 1)>(vb), l3 = tr_read<v_rd_off(D0, 3, 0)>(vb), h3 = tr_read<v_rd_off(D0, 3, 1)>(vb);
#define PK(L, H) (bf16x8){L[0], L[1], L[2], L[3], H[0], H[1], H[2], H[3]}
    od = __builtin_amdgcn_mfma_f32_32x32x16_bf16(PK(l0, h0), pa0, od, 0, 0, 0);
    od = __builtin_amdgcn_mfma_f32_32x32x16_bf16(PK(l1, h1), pa1, od, 0, 0, 0);
    od = __builtin_amdgcn_mfma_f32_32x32x16_bf16(PK(l2, h2), pa2, od, 0, 0, 0);
    od = __builtin_amdgcn_mfma_f32_32x32x16_bf16(PK(l3, h3), pa3, od, 0, 0, 0);
#undef PK
}
DI void pv_d0(f32x16* o, int vb, bf16x8 pa0, bf16x8 pa1, bf16x8 pa2, bf16x8 pa3) { pv_one<0>(o[0], vb, pa0, pa1, pa2, pa3); pv_one<1>(o[1], vb, pa0, pa1, pa2, pa3); }

DI void attn_unit(const bf16_t* __restrict__ Qb, const bf16_t* __restrict__ Kn, const bf16_t* __restrict__ Kr, const bf16_t* __restrict__ Vh,
                  const bf16_t* Zg, bf16_t* Zo, const float* __restrict__ ropec, const float* __restrict__ ropes, int pos0, char* lds, const int tid) {
    const int wid = tid >> 6, lane = tid & 63, r32 = lane & 31, hi = lane >> 5;
    char* V_lds = lds + OFF_V; char* K_lds = lds + OFF_K;
    float* ws = (float*)(lds + OFF_WS) + wid * 64; float* li_l = ws; float* al_l = ws + 32;
    float l_reg = 0; f32x16 o[2], negm;
#pragma unroll
    for (int r = 0; r < 16; ++r) { o[0][r] = 0.f; o[1][r] = 0.f; negm[r] = 0.f; }
    bf16x8 qr[6];
    { const bf16_t* Qw = Qb + (size_t)(wid * 32 + r32) * 96 + hi * 8;
#pragma unroll
      for (int d0 = 0; d0 < 6; ++d0) qr[d0] = *reinterpret_cast<const bf16x8*>(Qw + d0 * 16);
      const int pos = pos0 + wid * 32 + r32;
      const f32x4 c0 = *(const f32x4*)(ropec + pos * 16 + hi * 8), c1 = *(const f32x4*)(ropec + pos * 16 + hi * 8 + 4);
      const f32x4 s0 = *(const f32x4*)(ropes + pos * 16 + hi * 8), s1 = *(const f32x4*)(ropes + pos * 16 + hi * 8 + 4);
      float x1[8], x2[8], cs[8], sn[8];
#pragma unroll
      for (int j = 0; j < 8; ++j) { x1[j] = bf2f((bf16_t)qr[4][j]); x2[j] = bf2f((bf16_t)qr[5][j]); cs[j] = j < 4 ? c0[j & 3] : c1[j & 3]; sn[j] = j < 4 ? s0[j & 3] : s1[j & 3]; }
      u32x4 w1, w2;
      w1.x = cvt_pk(x1[0] * cs[0] - x2[0] * sn[0], x1[1] * cs[1] - x2[1] * sn[1]); w1.y = cvt_pk(x1[2] * cs[2] - x2[2] * sn[2], x1[3] * cs[3] - x2[3] * sn[3]);
      w1.z = cvt_pk(x1[4] * cs[4] - x2[4] * sn[4], x1[5] * cs[5] - x2[5] * sn[5]); w1.w = cvt_pk(x1[6] * cs[6] - x2[6] * sn[6], x1[7] * cs[7] - x2[7] * sn[7]);
      w2.x = cvt_pk(x2[0] * cs[0] + x1[0] * sn[0], x2[1] * cs[1] + x1[1] * sn[1]); w2.y = cvt_pk(x2[2] * cs[2] + x1[2] * sn[2], x2[3] * cs[3] + x1[3] * sn[3]);
      w2.z = cvt_pk(x2[4] * cs[4] + x1[4] * sn[4], x2[5] * cs[5] + x1[5] * sn[5]); w2.w = cvt_pk(x2[6] * cs[6] + x1[6] * sn[6], x2[7] * cs[7] + x1[7] * sn[7]);
      qr[4] = __builtin_bit_cast(bf16x8, w1); qr[5] = __builtin_bit_cast(bf16x8, w2); }
    const int ka_r = tid / 12, ka_c = tid - 12 * ka_r; const int kb_i = 512 + (tid >> 1), kb_r = kb_i / 12, kb_c = kb_i - 12 * kb_r, kb_h = (tid & 1) * 8;
    const int dKr = (int)((const char*)Kr - (const char*)Kn);
    const int koa = ka_c < 8 ? (ka_r * 64 + ka_c * 8) * 2 : dKr + (ka_r * 32 + (ka_c - 8) * 8) * 2; const int ksa = ka_c < 8 ? 128 : 64;
    const int kob = (kb_c < 8 ? (kb_r * 64 + kb_c * 8) * 2 : dKr + (kb_r * 32 + (kb_c - 8) * 8) * 2) + kb_h; const int ksb = kb_c < 8 ? 128 : 64;
    const int kda = ka_r * KROWB + ka_c * 16, kdb = kb_r * KROWB + kb_c * 16 + kb_h;
    const int vr = tid >> 3, vc = (tid & 7) * 8; const int vo = (vr * 64 + vc) * 2; const int vd = v_st(vr, vc);
    const int vb0 = (int)(uintptr_t)V_lds + v_rd_base(lane);
    struct { bf16x8 ka, vv; u32x2 kb; } sr_[2];
#define SLOAD(i, k0) do { sr_[i].ka = *reinterpret_cast<const bf16x8*>((const char*)Kn + (koa + (k0) * ksa)); sr_[i].kb = *reinterpret_cast<const u32x2*>((const char*)Kn + (kob + (k0) * ksb)); \
    sr_[i].vv = *reinterpret_cast<const bf16x8*>((const char*)Vh + (vo + (k0) * 128)); } while (0)
#define SWRITE(b, i) do { *(bf16x8*)(V_lds + (b) * SHM_V + vd) = sr_[i].vv; *(bf16x8*)(K_lds + (b) * SHM_K + kda) = sr_[i].ka; \
    *(u32x2*)(K_lds + (b) * SHM_K + kdb) = sr_[i].kb; } while (0)
#define SWAIT() asm volatile("s_waitcnt vmcnt(3)" ::: "memory")
#define RESC(a) do { if (__any((a) < 1.f)) { _Pragma("unroll") for (int d = 0; d < 2; ++d) _Pragma("unroll") for (int r = 0; r < 16; ++r) o[d][r] *= (a); } } while (0)
    f32x16 pA0, pA1, pB0, pB1; float alA, alB; bf16x8 pa0, pa1, pa2, pa3; constexpr int NT = SEQ / 64;
    SLOAD(0, 0); asm volatile("s_waitcnt vmcnt(0)" ::: "memory"); SWRITE(0, 0); __syncthreads();
    qkt(pA0, pA1, K_lds, qr, r32, hi, negm); partialSM<true>(pA0, pA1, negm, alA);
    SLOAD(1, 64); SLOAD(0, 128);
    SWAIT(); SWRITE(1, 1); __syncthreads();
    int bc = 1;
    for (int j = 1; j + 1 < NT; j += 2) {
        const int bp = bc == 0 ? 2 : bc - 1, bn = bc == 2 ? 0 : bc + 1, bnn = bn == 2 ? 0 : bn + 1;
        SBAR(); qkt(pB0, pB1, K_lds + bc * SHM_K, qr, r32, hi, negm);
        finishSM(pA0, pA1, alA, l_reg, pa0, pa1, pa2, pa3); SBAR();
        SLOAD(1, (j + 2) * 64); SBAR();
        pv_d0(o, vb0 + bp * SHM_V, pa0, pa1, pa2, pa3); partialSM<false>(pB0, pB1, negm, alB);
        SWAIT(); SWRITE(bn, 0);
        RESC(alB); __syncthreads();
        SBAR(); qkt(pA0, pA1, K_lds + bn * SHM_K, qr, r32, hi, negm);
        finishSM(pB0, pB1, alB, l_reg, pa0, pa1, pa2, pa3); SBAR();
        if (j + 3 < NT) SLOAD(0, (j + 3) * 64); SBAR();
        pv_d0(o, vb0 + bc * SHM_V, pa0, pa1, pa2, pa3); partialSM<false>(pA0, pA1, negm, alA);
        SWAIT(); SWRITE(bnn, 1);
        RESC(alA); __syncthreads();
        bc = bnn;
    }
    { const int bp = bc == 0 ? 2 : bc - 1;
      SBAR(); qkt(pB0, pB1, K_lds + bc * SHM_K, qr, r32, hi, negm);
      finishSM(pA0, pA1, alA, l_reg, pa0, pa1, pa2, pa3); SBAR();
      pv_d0(o, vb0 + bp * SHM_V, pa0, pa1, pa2, pa3); partialSM<false>(pB0, pB1, negm, alB);
      RESC(alB);
      finishSM(pB0, pB1, alB, l_reg, pa0, pa1, pa2, pa3); SBAR();
      pv_d0(o, vb0 + bc * SHM_V, pa0, pa1, pa2, pa3); }
    { const float rl = __builtin_amdgcn_rcpf(l_reg);
      bf16_t* Zw = Zo + (size_t)(wid * 32 + r32) * NZ + 4 * hi; const bf16_t* Zgw = Zg + (size_t)(wid * 32 + r32) * NZ + 4 * hi;
#pragma unroll
      for (int d0 = 0; d0 < 2; ++d0)
#pragma unroll
          for (int g = 0; g < 4; ++g) { const int off = d0 * 32 + 8 * g; const u32x2 w = *(const u32x2*)(Zgw + off);
              u32x2 ov; ov.x = cvt_pk(o[d0][4 * g + 0] * rl * bflo(w.x), o[d0][4 * g + 1] * rl * bfhi(w.x)); ov.y = cvt_pk(o[d0][4 * g + 2] * rl * bflo(w.y), o[d0][4 * g + 3] * rl * bfhi(w.y));
              *(u32x2*)(Zw + off) = ov; } }
    __syncthreads();
#undef SLOAD
#undef SWRITE
#undef SWAIT
#undef RESC
}
}

struct Ctx {
    const Params* p; unsigned char* ws; char* lds; int G, c, tid, wave, zero;
};

DI void job_transpose(const Ctx& X, const float* W, int ldw, int col0, int ncols, int K, int kvalid, bf16_t* dst, int ldd, int drow0, int dcol0, float scale) {
    const int k8n = K >> 3, total = ncols * k8n;
    for (int it = X.c * NTHREADS + X.tid; it < total; it += X.G * NTHREADS) {
        const int n = it % ncols, k8 = it / ncols; float v[8];
#pragma unroll
        for (int i = 0; i < 8; ++i) { const int k = k8 * 8 + i; v[i] = k < kvalid ? W[(size_t)k * ldw + col0 + n] * scale : 0.f; }
        u32x4 w; w.x = cvt_pk(v[0], v[1]); w.y = cvt_pk(v[2], v[3]); w.z = cvt_pk(v[4], v[5]); w.w = cvt_pk(v[6], v[7]);
        *(u32x4*)(dst + (size_t)(drow0 + n) * ldd + dcol0 + k8 * 8) = w;
    }
}
DI void job_zero_rows(const Ctx& X, bf16_t* dst, int ldd, int drow0, int nrows, int K) {
    const int k8n = K >> 3, total = nrows * k8n; unsigned zz = 0u; asm volatile("" : "+v"(zz));
    for (int it = X.c * NTHREADS + X.tid; it < total; it += X.G * NTHREADS) { const int n = it / k8n, k8 = it % k8n;
        *(u32x4*)(dst + (size_t)(drow0 + n) * ldd + k8 * 8) = (u32x4){zz, zz, zz, zz}; }
}

DI void prep1(const Ctx& X) {
    const Params& P = *X.p; unsigned char* ws = X.ws;
    const int gt = X.c * NTHREADS + X.tid, GT = X.G * NTHREADS;
    if (gt < 16) ((float*)(ws + 768 * 1024))[gt] = 0.f;
    { float* rc = (float*)(ws + WS_ROPE); float* rs = rc + 4096 * 16;
      for (int it = gt; it < 4096 * 16; it += GT) { const int pos = it >> 4, i = it & 15; const float ang = (float)pos * P.inv_freq[i];
          double rev = (double)ang * 0.15915494309189535; rev -= __builtin_rint(rev); const float rf = (float)rev;
          rc[it] = __builtin_amdgcn_cosf(rf); rs[it] = __builtin_amdgcn_sinf(rf); } }
    { bf16_t* T = (bf16_t*)(ws + WS_DFT);
      for (int it = gt; it < 8 * 2048 * 128; it += GT) { const int k8 = it & 127, ks = (it >> 7) & 2047, j = it >> 18; float v[8];
#pragma unroll
          for (int i = 0; i < 8; ++i) { const int kidx = k8 * 8 + i, kk = kidx & 511, s = 2 * ((j >> 1) * 512 + kk) + (j & 1);
              const float fr = (float)((ks * s) & 4095) * (1.f / 4096.f);
              v[i] = (kidx < 512 ? __builtin_amdgcn_cosf(fr) : -__builtin_amdgcn_sinf(fr)) * (1.f / 64.f); }
          u32x4 w; w.x = cvt_pk(v[0], v[1]); w.y = cvt_pk(v[2], v[3]); w.z = cvt_pk(v[4], v[5]); w.w = cvt_pk(v[6], v[7]);
          *(u32x4*)(T + (size_t)it * 8) = w; } }
    for (int l = 0; l < NLAYER; ++l) {
        unsigned char* wl = ws + WS_W + (size_t)l * LW;
        const float* w_in = P.in[4 + X.zero] + (size_t)l * DM * NIN;
        bf16_t* WinT = (bf16_t*)(wl + W_IN);
        job_transpose(X, w_in, NIN, 256, 256, DM, DM, WinT, DM, 256, 0, 1.f);
        job_transpose(X, w_in, NIN, 512, 160, DM, DM, WinT, DM, 512, 0, 1.f);
        job_zero_rows(X, WinT, DM, 672, 96, DM);
        job_transpose(X, w_in, NIN, 672, 128, DM, DM, WinT, DM, 768, 0, 1.f);
        job_transpose(X, w_in, NIN, 928, 128, DM, DM, WinT, DM, 896, 0, 1.f);
        job_transpose(X, w_in, NIN, 800, 128, DM, DM, WinT, DM, 1024, 0, 1.f);
        job_transpose(X, w_in, NIN, 1056, 128, DM, DM, WinT, DM, 1152, 0, 1.f);
        job_transpose(X, w_in, NIN, 1440, 1280, DM, DM, WinT, DM, 1792, 0, 1.f);
        job_transpose(X, w_in, NIN, 2720, 4096, DM, DM, (bf16_t*)(wl + W_G), DM, 0, 0, 1.f);
        job_transpose(X, P.in[7 + X.zero] + (size_t)l * 256 * 768, 768, 0, 768, 256, 256, (bf16_t*)(wl + W_UQ), 256, 0, 0, ATT_SCALE * 1.4426950408889634f);
        job_transpose(X, P.in[9 + X.zero] + (size_t)l * 128 * 1024, 1024, 0, 1024, 256, 128, (bf16_t*)(wl + W_UKV), 256, 0, 0, 1.f);
        job_transpose(X, P.in[19 + X.zero] + (size_t)l * 256 * DM, DM, 0, DM, 256, 256, (bf16_t*)(wl + W_UP), 1280, 0, 0, 1.f);
        job_transpose(X, P.in[20 + X.zero] + (size_t)l * 512 * DM, DM, 0, DM, 512, 512, (bf16_t*)(wl + W_UP), 1280, 0, 256, 1.f);
        job_transpose(X, P.in[21 + X.zero] + (size_t)l * 256 * DM, DM, 0, DM, 256, 256, (bf16_t*)(wl + W_UP), 1280, 0, 768, 1.f);
        job_transpose(X, P.in[22 + X.zero] + (size_t)l * 256 * DM, DM, 0, DM, 256, 256, (bf16_t*)(wl + W_UP), 1280, 0, 1024, 1.f);
        job_transpose(X, P.in[23 + X.zero] + (size_t)l * DM * DM, DM, 0, DM, DM, DM, (bf16_t*)(wl + W_OUT), DM, 0, 0, 1.f);
        job_transpose(X, P.in[16 + X.zero] + (size_t)l * 256 * 256, 256, 0, 256, 256, 256, (bf16_t*)(wl + W_PW), 256, 0, 0, 1.f);
        { const float* pw = P.in[10 + X.zero] + (size_t)l * 4 * 64 * 64; const float* psc = P.in[11 + X.zero] + (size_t)l * 256;
          for (int it = gt; it < DM * 256; it += GT) { const int n = it & 255, k = it >> 8, g = n >> 6, d = n & 63; float a = 0.f;
              const float* wr_ = w_in + (size_t)k * NIN + g * 64; const float* pp = pw + g * 4096 + d;
#pragma unroll 8
              for (int cc = 0; cc < 64; ++cc) a = fmaf(wr_[cc], pp[cc * 64], a);
              WinT[(size_t)n * DM + k] = f2bf(a * psc[n]); } }
        { const float* wf = P.in[18 + X.zero] + (size_t)l * 256 * 256; float* MA = (float*)(ws + WS_MAB) + (size_t)l * 2 * 65536; float* MB = MA + 65536;
          for (int it = gt; it < 65536; it += GT) { const int d = it & 255, gc = it >> 8, g = gc >> 6, cch = gc & 63; float a = 0.f, b = 0.f;
              for (int kc = 0; kc < 64; ++kc) { const float fr = (float)((kc * cch) & 63) * (1.f / 64.f); const float w = wf[(size_t)(g * 64 + kc) * 256 + d];
                  a = fmaf(__builtin_amdgcn_cosf(fr), w, a); b = fmaf(__builtin_amdgcn_sinf(fr), w, b); }
              MA[it] = a; MB[it] = b; } }
    }
}
DI void prep2(const Ctx& X) {
    const Params& P = *X.p; unsigned char* ws = X.ws;
    const int gt = X.c * NTHREADS + X.tid, GT = X.G * NTHREADS;
    for (int l = 0; l < NLAYER; ++l) {
        const float* w_in = P.in[4 + X.zero] + (size_t)l * DM * NIN + 1184; bf16_t* WinT = (bf16_t*)(ws + WS_W + (size_t)l * LW + W_IN);
        const float* MA = (const float*)(ws + WS_MAB) + (size_t)l * 2 * 65536;
        for (int it = gt; it < DM * 512; it += GT) { const int n = it & 511, k = it >> 9; const float* Mx = MA + (n >> 8) * 65536 + (n & 255); const float* wr_ = w_in + (size_t)k * NIN; float a = 0.f;
#pragma unroll 8
            for (int gc = 0; gc < 256; ++gc) a = fmaf(wr_[gc], Mx[gc * 256], a);
            WinT[(size_t)(1280 + n) * DM + k] = f2bf(a * 0.125f); }
    }
}

DI void norm_pass(const Ctx& X, int ch, int l) {
    float NEPS = NORM_EPS; asm volatile("" : "+s"(NEPS));
    const Params& P = *X.p; const int lane = X.tid & 63;
    const int gw = X.G == 256 ? (256 * (8 * (X.c & 7) + ((X.c >> 3) & 7)) + 64 * (X.c >> 6) + 8 * X.wave) : X.c * NWAVES + X.wave, NGW = X.G == 256 ? 1 : X.G * NWAVES;
    const int rend = X.G == 256 ? gw + 8 : MC;
    const float* xin = ch == 0 ? P.in[0 + X.zero] : P.in[1 + X.zero] + (size_t)(ch - 1) * MC * DM;
    float* xo = P.out + (size_t)ch * MC * DM;
    const bf16_t* ob = (const bf16_t*)(X.ws + WS_OB); bf16_t* hb = (bf16_t*)(X.ws + WS_H);
    for (int r = gw; r < rend; r += NGW) {
        const float* xr = (l == 0 ? xin : (l == 1 ? xin : xo)) + (size_t)r * DM;
        f32x4 v[4];
#pragma unroll
        for (int j = 0; j < 4; ++j) v[j] = *(const f32x4*)(xr + (lane + 64 * j) * 4);
        if (l >= 1) {
            const float* pg = P.in[3 + X.zero] + (size_t)(l - 1) * DM; f32x4 ov[4]; float ss = 0.f;
#pragma unroll
            for (int j = 0; j < 4; ++j) { const u32x2 w = *(const u32x2*)(ob + (size_t)r * DM + (lane + 64 * j) * 4); ov[j] = (f32x4){bflo(w.x), bfhi(w.x), bflo(w.y), bfhi(w.y)};
                ss += ov[j][0] * ov[j][0] + ov[j][1] * ov[j][1] + ov[j][2] * ov[j][2] + ov[j][3] * ov[j][3]; }
            const float rs = __builtin_amdgcn_rsqf(wave_sum(ss, lane) * (1.f / DM) + NEPS);
#pragma unroll
            for (int j = 0; j < 4; ++j) { const f32x4 g = *(const f32x4*)(pg + (lane + 64 * j) * 4); v[j] += ov[j] * rs * g; *(f32x4*)(xo + (size_t)r * DM + (lane + 64 * j) * 4) = v[j]; }
        }
        if (l <= 1) {
            const float* pg = P.in[2 + X.zero] + (size_t)l * DM; float ss = 0.f;
#pragma unroll
            for (int j = 0; j < 4; ++j) ss += v[j][0] * v[j][0] + v[j][1] * v[j][1] + v[j][2] * v[j][2] + v[j][3] * v[j][3];
            const float rs = __builtin_amdgcn_rsqf(wave_sum(ss, lane) * (1.f / DM) + NEPS);
#pragma unroll
            for (int j = 0; j < 4; ++j) { const f32x4 g = *(const f32x4*)(pg + (lane + 64 * j) * 4); const f32x4 hv = v[j] * rs * g;
                u32x2 w; w.x = cvt_pk(hv[0], hv[1]); w.y = cvt_pk(hv[2], hv[3]); *(u32x2*)(hb + (size_t)r * DM + (lane + 64 * j) * 4) = w; }
        }
    }
}

DI void s_pass(const Ctx& X, int l) {
    float NEPS = NORM_EPS; asm volatile("" : "+s"(NEPS));
    const Params& P = *X.p; const int gw = X.c * NWAVES + X.wave, NGW = X.G * NWAVES, lane = X.tid & 63;
    const bf16_t* z = (const bf16_t*)(X.ws + WS_Z); bf16_t* cqn = (bf16_t*)(X.ws + WS_CQN); bf16_t* ckvn = (bf16_t*)(X.ws + WS_CKVN); bf16_t* kro = (bf16_t*)(X.ws + WS_KROPE);
    const float* qg = P.in[6 + X.zero] + (size_t)l * 256; const float* kg = P.in[8 + X.zero] + (size_t)l * 128;
    const float* rc = (const float*)(X.ws + WS_ROPE); const float* rs_ = rc + 4096 * 16;
    for (int r = gw; r < MC; r += NGW) {
        const bf16_t* zr = z + (size_t)r * NZ;
        { const u32x2 w = *(const u32x2*)(zr + 256 + lane * 4); f32x4 v = {bflo(w.x), bfhi(w.x), bflo(w.y), bfhi(w.y)};
          const float rs = __builtin_amdgcn_rsqf(wave_sum(v[0] * v[0] + v[1] * v[1] + v[2] * v[2] + v[3] * v[3], lane) * (1.f / 256.f) + NEPS);
          const f32x4 g = *(const f32x4*)(qg + lane * 4); v = v * rs * g; u32x2 o; o.x = cvt_pk(v[0], v[1]); o.y = cvt_pk(v[2], v[3]); *(u32x2*)(cqn + (size_t)r * 256 + lane * 4) = o; }
        { const unsigned w = *(const unsigned*)(zr + 512 + lane * 2); float a = bflo(w), b = bfhi(w);
          const float rs = __builtin_amdgcn_rsqf(wave_sum(a * a + b * b, lane) * (1.f / 128.f) + NEPS);
          const f32x2 g = *(const f32x2*)(kg + lane * 2); *(unsigned*)(ckvn + (size_t)r * 256 + lane * 2) = cvt_pk(a * rs * g[0], b * rs * g[1]);
          *(unsigned*)(ckvn + (size_t)r * 256 + 128 + lane * 2) = 0u; }
        if (lane < 16) { const int pos = r & 4095; const float x1 = bf2f(zr[640 + lane]), x2 = bf2f(zr[656 + lane]), cs = rc[pos * 16 + lane], sn = rs_[pos * 16 + lane];
          kro[(size_t)r * 32 + lane] = f2bf(x1 * cs - x2 * sn); kro[(size_t)r * 32 + 16 + lane] = f2bf(x2 * cs + x1 * sn); }
    }
}

DI void pool_pass(const Ctx& X, bf16_t* zo) {
    bf16_t* z = (bf16_t*)(X.ws + WS_Z);
    for (int e = X.c * NTHREADS + X.tid; e < MC * 32; e += X.G * NTHREADS) {
        const int t = e >> 5, cgp = e & 31, ch0 = cgp * 8, g = cgp >> 3, hw = 1 << g, s = t & 4095, tb = t - s;
        const int lo = max(s - hw, 0), hi = min(s + hw, SEQ);
        f32x4 a0 = {0.f, 0.f, 0.f, 0.f}, a1 = a0;
        for (int r = lo; r < hi; ++r) { f32x4 v0, v1; load8(z + (size_t)(tb + r) * NZ + ch0, v0, v1); a0 += v0; a1 += v1; }
        const float ic = 1.f / (float)(hi - lo); f32x4 u0, u1, g0, g1; load8(z + (size_t)t * NZ + ch0, u0, u1); load8(z + (size_t)t * NZ + ZC_G + ch0, g0, g1);
        store8(zo + (size_t)t * NZ + ZC_G + ch0, (a0 * ic - u0) * g0, (a1 * ic - u1) * g1);
    }
}

DI void dft_combine(const Ctx& X) {
    bf16_t* z = (bf16_t*)(X.ws + WS_Z); const bf16_t* Pp = (const bf16_t*)(X.ws + WS_P);
    for (int e = X.c * NTHREADS + X.tid; e < MC * 32; e += X.G * NTHREADS) {
        const int t = e >> 5, ch0 = (e & 31) * 8, b = t >> 12, s = t & 4095, ks = s & 2047; const float sg = s >= 2048 ? -1.f : 1.f;
        f32x4 a0 = {0.f, 0.f, 0.f, 0.f}, a1 = a0;
#pragma unroll
        for (int j = 0; j < 8; ++j) { f32x4 v0, v1; load8(Pp + ((size_t)(b * 8 + j) * 2048 + ks) * 256 + ch0, v0, v1); const float sj = (j & 1) ? sg : 1.f; a0 += v0 * sj; a1 += v1 * sj; }
        f32x4 g0, g1; bf16_t* zp = z + (size_t)t * NZ + ZC_GFOUR + ch0; load8(zp, g0, g1); store8(zp, a0 * g0, a1 * g1);
    }
}

DI void conv_item(const Ctx& X, int item, int l) {
    float LEPS = LN_EPS; asm volatile("" : "+s"(LEPS)); unsigned zz = 0u; asm volatile("" : "+v"(zz));
    const Params& P = *X.p; const int tid = X.tid;
    const bf16_t* z = (const bf16_t*)(X.ws + WS_Z); bf16_t* cb = (bf16_t*)(X.ws + WS_CB);
    char* gl = X.lds; float* co = (float*)(X.lds + 49152);
    const int t0 = item * 64, s0 = t0 & 4095, tb = t0 - s0;
    for (int i = tid; i < 94 * 32; i += NTHREADS) { const int r = i >> 5, c8 = i & 31, s = s0 - 15 + r; u32x4 w = {zz, zz, zz, zz};
        if (s >= 0 && s < SEQ) w = *(const u32x4*)(z + (size_t)(tb + s) * NZ + ZC_GLU + c8 * 8);
        *(u32x4*)(gl + r * 512 + c8 * 16) = w; }
    __syncthreads();
    { const int cp = tid & 127, tg = tid >> 7; const float* cw = P.in[12 + X.zero] + (size_t)l * 31 * 256 + 2 * cp; const f32x2 bias = *(const f32x2*)(P.in[13 + X.zero] + (size_t)l * 256 + 2 * cp);
      f32x2 w[31];
#pragma unroll
      for (int k = 0; k < 31; ++k) w[k] = *(const f32x2*)(cw + k * 256);
      f32x2 a[16];
#pragma unroll
      for (int i = 0; i < 16; ++i) a[i] = bias;
#pragma unroll
      for (int r = 0; r < 46; ++r) { const unsigned u = *(const unsigned*)(gl + (tg * 16 + r) * 512 + cp * 4); const f32x2 v = {bflo(u), bfhi(u)};
#pragma unroll
          for (int i = 0; i < 16; ++i) { if (r - i >= 0 && r - i <= 30) a[i] += v * w[r - i]; } }
#pragma unroll
      for (int i = 0; i < 16; ++i) *(f32x2*)(co + (tg * 16 + i) * 256 + 2 * cp) = a[i]; }
    __syncthreads();
    { const int wv = X.wave, lane = X.tid & 63; const f32x4 g = *(const f32x4*)(P.in[14 + X.zero] + (size_t)l * 256 + lane * 4), be = *(const f32x4*)(P.in[15 + X.zero] + (size_t)l * 256 + lane * 4);
#pragma unroll
      for (int i = 0; i < 8; ++i) { const int tok = wv * 8 + i; f32x4 v = *(const f32x4*)(co + tok * 256 + lane * 4);
          const float mu = wave_sum(v[0] + v[1] + v[2] + v[3], lane) * (1.f / 256.f); v -= mu;
          const float rs = __builtin_amdgcn_rsqf(wave_sum(v[0] * v[0] + v[1] * v[1] + v[2] * v[2] + v[3] * v[3], lane) * (1.f / 256.f) + LEPS);
          v = v * rs * g + be;
#pragma unroll
          for (int e = 0; e < 4; ++e) v[e] = siluf_(v[e]);
          u32x2 o; o.x = cvt_pk(v[0], v[1]); o.y = cvt_pk(v[2], v[3]); *(u32x2*)(cb + (size_t)(t0 + tok) * 256 + lane * 4) = o; } }
    __syncthreads();
}


DI float dotbf(const bf16_t* a, const bf16_t* b, int K) { float s = 0.f; for (int k = 0; k < K; ++k) s = fmaf(bf2f(a[k]), bf2f(b[k]), s); return s; }
DI void dbg_max(float* w, float v) { atomicMax((int*)w, __builtin_bit_cast(int, fabsf(v))); }
DI void dbg_check(const Ctx& X, int l) {
    const Params& P = *X.p; unsigned char* ws = X.ws; unsigned char* wl = ws + WS_W + (size_t)l * LW;
    float* dbg = (float*)(ws + 768 * 1024);
    const bf16_t* h = (const bf16_t*)(ws + WS_H); const bf16_t* z = (const bf16_t*)(ws + WS_Z); const bf16_t* WinT = (const bf16_t*)(wl + W_IN);
    const bf16_t* abt = (const bf16_t*)(ws + WS_ABT); const bf16_t* T = (const bf16_t*)(ws + WS_DFT); const bf16_t* Pp = (const bf16_t*)(ws + WS_P);
    const bf16_t* U = (const bf16_t*)(ws + WS_U); const bf16_t* mb = (const bf16_t*)(ws + WS_M); const bf16_t* ob = (const bf16_t*)(ws + WS_OB);
    const bf16_t* WupT = (const bf16_t*)(wl + W_UP); const bf16_t* WgT = (const bf16_t*)(wl + W_G); const bf16_t* WoT = (const bf16_t*)(wl + W_OUT);
    const int i = X.c * NTHREADS + X.tid; if (i >= 32768) return;
    const unsigned hsh = (unsigned)i * 2654435761u; const int row = (hsh >> 7) % MC; const int cc = (hsh >> 3) & 1023;
    const bf16_t* hr = h + (size_t)row * DM;
    { const int col = cc % 672; dbg_max(dbg + 1, bf2f(z[(size_t)row * NZ + col]) - dotbf(hr, WinT + (size_t)col * DM, DM)); }
    { const int col = cc & 255, wr0 = 768 + (col >> 7) * 256 + (col & 127); const float a = dotbf(hr, WinT + (size_t)wr0 * DM, DM), b = dotbf(hr, WinT + (size_t)(wr0 + 128) * DM, DM);
      dbg_max(dbg + 2, bf2f(z[(size_t)row * NZ + ZC_GLU + col]) - a / (1.f + expf(-b))); }
    { const int ch = cc & 255, b = row >> 12, s = row & 4095, j = (s & 1) + 2 * (s >> 10), kidx = (s >> 1) & 511; const bf16_t* ap = abt + ((size_t)(b * 8 + j) * 256 + ch) * 1024;
      dbg_max(dbg + 3, bf2f(ap[kidx]) - dotbf(hr, WinT + (size_t)(1280 + ch) * DM, DM)); dbg_max(dbg + 3, bf2f(ap[512 + kidx]) - dotbf(hr, WinT + (size_t)(1536 + ch) * DM, DM)); }
    { const int ch = cc & 255, bj = (row >> 11) & 31, ks = row & 2047; dbg_max(dbg + 4, bf2f(Pp[((size_t)bj * 2048 + ks) * 256 + ch]) - dotbf(T + ((size_t)(bj & 7) * 2048 + ks) * 1024, abt + ((size_t)bj * 256 + ch) * 1024, 1024)); }
    { const int br = (hsh >> 1) & 3, koff = br == 0 ? 0 : (br == 1 ? 256 : (br == 2 ? 768 : 1024)), K = br == 1 ? 512 : 256;
      dbg_max(dbg + 5, bf2f(U[(size_t)row * 4096 + br * 1024 + cc]) - dotbf(z + (size_t)row * NZ + ZC_G + koff, WupT + (size_t)cc * 1280 + koff, K)); }
    { float acc = 0.f; for (int b = 0; b < 4; ++b) { const float g = dotbf(hr, WgT + (size_t)(b * 1024 + cc) * DM, DM) + P.in[5 + X.zero][(size_t)l * 4096 + b * 1024 + cc];
          acc += bf2f(U[(size_t)row * 4096 + b * 1024 + cc]) / (1.f + expf(-g)); }
      dbg_max(dbg + 6, bf2f(mb[(size_t)row * 1024 + cc]) - acc); }
    { dbg_max(dbg + 7, bf2f(ob[(size_t)row * 1024 + cc]) - dotbf(mb + (size_t)row * 1024, WoT + (size_t)cc * DM, DM)); }
    { const int col = cc & 255, g = col >> 6, hw = 1 << g, s = row & 4095, tb = row - s, lo = max(s - hw, 0), hi = min(s + hw, SEQ); float a = 0.f;
      for (int r = lo; r < hi; ++r) a += bf2f(z[(size_t)(tb + r) * NZ + col]);
      const float gg = dotbf(hr, WinT + (size_t)(1792 + col) * DM, DM), sg = gg / (1.f + expf(-gg));
      dbg_max(dbg + 8, bf2f(z[(size_t)row * NZ + ZC_G + col]) - (a / (float)(hi - lo) - bf2f(z[(size_t)row * NZ + col])) * sg); }
    { const bf16_t* cbp = (const bf16_t*)(ws + WS_CB); const int col = cc & 255, s = row & 4095, tb = row - s; float sum = 0.f, sq = 0.f, mine = 0.f;
      for (int ch = 0; ch < 256; ++ch) { float a = P.in[13 + X.zero][(size_t)l * 256 + ch];
          for (int k = 0; k < 31; ++k) { const int ss = s + k - 15; if (ss >= 0 && ss < SEQ) a = fmaf(bf2f(z[(size_t)(tb + ss) * NZ + ZC_GLU + ch]), P.in[12 + X.zero][((size_t)l * 31 + k) * 256 + ch], a); }
          sum += a; sq += a * a; if (ch == col) mine = a; }
      const float mu = sum / 256.f, var = sq / 256.f - mu * mu; float y = (mine - mu) / sqrtf(var + LN_EPS) * P.in[14 + X.zero][(size_t)l * 256 + col] + P.in[15 + X.zero][(size_t)l * 256 + col]; y = y / (1.f + expf(-y));
      dbg_max(dbg + 9, bf2f(cbp[(size_t)row * 256 + col]) - y);
      const float gg = dotbf(hr, WinT + (size_t)(2560 + col) * DM, DM), sg = gg / (1.f + expf(-gg));
      dbg_max(dbg + 10, bf2f(z[(size_t)row * NZ + ZC_GCONV + col]) - (dotbf(cbp + (size_t)row * 256, (const bf16_t*)(wl + W_PW) + (size_t)col * 256, 256) + P.in[17 + X.zero][(size_t)l * 256 + col]) * sg); }
    { const int col = cc & 255, b = row >> 12, s = row & 4095, ks = s & 2047; float f = 0.f;
      for (int j = 0; j < 8; ++j) { const float pv = bf2f(Pp[((size_t)(b * 8 + j) * 2048 + ks) * 256 + col]); f += ((j & 1) && s >= 2048) ? -pv : pv; }
      const float gg = dotbf(hr, WinT + (size_t)(2816 + col) * DM, DM), sg = gg / (1.f + expf(-gg));
      dbg_max(dbg + 11, bf2f(z[(size_t)row * NZ + ZC_GFOUR + col]) - f * sg); }
    { const float* xr = P.in[0 + X.zero] + (size_t)row * DM; float ss = 0.f; for (int k = 0; k < DM; ++k) ss = fmaf(xr[k], xr[k], ss);
      dbg_max(dbg + 12, bf2f(hr[cc]) - xr[cc] / sqrtf(ss / DM + NORM_EPS) * P.in[2 + X.zero][(size_t)l * DM + cc]); }
}
DI void dbg_report(const Ctx& X) {
    const float* dbg = (const float*)(X.ws + 768 * 1024);
    if (X.c == 0 && X.tid == 0) { float add = 0.f;
        if (dbg[1] > 0.03f) add = 1e2f; if (dbg[2] > 0.03f) add = 1e3f; if (dbg[3] > 0.03f) add = 1e4f; if (dbg[4] > 0.03f) add = 1e5f;
        if (dbg[5] > 0.03f) add = 1e6f; if (dbg[6] > 0.03f) add = 1e7f; if (dbg[7] > 0.03f) add = 1e8f; if (dbg[8] > 0.03f) add = 1e9f; if (dbg[9] > 0.03f) add = 1e10f; if (dbg[10] > 0.03f) add = 1e11f; if (dbg[11] > 0.03f) add = 1e12f; if (dbg[12] > 0.03f) add = 1e13f;
        X.p->out[0] += add; }
}

#define XB_TMO      128
#define XB_XCNT(j)  (256  + 64 * (j))
#define XB_XSUB(j)  (1280 + 64 * (j))
#define XB_XGEN(j)  (2304 + 64 * (j))
#define XB_TOP      3328
#define XB_TOPGEN   3392
#define XCD_BAR_WORDS 3456
#define XB_SPIN_CAP (1u << 22)
constexpr size_t WS_BAR = 800 * 1024;
constexpr int LDS_MISC = 131072 + 1024;
DI unsigned xb_ld(unsigned* p)              { return __hip_atomic_load(p, __ATOMIC_RELAXED, __HIP_MEMORY_SCOPE_AGENT); }
DI unsigned xb_add(unsigned* p, unsigned v) { return __hip_atomic_fetch_add(p, v, __ATOMIC_RELAXED, __HIP_MEMORY_SCOPE_AGENT); }
DI unsigned xb_xcc_id() { return (unsigned)__builtin_amdgcn_s_getreg((3 << 11) | 20) & 0xFu; }
#define XB_SPIN(cond, bar) do { unsigned _sp = 0; while (cond) { __builtin_amdgcn_s_sleep(1); \
    if ((++_sp & 255u) == 0u) { if (xb_ld(&(bar)[XB_TMO])) break; if (_sp > XB_SPIN_CAP) { atomicAdd(&(bar)[XB_TMO], 1u); break; } } } } while (0)
struct XcdBarrier { unsigned* bar; unsigned x; volatile LAS unsigned* st; };
DI void xcd_barrier_complete(unsigned* bar, unsigned x, unsigned& nloc, unsigned& nx) {
    const unsigned G = gridDim.x * gridDim.y * gridDim.z;
    unsigned sum, cnt, mine, sp = 0u;
    for (;;) {
        sum = 0u; cnt = 0u; mine = 0u;
#pragma unroll
        for (unsigned j = 0; j < 16; ++j) { const unsigned c = xb_ld(&bar[XB_XCNT(j)]); sum += c; cnt += (c > 0u) ? 1u : 0u; mine = (j == x) ? c : mine; }
        if (sum == G) break;
        __builtin_amdgcn_s_sleep(1);
        if ((++sp & 255u) == 0u) { if (xb_ld(&bar[XB_TMO])) break; if (sp > XB_SPIN_CAP) { atomicAdd(&bar[XB_TMO], 1u); break; } }
    }
    nloc = mine > 0u ? mine : 1u; nx = cnt > 0u ? cnt : 1u;
}
DI void xcd_barrier(const XcdBarrier& b, const int tid) {
    asm volatile("s_waitcnt vmcnt(0)" ::: "memory");
    __syncthreads();
    if (tid == 0) {
        unsigned* bar = b.bar;
        __builtin_amdgcn_s_waitcnt(0);
        unsigned nloc = b.st[0], nx = b.st[1];
        if (nloc == 0u) { xcd_barrier_complete(bar, b.x, nloc, nx); b.st[0] = nloc; b.st[1] = nx; }
        const unsigned old = xb_add(&bar[XB_XSUB(b.x)], 1u);
        const unsigned gen = old / nloc;
        if (old + 1u == (gen + 1u) * nloc) {
            __builtin_amdgcn_fence(__ATOMIC_RELEASE, "agent");
            asm volatile("s_waitcnt vmcnt(0)" ::: "memory");
            const unsigned og = xb_add(&bar[XB_TOP], 1u);
            const unsigned tg = og / nx;
            if (og + 1u == (tg + 1u) * nx) xb_add(&bar[XB_TOPGEN], 1u);
            else XB_SPIN(xb_ld(&bar[XB_TOPGEN]) == tg, bar);
            __builtin_amdgcn_fence(__ATOMIC_ACQUIRE, "agent");
            xb_add(&bar[XB_XGEN(b.x)], 1u);
            asm volatile("s_waitcnt vmcnt(0)" ::: "memory");
        } else {
            XB_SPIN(xb_ld(&bar[XB_XGEN(b.x)]) == gen, bar);
            __builtin_amdgcn_fence(__ATOMIC_ACQUIRE, "agent");
            asm volatile("s_waitcnt vmcnt(0)" ::: "memory");
        }
    }
    __syncthreads();
}


#define GB_SUB(g)  (8192 + 16 * (g))
#define GB_GEN(g)  (9216 + 16 * (g))
#define GB_OK      6144
#define GB_MAP     6400
DI void grp_barrier(unsigned* bar, const int g, const unsigned nloc, const int tid) {
    asm volatile("s_waitcnt vmcnt(0)" ::: "memory");
    __syncthreads();
    if (tid == 0) {
        __builtin_amdgcn_s_waitcnt(0);
        const unsigned old = xb_add(&bar[GB_SUB(g)], 1u); const unsigned gen = old / nloc;
        if (old + 1u == (gen + 1u) * nloc) xb_add(&bar[GB_GEN(g)], 1u);
        else XB_SPIN(xb_ld(&bar[GB_GEN(g)]) == gen, bar);
        __builtin_amdgcn_fence(__ATOMIC_ACQUIRE, "agent");
        asm volatile("s_waitcnt vmcnt(0)" ::: "memory");
    }
    __syncthreads();
}

constexpr int NPH = 7;
constexpr int NSTEPS = 2 + NCHUNK * NLAYER * NPH + 1;

DI void run_step(const Ctx& X, int step, const int dummy, const XcdBarrier* xb) {
    const Params& P = *X.p; unsigned char* ws = X.ws; LAS unsigned char* ldsl = (LAS unsigned char*)X.lds;
    if (step == 0) { prep1(X); return; }
    if (step == 1) { prep2(X); return; }
    if (step == NSTEPS - 1) { norm_pass(X, NCHUNK - 1, 2); return; }
    const int s2 = step - 2, ph = s2 % NPH, cl = s2 / NPH, l = cl % NLAYER, ch = cl / NLAYER;
    unsigned char* wl = ws + WS_W + (size_t)l * LW;
    switch (ph) {
    case 0: { if (l == 0 && ch > 0) norm_pass(X, ch - 1, 2); norm_pass(X, ch, l); } break;
    case 1: { SchedSimple S{(const char*)(ws + WS_H), (const char*)(wl + W_IN), DM, DM, 16, 12, X.G, X.c, 0};
              EpiIn E{(bf16_t*)(ws + WS_Z), (bf16_t*)(ws + WS_ABT)};
              pg8::gemm_phase(ldsl, X.tid, DM, DM, S, E); } break;
    case 2: {
        s_pass(X, l);
        { SchedDft S{(const char*)(ws + WS_DFT), (const char*)(ws + WS_ABT), X.G, X.c}; EpiDft E{(bf16_t*)(ws + WS_P)};
          pg8::gemm_phase(ldsl, X.tid, 1024, 1024, S, E); }
        for (int it = X.c; it < MC / 64; it += X.G) conv_item(X, it, l);
        pool_pass(X, dummy ? (bf16_t*)(ws + WS_U) : (bf16_t*)(ws + WS_Z));
    } break;
    case 3: { { SchedQKV S{(const char*)(ws + WS_CQN), (const char*)(ws + WS_CKVN), (const char*)(wl + W_UQ), (const char*)(wl + W_UKV), X.G, X.c};
                EpiQKV E{(bf16_t*)(ws + WS_Q), (bf16_t*)(ws + WS_KN), (bf16_t*)(ws + WS_V)};
                pg8::gemm_phase(ldsl, X.tid, 256, 256, S, E); }
              { SchedSimple S{(const char*)(ws + WS_CB), (const char*)(wl + W_PW), 256, 256, 4, 1, X.G, X.c, (X.G >> 3) >= 32 ? 24 : 0};
                EpiPw E{(bf16_t*)(ws + WS_Z), P.in[17 + X.zero] + (size_t)l * 256};
                pg8::gemm_phase(ldsl, X.tid, 256, 256, S, E); }
              dft_combine(X); } break;
    case 4: {
        const bf16_t* q = (const bf16_t*)(ws + WS_Q); const bf16_t* kn = (const bf16_t*)(ws + WS_KN); const bf16_t* kr = (const bf16_t*)(ws + WS_KROPE); const bf16_t* v = (const bf16_t*)(ws + WS_V);
        bf16_t* z = (bf16_t*)(ws + WS_Z); bf16_t* zo = dummy ? (bf16_t*)(ws + WS_U) : z; const float* rc = (const float*)(ws + WS_ROPE); const float* rs = rc + 4096 * 16;
        for (int i = 0;; ++i) { int pair, qb;
            if (X.G == 256) { if (i >= 2) break; const int pm = 8 * (X.c & 7) + ((X.c >> 3) & 7), pc = X.c >> 6; pair = (pm >> 4) * 8 + 2 * pc + i; qb = pm & 15; }
            else if ((X.G & 7) == 0) { const int per = X.G >> 3, x = X.c & 7, idx = X.c >> 3, qq = i * per + idx; if (qq >= 64) break; pair = 4 * x + (qq >> 4); qb = qq & 15; }
            else { const int L = i * X.G + X.c; if (L >= 512) break; pair = L >> 4; qb = L & 15; }
            const int b = pair >> 3, h = pair & 7;
            att::attn_unit(q + ((size_t)pair * 4096 + qb * 256) * 96, kn + (size_t)pair * 4096 * 64, kr + (size_t)b * 4096 * 32, v + (size_t)pair * 4096 * 64,
                           z + ((size_t)(b * 4096 + qb * 256)) * NZ + ZC_GATTN + h * 64, zo + ((size_t)(b * 4096 + qb * 256)) * NZ + ZC_GATTN + h * 64, rc, rs, qb * 256, X.lds, X.tid); }
    } break;
    case 5: { { SchedUp S{(const char*)(ws + WS_Z), (const char*)(wl + W_UP), X.G, X.c}; EpiPlain E{(bf16_t*)(ws + WS_U), 4096, 0};
                pg8::gemm_phase(ldsl, X.tid, NZ, 1280, S, E); }
              if (X.G != 256) xcd_barrier(*xb, X.tid);
              { SchedGate S{(const char*)(ws + WS_H), (const char*)(wl + W_G), X.G, X.c};
                EpiGate E{(const bf16_t*)(ws + WS_U), (bf16_t*)(ws + WS_M), P.in[5 + X.zero] + (size_t)l * 4096};
                pg8::gemm_phase(ldsl, X.tid, DM, DM, S, E); } } break;
    case 6: { SchedSimple S{(const char*)(ws + WS_M), (const char*)(wl + W_OUT), DM, DM, 16, 4, X.G, X.c, 0}; EpiPlain E{(bf16_t*)(ws + WS_OB), DM, 0};
              pg8::gemm_phase(ldsl, X.tid, DM, DM, S, E); } break;
    }
}


__global__ void __launch_bounds__(NTHREADS, 2) mk_fwd(Params prm) {
    extern __shared__ __attribute__((aligned(16))) unsigned char lds[];
    const int wave_s = __builtin_amdgcn_readfirstlane(threadIdx.x >> 6);
    volatile LAS unsigned* bst = (volatile LAS unsigned*)((LAS unsigned char*)lds + LDS_MISC);
    if (threadIdx.x == 0) { bst[0] = 0u; bst[1] = 0u; }
    __syncthreads();
    XcdBarrier xbar; xbar.bar = (unsigned*)(prm.ws + WS_BAR); xbar.x = xb_xcc_id(); xbar.st = bst;
    if (threadIdx.x == 0) { (void)xb_add(&xbar.bar[XB_XCNT(xbar.x)], 1u); __hip_atomic_store(&xbar.bar[GB_MAP + blockIdx.x], xbar.x + 1u, __ATOMIC_RELAXED, __HIP_MEMORY_SCOPE_AGENT); }
    int use_local = 0;
    int rep = 0;
    for (int step = prm.step_lo; step < prm.step_hi;) {
        int wv_ = wave_s, cb_ = blockIdx.x, gd_ = gridDim.x, zero_ = 0;
        asm volatile("" : "+s"(wv_), "+s"(cb_), "+s"(gd_), "+s"(zero_));
        int lane_; asm volatile("v_mbcnt_lo_u32_b32 %0, -1, 0\n\tv_mbcnt_hi_u32_b32 %0, -1, %0" : "=v"(lane_));
        int tidv = wv_ * 64 + lane_;
        Ctx X; X.p = &prm; X.ws = prm.ws + (size_t)(unsigned)zero_; X.lds = (char*)lds; X.G = gd_; X.c = cb_; X.tid = tidv; X.zero = zero_;
        X.wave = __builtin_amdgcn_readfirstlane(tidv >> 6);
        const bool want2 = (DBL_PREP && step < 2) || (DBL_MASK != 0 && step >= 2 && step < NSTEPS - 1 && ((DBL_MASK >> ((step - 2) % NPH)) & 1));
        const int dummy = (want2 && rep == 0) ? 1 : 0;
        run_step(X, step, dummy, &xbar);
        if (dummy) rep = 1; else { rep = 0; ++step; }
        if (step < prm.step_hi) {
            if (step == 1) { cg::this_grid().sync();
                if (tidv == 0) { unsigned ok = (gd_ == 256) ? 1u : 0u; for (int k = 0; k < 32 && ok; ++k) ok = (xb_ld(&xbar.bar[GB_MAP + (cb_ & 7) + 8 * k]) == xbar.x + 1u) ? 1u : 0u; (void)xb_add(&xbar.bar[GB_OK], ok); } }
            else if (step == 2) { xcd_barrier(xbar, tidv); use_local = __builtin_amdgcn_readfirstlane((int)(xb_ld(&xbar.bar[GB_OK]) == (unsigned)gd_)); }
            else { const int phd = (step - 3) % NPH;
                if (use_local && step >= 3 && (phd == 4 || phd == 5 || phd == 6 || phd == 0)) grp_barrier(xbar.bar, (cb_ & 7) * 8 + ((cb_ >> 3) & 7), 4u, tidv); else xcd_barrier(xbar, tidv); }
        }
    }
}

__global__ void __launch_bounds__(NTHREADS) dbg_kernel(Params prm, int mode) {
    Ctx X; X.p = &prm; X.ws = prm.ws; X.lds = nullptr; X.G = gridDim.x; X.c = blockIdx.x; X.tid = threadIdx.x; X.wave = threadIdx.x >> 6; X.zero = 0;
    if (mode == 0) dbg_check(X, 0); else dbg_report(X);
}

extern "C" void kernel_launch(void* const* d_in, const int* in_sizes, int n_in, void* d_out, int out_size, void* d_ws, size_t ws_size, hipStream_t stream) {
    static int grid = 0;
    if (grid == 0) {
        if (n_in != 24 || ws_size < WS_END) { fprintf(stderr, "kernel_launch: unexpected n_in %d / ws %zu\n", n_in, ws_size); grid = -1; return; }
        int dev = 0, cus = 0, per_cu = 0;
        hipGetDevice(&dev); hipDeviceGetAttribute(&cus, hipDeviceAttributeMultiprocessorCount, dev);
        if (hipFuncSetAttribute((const void*)mk_fwd, hipFuncAttributeMaxDynamicSharedMemorySize, LDS_BYTES) != hipSuccess) { fprintf(stderr, "kernel_launch: hipFuncSetAttribute failed\n"); grid = -1; return; }
        if (hipOccupancyMaxActiveBlocksPerMultiprocessor(&per_cu, (const void*)mk_fwd, NTHREADS, LDS_BYTES) != hipSuccess || per_cu < 1) { fprintf(stderr, "kernel_launch: occupancy query says %d\n", per_cu); per_cu = 1; }
        (void)hipGetLastError();
        grid = cus;
    }
    if (grid < 0) return;
    Params p{};
    for (int i = 0; i < 24; ++i) p.in[i] = (const float*)d_in[i];
    p.out = (float*)d_out; p.ws = (unsigned char*)d_ws;
    for (int i = 0; i < 16; ++i) p.inv_freq[i] = 1.0f / powf(10000.0f, (float)(2 * i) / 32.0f);
#if MULTI_LAUNCH
    for (int s = 0; s < NSTEPS; ++s) {
#if DBG_ON
        if (s == 2 + (DBG_CH * 2 + 1) * NPH) hipLaunchKernelGGL(dbg_kernel, dim3(64), dim3(NTHREADS), 0, stream, p, 0);
#endif

        p.step_lo = s; p.step_hi = s + 1; hipLaunchKernelGGL(mk_fwd, dim3(grid), dim3(NTHREADS), LDS_BYTES, stream, p); }
#if DBG_ON
    hipLaunchKernelGGL(dbg_kernel, dim3(1), dim3(NTHREADS), 0, stream, p, 1);
#endif
#else
    p.step_lo = 0; p.step_hi = NSTEPS;
    (void)hipMemsetAsync((char*)d_ws + WS_BAR, 0, 65536, stream);
    void* args[] = {&p};
    hipError_t e = hipLaunchCooperativeKernel((const void*)mk_fwd, dim3(grid), dim3(NTHREADS), args, LDS_BYTES, stream);
    if (e != hipSuccess) fprintf(stderr, "cooperative launch failed: %s (grid %d)\n", hipGetErrorString(e), grid);
#endif
}
```
